# Optimizing an MI355X kernel written in HIP

```python
import math
import jax, jax.numpy as jnp
from jax import lax
import numpy as np

D_MODEL = 1024
BATCH = 4
SEQ = 8192
DEPTH = 2

CHUNK = 64
Q_BLOCK = 128
D_MIX = D_MODEL
LRU_WIDTH = D_MIX // 2
LRU_BLOCKS = 8
LRU_BLOCK_W = LRU_WIDTH // LRU_BLOCKS
CONV_W = 4
RG_C = 8.0
ATTN_WIDTH = D_MIX - LRU_WIDTH
DIFF_HEADS = 4
DIFF_VDIM = ATTN_WIDTH // DIFF_HEADS
DIFF_DH = DIFF_VDIM // 2
ROPE_THETA = 10000.0
D_IN = 2 * LRU_WIDTH + 3 * ATTN_WIDTH
D_FF = 3 * D_MODEL
N_EXPERTS = 8
TOP_K = 2
N_DENSE = (DEPTH + 1) // 2
N_MOE = DEPTH // 2
EPS = 1e-6
MAX_OFFSET_CHUNKS = 64

kernel_name = 'hybrid_rglru_diffattn_moe_adaln'


def rmsnorm(x, g):
    x32 = x.astype(jnp.float32)
    y = x32 * lax.rsqrt(jnp.mean(x32 * x32, axis=-1, keepdims=True) + EPS)
    return y.astype(x.dtype) * g


def rope5(x, pos):
    inv = ROPE_THETA ** (-jnp.arange(0, DIFF_DH, 2, dtype=jnp.float32) / DIFF_DH)
    ang = pos.astype(jnp.float32)[..., None] * inv
    ang = jnp.concatenate([ang, ang], axis=-1)[:, :, None, None, :]
    cos, sin = jnp.cos(ang), jnp.sin(ang)
    x1, x2 = jnp.split(x, 2, axis=-1)
    rot = jnp.concatenate([-x2, x1], axis=-1)
    return (x * cos + rot * sin).astype(x.dtype)


def causal_conv(x, w, b):
    rhs = w[:, None, :]
    y = lax.conv_general_dilated(x, rhs, window_strides=(1,), padding=[(CONV_W - 1, 0)],
                                 dimension_numbers=('NWC', 'WIO', 'NWC'),
                                 feature_group_count=x.shape[-1])
    return y + b


def _lin_rec(e1, e2):
    a1, b1 = e1
    a2, b2 = e2
    return a1 * a2, a2 * b1 + b2


def rg_lru(x, wa, ba, wx, bx, lam):
    B, S, W = x.shape
    xb = x.reshape(B, S, LRU_BLOCKS, LRU_BLOCK_W)
    r = jax.nn.sigmoid(jnp.einsum('bsnh,nhk->bsnk', xb, wa).reshape(B, S, W) + ba)
    i = jax.nn.sigmoid(jnp.einsum('bsnh,nhk->bsnk', xb, wx).reshape(B, S, W) + bx)
    log_a = -RG_C * r.astype(jnp.float32) * jax.nn.softplus(-lam.astype(jnp.float32))
    a = jnp.exp(log_a)
    mult = jnp.sqrt(-jnp.expm1(2.0 * log_a))
    bt = mult * (i * x).astype(jnp.float32)
    _, h = lax.associative_scan(_lin_rec, (a, bt), axis=1)
    return h.astype(x.dtype)


def diff_attention(q, k, v, pos, lq1, lk1, lq2, lk2, subln_g, lambda_init):
    B, S, _ = q.shape
    q = rope5(q.reshape(B, S, DIFF_HEADS, 2, DIFF_DH), pos)
    k = rope5(k.reshape(B, S, DIFF_HEADS, 2, DIFF_DH), pos)
    v = v.reshape(B, S, DIFF_HEADS, DIFF_VDIM)
    lam = (jnp.exp(jnp.sum(lq1.astype(jnp.float32) * lk1.astype(jnp.float32)))
           - jnp.exp(jnp.sum(lq2.astype(jnp.float32) * lk2.astype(jnp.float32)))
           + lambda_init)
    chunk = pos // CHUNK
    nqb = S // Q_BLOCK
    qs = q.reshape(B, nqb, Q_BLOCK, DIFF_HEADS, 2, DIFF_DH).transpose(1, 0, 3, 4, 2, 5)
    qc = chunk.reshape(B, nqb, Q_BLOCK).transpose(1, 0, 2)
    kt = k.transpose(0, 2, 3, 1, 4)
    vt = v.transpose(0, 2, 1, 3)
    scale = DIFF_DH ** -0.5
    neg = jnp.finfo(jnp.float32).min

    def attend(args):
        qb, qcb = args
        s = jnp.einsum('bhcqd,bhckd->bhcqk', qb, kt).astype(jnp.float32) * scale
        mask = (chunk[:, None, :] <= qcb[:, :, None])[:, None, None]
        p = jax.nn.softmax(jnp.where(mask, s, neg), axis=-1)
        pd = p[:, :, 0] - lam * p[:, :, 1]
        return jnp.einsum('bhqk,bhkd->bhqd', pd.astype(vt.dtype), vt)

    o = lax.map(attend, (qs, qc))
    o = o.transpose(1, 0, 3, 2, 4).reshape(B, S, DIFF_HEADS, DIFF_VDIM)
    o = rmsnorm(o, subln_g) * (1.0 - lambda_init)
    return o.reshape(B, S, ATTN_WIDTH)


def swiglu(h, wg, wu, wd):
    return (jax.nn.silu(h @ wg) * (h @ wu)) @ wd


def moe(h, router, wg, wu, wd):
    logits = (h @ router).astype(jnp.float32)
    vals, idx = lax.top_k(logits, TOP_K)
    w = jax.nn.softmax(vals, axis=-1)
    gates = jnp.sum(jax.nn.one_hot(idx, N_EXPERTS, dtype=jnp.float32) * w[..., None], axis=-2)
    y = jnp.zeros_like(h)
    for e in range(N_EXPERTS):
        y = y + gates[..., e:e + 1].astype(h.dtype) * swiglu(h, wg[e], wu[e], wd[e])
    return y


def setup_inputs(seed: int = 0) -> dict:
    key = jax.random.key(seed)
    ks = iter(jax.random.split(key, 40))
    f32 = jnp.float32

    def nrm(shape, scale):
        return jax.random.normal(next(ks), shape, f32) * scale

    a0 = jax.random.uniform(next(ks), (DEPTH, LRU_WIDTH), f32, 0.9, 0.999)
    s0 = a0 ** (1.0 / RG_C)
    lru_lambda = jnp.log(s0) - jnp.log1p(-s0)
    offsets = jax.random.randint(next(ks), (BATCH, 1), 0, MAX_OFFSET_CHUNKS) * CHUNK
    positions = (offsets + jnp.arange(SEQ, dtype=jnp.int32)[None, :]).astype(jnp.int32)
    return {
        'x': nrm((BATCH, SEQ, D_MODEL), 1.0),
        'c': nrm((BATCH, D_MODEL), 1.0),
        'positions': positions,
        'ada_w': nrm((DEPTH, D_MODEL, 6 * D_MODEL), 0.5 * D_MODEL ** -0.5),
        'ada_b': nrm((DEPTH, 6 * D_MODEL), 0.02),
        'ln1_g': 1.0 + nrm((DEPTH, D_MODEL), 0.02),
        'ln2_g': 1.0 + nrm((DEPTH, D_MODEL), 0.02),
        'w_in': nrm((DEPTH, D_MODEL, D_IN), D_MODEL ** -0.5),
        'conv_w': nrm((DEPTH, CONV_W, LRU_WIDTH), CONV_W ** -0.5),
        'conv_b': nrm((DEPTH, LRU_WIDTH), 0.02),
        'gate_a_w': nrm((DEPTH, LRU_BLOCKS, LRU_BLOCK_W, LRU_BLOCK_W), LRU_BLOCK_W ** -0.5),
        'gate_a_b': nrm((DEPTH, LRU_WIDTH), 0.02),
        'gate_x_w': nrm((DEPTH, LRU_BLOCKS, LRU_BLOCK_W, LRU_BLOCK_W), LRU_BLOCK_W ** -0.5),
        'gate_x_b': nrm((DEPTH, LRU_WIDTH), 0.02),
        'lru_lambda': lru_lambda,
        'lam_q1': nrm((DEPTH, DIFF_DH), 0.1),
        'lam_k1': nrm((DEPTH, DIFF_DH), 0.1),
        'lam_q2': nrm((DEPTH, DIFF_DH), 0.1),
        'lam_k2': nrm((DEPTH, DIFF_DH), 0.1),
        'subln_g': 1.0 + nrm((DEPTH, DIFF_VDIM), 0.02),
        'w_out': nrm((DEPTH, D_MIX, D_MODEL), D_MIX ** -0.5),
        'ffn_w_gate': nrm((N_DENSE, D_MODEL, D_FF), D_MODEL ** -0.5),
        'ffn_w_up': nrm((N_DENSE, D_MODEL, D_FF), D_MODEL ** -0.5),
        'ffn_w_down': nrm((N_DENSE, D_FF, D_MODEL), D_FF ** -0.5),
        'moe_router': nrm((N_MOE, D_MODEL, N_EXPERTS), D_MODEL ** -0.5),
        'moe_w_gate': nrm((N_MOE, N_EXPERTS, D_MODEL, D_FF), D_MODEL ** -0.5),
        'moe_w_up': nrm((N_MOE, N_EXPERTS, D_MODEL, D_FF), D_MODEL ** -0.5),
        'moe_w_down': nrm((N_MOE, N_EXPERTS, D_FF, D_MODEL), D_FF ** -0.5),
        'final_g': 1.0 + nrm((D_MODEL,), 0.02),
    }


def reference(x, c, positions, ada_w, ada_b, ln1_g, ln2_g, w_in, conv_w, conv_b,
              gate_a_w, gate_a_b, gate_x_w, gate_x_b, lru_lambda, lam_q1, lam_k1,
              lam_q2, lam_k2, subln_g, w_out, ffn_w_gate, ffn_w_up, ffn_w_down,
              moe_router, moe_w_gate, moe_w_up, moe_w_down, final_g):
    splits = [LRU_WIDTH, 2 * LRU_WIDTH, 2 * LRU_WIDTH + ATTN_WIDTH, 2 * LRU_WIDTH + 2 * ATTN_WIDTH]
    for l in range(DEPTH):
        lambda_init = 0.8 - 0.6 * math.exp(-0.3 * l)
        mod = jax.nn.silu(c) @ ada_w[l] + ada_b[l]
        sh1, sc1, g1, sh2, sc2, g2 = jnp.split(mod[:, None, :], 6, axis=-1)
        h = rmsnorm(x, ln1_g[l]) * (1.0 + sc1) + sh1
        z = h @ w_in[l]
        xr, yr, q, k, v = jnp.split(z, splits, axis=-1)
        lru = rg_lru(causal_conv(xr, conv_w[l], conv_b[l]), gate_a_w[l], gate_a_b[l],
                     gate_x_w[l], gate_x_b[l], lru_lambda[l]) * jax.nn.gelu(yr)
        att = diff_attention(q, k, v, positions, lam_q1[l], lam_k1[l], lam_q2[l], lam_k2[l],
                             subln_g[l], lambda_init)
        x = x + g1 * (jnp.concatenate([lru, att], axis=-1) @ w_out[l])
        h = rmsnorm(x, ln2_g[l]) * (1.0 + sc2) + sh2
        if l % 2 == 0:
            j = l // 2
            f = swiglu(h, ffn_w_gate[j], ffn_w_up[j], ffn_w_down[j])
        else:
            j = l // 2
            f = moe(h, moe_router[j], moe_w_gate[j], moe_w_up[j], moe_w_down[j])
        x = x + g2 * f
    return rmsnorm(x, final_g)
```

```cpp
#include <hip/hip_runtime.h>
#include <cstdio>
#include <cstdint>

namespace pg8 {
#define PG8_LAS __attribute__((address_space(3)))
typedef unsigned short bf16_t;
typedef short bf16x8 __attribute__((ext_vector_type(8)));
typedef float f32x4 __attribute__((ext_vector_type(4)));
typedef unsigned u32x4 __attribute__((ext_vector_type(4)));
constexpr int BM = 256, BK = 64, HALF = 128, HTB = HALF * BK * 2, STAGE_BYTES = 8 * HTB, NXCD = 8, WGM = 8;

__host__ __device__ __forceinline__ int lds_byte(int r, int c) { const int st = (r >> 4) * 2 + (c >> 5), rr = r & 15, cc = c & 31, ob = rr * 64 + cc * 2; return st * 1024 + (ob ^ (((ob >> 9) & 1) << 5)); }
__host__ __device__ __forceinline__ void stage_rc(int b, int& R, int& C) { const int st = b / 1024, sb = b % 1024, swz = sb ^ (((sb >> 9) & 1) << 5); R = (st >> 1) * 16 + swz / 64; C = (st & 1) * 32 + (swz % 64) / 2; }
__host__ __device__ __forceinline__ int perm32(int rho) { const int n = rho >> 4, i = rho & 15; return 8 * (i >> 2) + 4 * n + (i & 3); }

struct Unit { int pm, pn; };
struct Gemm { const bf16_t* A; const bf16_t* Bt; int M, N, K, pad; };

struct StaticOrder {
    int nM, nN, nwg, G, c;
    __host__ __device__ void init(int M, int N, int G_, int c_) { nM = M / BM; nN = N / BM; nwg = nM * nN; G = G_; c = c_; }
    __host__ __device__ bool next(int i, Unit& u) const {
        const long L = (long)i * G + c; if (L >= nwg) return false;
        int wgid = (int)L; { const int q = nwg / NXCD, r = nwg % NXCD, xcd = wgid % NXCD, off = wgid / NXCD; wgid = (xcd < r ? xcd * (q + 1) : r * (q + 1) + (xcd - r) * q) + off; }
        const int nig = WGM * nN, gid = wgid / nig, fm = gid * WGM, gsz = (nM - fm) < WGM ? (nM - fm) : WGM;
        u.pm = fm + ((wgid % nig) % gsz); u.pn = (wgid % nig) / gsz; return true;
    }
    __device__ __forceinline__ void a_ready(const Unit&) const {}
    __device__ __forceinline__ void done(const Unit&) const {}
};

typedef float f32x2_t __attribute__((ext_vector_type(2))); typedef __bf16 bf16x2_t __attribute__((ext_vector_type(2)));
__device__ __forceinline__ unsigned cvt_pk_bf16(float lo, float hi) { f32x2_t v = {lo, hi}; bf16x2_t b = __builtin_convertvector(v, bf16x2_t); return __builtin_bit_cast(unsigned, b); }

struct EpiStoreBf16 {
    static constexpr bool PERM = true, AFTER_DRAIN = false;
    bf16_t* O; int ldc; int pad;
    __device__ __forceinline__ void operator()(const f32x4 (&acc)[2][2][4][2], const Unit& u, int wr, int wc, int fr, int fq) const {
        const int row0 = u.pm * BM + wr * 64 + fr; const int col0 = u.pn * BM + wc * 32 + 8 * fq;
#pragma unroll
        for (int ai = 0; ai < 2; ++ai)
#pragma unroll
            for (int m = 0; m < 4; ++m) { bf16_t* rowp = O + (size_t)(row0 + ai * HALF + m * 16) * ldc + col0;
#pragma unroll
                for (int bj = 0; bj < 2; ++bj) { const f32x4 v0 = acc[ai][bj][m][0], v1 = acc[ai][bj][m][1];
                    u32x4 w; w.x = cvt_pk_bf16(v0[0], v0[1]); w.y = cvt_pk_bf16(v0[2], v0[3]); w.z = cvt_pk_bf16(v1[0], v1[1]); w.w = cvt_pk_bf16(v1[2], v1[3]);
                    *(u32x4*)(rowp + bj * HALF) = w; } }
    }
};
__device__ __forceinline__ float silu_f(float x) { return x / (1.0f + __expf(-x)); }
struct EpiSwiglu {
    static constexpr bool PERM = true, AFTER_DRAIN = false;
    bf16_t* O; int ldc; int pad;
    __device__ __forceinline__ void operator()(const f32x4 (&acc)[2][2][4][2], const Unit& u, int wr, int wc, int fr, int fq) const {
        const int row0 = u.pm * BM + wr * 64 + fr; const int col0 = u.pn * HALF + wc * 32 + 8 * fq;
#pragma unroll
        for (int ai = 0; ai < 2; ++ai)
#pragma unroll
            for (int m = 0; m < 4; ++m) { bf16_t* rowp = O + (size_t)(row0 + ai * HALF + m * 16) * ldc + col0;
                float r[8];
#pragma unroll
                for (int n = 0; n < 2; ++n)
#pragma unroll
                    for (int i = 0; i < 4; ++i) r[n * 4 + i] = silu_f(acc[ai][0][m][n][i]) * acc[ai][1][m][n][i];
                u32x4 w; w.x = cvt_pk_bf16(r[0], r[1]); w.y = cvt_pk_bf16(r[2], r[3]); w.z = cvt_pk_bf16(r[4], r[5]); w.w = cvt_pk_bf16(r[6], r[7]);
                *(u32x4*)rowp = w; }
    }
};
struct EpiResid {
    static constexpr bool PERM = true, AFTER_DRAIN = false;
    const float* base; float* out; const float* gvec; const float* rowscale; int ldc; int gstride; int rows_per_batch; int rs_stride;
    __device__ __forceinline__ void operator()(const f32x4 (&acc)[2][2][4][2], const Unit& u, int wr, int wc, int fr, int fq) const {
        const int row0 = u.pm * BM + wr * 64 + fr; const int col0 = u.pn * BM + wc * 32 + 8 * fq;
        const float* gv = gvec + (size_t)((u.pm * BM) / rows_per_batch) * gstride + col0;
        f32x4 g[2][2];
#pragma unroll
        for (int bj = 0; bj < 2; ++bj)
#pragma unroll
            for (int n = 0; n < 2; ++n) g[bj][n] = *(const f32x4*)(gv + bj * HALF + 4 * n);
#pragma unroll
        for (int ai = 0; ai < 2; ++ai)
#pragma unroll
            for (int m = 0; m < 4; ++m) { const int row = row0 + ai * HALF + m * 16; const size_t off = (size_t)row * ldc + col0;
                const float rs = rowscale ? rowscale[(size_t)row * rs_stride] : 1.0f;
#pragma unroll
                for (int bj = 0; bj < 2; ++bj)
#pragma unroll
                    for (int n = 0; n < 2; ++n) { const f32x4 b = *(const f32x4*)(base + off + bj * HALF + 4 * n);
                        *(f32x4*)(out + off + bj * HALF + 4 * n) = b + g[bj][n] * rs * acc[ai][bj][m][n]; } }
    }
};

template <class Epi, class Sched, bool ALIGN_EPI = false, bool SP2 = false>
__device__ __forceinline__ void gemm_phase(PG8_LAS unsigned char* lds, const Gemm g, const Sched& S, const Epi& E) {
    const int tid = threadIdx.x, wid = __builtin_amdgcn_readfirstlane(tid >> 6), lane = tid & 63, wr = wid >> 2, wc = wid & 3, fr = lane & 15, fq = lane >> 4;
    const int K = g.K, nt = K / BK;
    unsigned voffA[2], voffB[2];
#pragma unroll
    for (int i = 0; i < 2; ++i) { int R, C; stage_rc(tid * 16 + i * 8192, R, C); const int Rb = Epi::PERM ? ((R & ~31) + perm32(R & 31)) : R;
        voffA[i] = (unsigned)(R * K + C) * 2u; voffB[i] = (unsigned)(Rb * K + C) * 2u; }
    const size_t kstep = (size_t)(BK * 2);
    const size_t hstep = (size_t)HALF * K * 2;
    const size_t tstep = 2 * hstep;
    const unsigned ldsw = (unsigned)wid * 1024u;
    const int aoff = lds_byte(wr * 64 + fr, fq * 8), boff = lds_byte(wc * 32 + fr, fq * 8);
#define PG8_SA(b, h) (((b) * 2 + (h)) * HTB)
#define PG8_SB(b, h) ((4 + (b) * 2 + (h)) * HTB)
#define PG8_STAGE(bufoff, gbase, voff) do { _Pragma("unroll") for (int _i = 0; _i < 2; ++_i) \
        __builtin_amdgcn_global_load_lds((const unsigned*)((const char*)(gbase) + (voff)[_i]), (PG8_LAS unsigned*)(lds + (bufoff) + ldsw + _i * 8192), 16, 0, 0); } while (0)
#define PG8_LDA(dst, b, h) do { _Pragma("unroll") for (int m = 0; m < 4; ++m) _Pragma("unroll") for (int k = 0; k < 2; ++k) dst[m][k] = *(const PG8_LAS bf16x8*)(lds + PG8_SA(b, h) + aoff + m * 2048 + k * 1024); } while (0)
#define PG8_LDB(dst, b, h) do { _Pragma("unroll") for (int n = 0; n < 2; ++n) _Pragma("unroll") for (int k = 0; k < 2; ++k) dst[n][k] = *(const PG8_LAS bf16x8*)(lds + PG8_SB(b, h) + boff + n * 2048 + k * 1024); } while (0)
#define PG8_MMA(ai, bj, At, Bt) do { __builtin_amdgcn_s_setprio(1); _Pragma("unroll") for (int m = 0; m < 4; ++m) _Pragma("unroll") for (int n = 0; n < 2; ++n) _Pragma("unroll") for (int k = 0; k < 2; ++k) \
        acc[ai][bj][m][n] = __builtin_amdgcn_mfma_f32_16x16x32_bf16(Bt[n][k], At[m][k], acc[ai][bj][m][n], 0, 0, 0); __builtin_amdgcn_s_setprio(0); } while (0)
#define PG8_WAIT_V(n) asm volatile("s_waitcnt vmcnt(" #n ")" ::: "memory")
#define PG8_WAIT_L(n) asm volatile("s_waitcnt lgkmcnt(" #n ")" ::: "memory")
#define PG8_BAR __builtin_amdgcn_s_barrier()
#define PG8_SCHED __builtin_amdgcn_sched_barrier(0)
    Unit cur, nxt; int ui = 0;
    if (!S.next(0, cur)) return;
    f32x4 acc[2][2][4][2];
#pragma unroll
    for (int a = 0; a < 2; ++a)
#pragma unroll
        for (int b = 0; b < 2; ++b)
#pragma unroll
            for (int m = 0; m < 4; ++m)
#pragma unroll
                for (int n = 0; n < 2; ++n) acc[a][b][m][n] = (f32x4){0.f, 0.f, 0.f, 0.f};
    bf16x8 At[4][2], B0[2][2], B1[2][2];
    const char* cA = (const char*)g.A + (size_t)cur.pm * tstep; const char* cB = (const char*)g.Bt + (size_t)cur.pn * tstep;
    S.a_ready(cur);
    if constexpr (SP2) {
        PG8_STAGE(PG8_SB(0, 0), cB, voffB); PG8_STAGE(PG8_SB(0, 1), cB + hstep, voffB); PG8_STAGE(PG8_SA(0, 0), cA, voffA); PG8_STAGE(PG8_SA(0, 1), cA + hstep, voffA);
        if (wr == 1) PG8_BAR;
        PG8_WAIT_V(2); PG8_BAR;
        PG8_STAGE(PG8_SB(1, 0), cB + kstep, voffB); PG8_STAGE(PG8_SA(1, 0), cA + kstep, voffA); PG8_STAGE(PG8_SB(1, 1), cB + hstep + kstep, voffB);
        PG8_WAIT_V(6); PG8_BAR;
    } else {
        PG8_STAGE(PG8_SB(0, 0), cB, voffB); PG8_STAGE(PG8_SA(0, 0), cA, voffA); PG8_STAGE(PG8_SB(0, 1), cB + hstep, voffB); PG8_STAGE(PG8_SA(0, 1), cA + hstep, voffA);
        if (wr == 1) PG8_BAR;
        PG8_WAIT_V(4); PG8_BAR;
        PG8_STAGE(PG8_SB(1, 0), cB + kstep, voffB); PG8_STAGE(PG8_SA(1, 0), cA + kstep, voffA); PG8_STAGE(PG8_SB(1, 1), cB + hstep + kstep, voffB);
        PG8_WAIT_V(6); PG8_BAR;
    }
    for (;;) {
        const bool has_next = S.next(ui + 1, nxt);
        const char* nA = has_next ? (const char*)g.A + (size_t)nxt.pm * tstep : cA; const char* nB = has_next ? (const char*)g.Bt + (size_t)nxt.pn * tstep : cB;
        for (int t = 0; t < nt; t += 2) {
            const bool last = (t == nt - 2);
            const char* a1 = cA + (size_t)(t + 1) * kstep;
            const char* a2 = last ? nA : cA + (size_t)(t + 2) * kstep; const char* b2 = last ? nB : cB + (size_t)(t + 2) * kstep;
            const char* a3 = a2 + kstep; const char* b3 = b2 + kstep;
            if (last && has_next) S.a_ready(nxt);
            if constexpr (SP2) {
            PG8_LDB(B0, 0, 0); PG8_LDB(B1, 0, 1); PG8_SCHED; PG8_LDA(At, 0, 0); PG8_STAGE(PG8_SA(1, 1), a1 + hstep, voffA);
            PG8_WAIT_V(8); PG8_WAIT_L(0); PG8_BAR; PG8_MMA(0, 0, At, B0); PG8_MMA(0, 1, At, B1); PG8_BAR; PG8_SCHED;
            PG8_LDA(At, 0, 1); PG8_STAGE(PG8_SB(0, 0), b2, voffB); PG8_STAGE(PG8_SB(0, 1), b2 + hstep, voffB); PG8_STAGE(PG8_SA(0, 0), a2, voffA);
            PG8_WAIT_V(8); PG8_WAIT_L(0); PG8_BAR; PG8_MMA(1, 0, At, B0); PG8_MMA(1, 1, At, B1); PG8_BAR; PG8_SCHED;
            PG8_LDB(B0, 1, 0); PG8_LDB(B1, 1, 1); PG8_SCHED; PG8_LDA(At, 1, 0); PG8_STAGE(PG8_SA(0, 1), a2 + hstep, voffA);
            PG8_WAIT_V(8); PG8_WAIT_L(0); PG8_BAR; PG8_MMA(0, 0, At, B0); PG8_MMA(0, 1, At, B1); PG8_BAR; PG8_SCHED;
            PG8_LDA(At, 1, 1); PG8_STAGE(PG8_SB(1, 0), b3, voffB); PG8_STAGE(PG8_SB(1, 1), b3 + hstep, voffB); PG8_STAGE(PG8_SA(1, 0), a3, voffA);
            PG8_WAIT_V(8); PG8_WAIT_L(0); PG8_BAR; PG8_MMA(1, 0, At, B0); PG8_MMA(1, 1, At, B1); PG8_BAR; PG8_SCHED;
            } else {
            PG8_LDB(B0, 0, 0); PG8_SCHED; PG8_LDA(At, 0, 0); PG8_STAGE(PG8_SA(1, 1), a1 + hstep, voffA);
            PG8_WAIT_L(8); PG8_BAR; PG8_WAIT_L(0); PG8_MMA(0, 0, At, B0); PG8_BAR; PG8_SCHED;
            PG8_LDB(B1, 0, 1); PG8_STAGE(PG8_SB(0, 0), b2, voffB);
            PG8_BAR; PG8_WAIT_L(0); PG8_MMA(0, 1, At, B1); PG8_BAR;
            PG8_LDA(At, 0, 1); PG8_STAGE(PG8_SA(0, 0), a2, voffA);
            PG8_BAR; PG8_WAIT_L(0); PG8_MMA(1, 0, At, B0); PG8_BAR; PG8_SCHED;
            PG8_STAGE(PG8_SB(0, 1), b2 + hstep, voffB);
            PG8_WAIT_V(6); PG8_BAR; PG8_MMA(1, 1, At, B1); PG8_BAR;
            PG8_LDB(B0, 1, 0); PG8_SCHED; PG8_LDA(At, 1, 0); PG8_STAGE(PG8_SA(0, 1), a2 + hstep, voffA);
            PG8_WAIT_L(8); PG8_BAR; PG8_WAIT_L(0); PG8_MMA(0, 0, At, B0); PG8_BAR; PG8_SCHED;
            PG8_LDB(B1, 1, 1); PG8_STAGE(PG8_SB(1, 0), b3, voffB);
            PG8_BAR; PG8_WAIT_L(0); PG8_MMA(0, 1, At, B1); PG8_BAR;
            PG8_LDA(At, 1, 1); PG8_STAGE(PG8_SA(1, 0), a3, voffA);
            PG8_BAR; PG8_WAIT_L(0); PG8_MMA(1, 0, At, B0); PG8_BAR; PG8_SCHED;
            PG8_STAGE(PG8_SB(1, 1), b3 + hstep, voffB);
            PG8_WAIT_V(6); PG8_BAR; PG8_MMA(1, 1, At, B1); PG8_BAR;
            }
        }
        if constexpr (ALIGN_EPI) { if (wr == 0) PG8_BAR; }
        if constexpr (!Epi::AFTER_DRAIN) { E(acc, cur, wr, wc, fr, fq); S.done(cur); }
        if (!has_next) break;
#pragma unroll
        for (int a = 0; a < 2; ++a)
#pragma unroll
            for (int b = 0; b < 2; ++b)
#pragma unroll
                for (int m = 0; m < 4; ++m)
#pragma unroll
                    for (int n = 0; n < 2; ++n) acc[a][b][m][n] = (f32x4){0.f, 0.f, 0.f, 0.f};
        cur = nxt; cA = nA; cB = nB; ++ui;
        if constexpr (ALIGN_EPI) { if (wr == 1) PG8_BAR; }
    }
    PG8_WAIT_V(0);
    if constexpr (!ALIGN_EPI) { if (wr == 0) PG8_BAR; }
    PG8_BAR;
#undef PG8_SA
#undef PG8_SB
#undef PG8_STAGE
#undef PG8_LDA
#undef PG8_LDB
#undef PG8_MMA
#undef PG8_WAIT_V
#undef PG8_WAIT_L
#undef PG8_BAR
#undef PG8_SCHED
}
}

typedef unsigned short bf16;
#define GAS __attribute__((address_space(1)))
#define LAS __attribute__((address_space(3)))
typedef unsigned v4u __attribute__((ext_vector_type(4)));
typedef float f32x4 __attribute__((ext_vector_type(4)));

constexpr int DM = 1024, NB = 4, SEQ = 8192, MROWS = NB * SEQ, DEPTH = 2;
constexpr int LRU_W = 512, DIN = 2560, DFF = 3072, NEXP = 8, NMOD = 6 * DM;
constexpr int ZC_XR = 0, ZC_YR = 512, ZC_Q = 1024, ZC_K = 1536, ZC_V = 2048;
constexpr float EPS = 1e-6f;
constexpr int NWAVES = 8;
constexpr int GEMM_LDS = 131072;

constexpr size_t MiB = 1u << 20;
constexpr size_t WS_CTL = 0;
constexpr size_t WS_WIN = 2 * MiB;
constexpr size_t WS_WOUT = 12 * MiB;
constexpr size_t WS_WGU = 16 * MiB;
constexpr size_t WS_WD = 28 * MiB;
constexpr size_t WS_MGU = 34 * MiB;
constexpr size_t WS_MD = 130 * MiB;
constexpr size_t WS_MOD = 178 * MiB;
constexpr size_t WS_ROPE = 180 * MiB;
constexpr size_t WS_GATES = 188 * MiB;
constexpr size_t WS_HB = 192 * MiB;
constexpr size_t WS_ZB = 256 * MiB;
constexpr size_t WS_MIX = 416 * MiB;
constexpr size_t WS_ACT = 256 * MiB;
constexpr size_t WS_END = 480 * MiB;

__device__ __forceinline__ float bf2f(bf16 v) { return __uint_as_float((unsigned)v << 16); }
__device__ __forceinline__ bf16 f2bf(float f) { return (bf16)(pg8::cvt_pk_bf16(f, 0.f) & 0xffffu); }
__device__ __forceinline__ float wave_sum(float v) {
#pragma unroll
    for (int o = 1; o < 64; o <<= 1) v += __shfl_xor(v, o);
    return v;
}
__device__ __forceinline__ float wave_max(float v) {
#pragma unroll
    for (int o = 1; o < 64; o <<= 1) v = fmaxf(v, __shfl_xor(v, o));
    return v;
}
__device__ __forceinline__ float gelu_tanh(float y) { const float u = 0.7978845608028654f * (y + 0.044715f * y * y * y); const float t = 1.0f - 2.0f / (1.0f + __expf(2.0f * u)); return 0.5f * y * (1.0f + t); }

__device__ __forceinline__ void transpose_item(const float* W, int K, int N, bf16* WT, int dest_row0, LAS float* scr, int k0, int n0, int lane) {
#pragma unroll 8
    for (int i = 0; i < 32; ++i) { const int kk = 2 * i + (lane >> 5); scr[kk * 33 + (lane & 31)] = W[(size_t)(k0 + kk) * N + n0 + (lane & 31)]; }
    asm volatile("s_waitcnt lgkmcnt(0)" ::: "memory");
    const int c = lane & 7;
#pragma unroll
    for (int j = 0; j < 4; ++j) { const int n = (lane >> 3) + 8 * j; const LAS float* s = scr + (8 * c) * 33 + n;
        v4u o; o.x = pg8::cvt_pk_bf16(s[0 * 33], s[1 * 33]); o.y = pg8::cvt_pk_bf16(s[2 * 33], s[3 * 33]); o.z = pg8::cvt_pk_bf16(s[4 * 33], s[5 * 33]); o.w = pg8::cvt_pk_bf16(s[6 * 33], s[7 * 33]);
        *(GAS v4u*)(WT + (size_t)(dest_row0 + n) * K + k0 + 8 * c) = o; }
    asm volatile("s_waitcnt lgkmcnt(0)" ::: "memory");
}
__global__ void __launch_bounds__(256) k_transpose(const float* W, int K, int N, bf16* WT, int mode) {
    __shared__ float scr_all[4][64 * 33];
    const int lane = threadIdx.x & 63, w = threadIdx.x >> 6;
    LAS float* scr = (LAS float*)&scr_all[w][0];
    const int nblk = N / 32, nitems = (K / 64) * nblk;
    for (int it = blockIdx.x * 4 + w; it < nitems; it += gridDim.x * 4) {
        const int kb = it / nblk, nb = it % nblk, k0 = 64 * kb, n0 = 32 * nb;
        int d0 = n0; if (mode == 1) d0 = 256 * (n0 / 128) + (n0 % 128); else if (mode == 2) d0 = 256 * (n0 / 128) + 128 + (n0 % 128);
        transpose_item(W, K, N, WT, d0, scr, k0, n0, lane);
    }
}
__global__ void __launch_bounds__(256) k_mod(const float* c, const float* ada_w, const float* ada_b, float* mod) {
    __shared__ float sc[NB][DM];
    for (int i = threadIdx.x; i < NB * DM; i += 256) { const float v = c[i]; sc[i / DM][i % DM] = v / (1.0f + expf(-v)); }
    __syncthreads();
    const int gid = blockIdx.x * 256 + threadIdx.x; if (gid >= DEPTH * NMOD) return;
    const int l = gid / NMOD, n = gid % NMOD;
    const float* w = ada_w + (size_t)l * DM * NMOD + n;
    float a0 = 0.f, a1 = 0.f, a2 = 0.f, a3 = 0.f;
    for (int k = 0; k < DM; ++k) { const float wv = w[(size_t)k * NMOD]; a0 += sc[0][k] * wv; a1 += sc[1][k] * wv; a2 += sc[2][k] * wv; a3 += sc[3][k] * wv; }
    const float bb = ada_b[l * NMOD + n];
    mod[((size_t)l * NB + 0) * NMOD + n] = a0 + bb; mod[((size_t)l * NB + 1) * NMOD + n] = a1 + bb;
    mod[((size_t)l * NB + 2) * NMOD + n] = a2 + bb; mod[((size_t)l * NB + 3) * NMOD + n] = a3 + bb;
}
__constant__ float c_inv[32] = {1.000000000e+00f, 7.498942018e-01f, 5.623413324e-01f, 4.216965139e-01f, 3.162277639e-01f, 2.371373773e-01f, 1.778279394e-01f, 1.333521456e-01f, 1.000000015e-01f, 7.498942316e-02f, 5.623413250e-02f, 4.216964915e-02f, 3.162277490e-02f, 2.371373773e-02f, 1.778279431e-02f, 1.333521400e-02f, 9.999999776e-03f, 7.498942316e-03f, 5.623413250e-03f, 4.216964822e-03f, 3.162277630e-03f, 2.371373819e-03f, 1.778279431e-03f, 1.333521446e-03f, 1.000000047e-03f, 7.498941850e-04f, 5.623413017e-04f, 4.216965172e-04f, 3.162277571e-04f, 2.371373703e-04f, 1.778279402e-04f, 1.333521504e-04f};
__device__ __forceinline__ void sincos_acc(float angf, float& cs, float& sn) {
    const double x = (double)angf;
    const double k = rint(x * 0.63661977236758134308);
    const double r = fma(-k, 6.123233995736766036e-17, fma(-k, 1.57079632679489655800, x));
    const double r2 = r * r;
    double s = -7.6471637318198164759e-13; s = fma(s, r2, 1.6059043836821614599e-10); s = fma(s, r2, -2.5052108385441718775e-08); s = fma(s, r2, 2.7557319223985890653e-06);
    s = fma(s, r2, -1.9841269841269841270e-04); s = fma(s, r2, 8.3333333333333333333e-03); s = fma(s, r2, -1.6666666666666666667e-01); s = fma(s * r2, r, r);
    double c = 4.7794773323873852974e-14; c = fma(c, r2, -1.1470745597729724714e-11); c = fma(c, r2, 2.0876756987868098979e-09); c = fma(c, r2, -2.7557319223985890653e-07);
    c = fma(c, r2, 2.4801587301587301587e-05); c = fma(c, r2, -1.3888888888888888889e-03); c = fma(c, r2, 4.1666666666666666667e-02); c = fma(c, r2, -0.5); c = fma(c, r2, 1.0);
    const int q = ((int)(long long)k) & 3;
    const double sv = (q == 0) ? s : (q == 1) ? c : (q == 2) ? -s : -c;
    const double cv = (q == 0) ? c : (q == 1) ? -s : (q == 2) ? -c : s;
    cs = (float)cv; sn = (float)sv;
}
__global__ void __launch_bounds__(256) k_rope_tbl(const int* pos, float2* tbl) {
    const int gid = blockIdx.x * 256 + threadIdx.x; if (gid >= MROWS * 32) return;
    const int row = gid >> 5, i = gid & 31;
    const float ang = __fmul_rn((float)pos[row], c_inv[i]);
    float cs, sn; sincos_acc(ang, cs, sn);
    tbl[gid] = make_float2(cs, sn);
}

__global__ void __launch_bounds__(256) k_norm_mod(const float* x, const float* lng, const float* mod_l  , int sh_off, int sc_off, bf16* H, const float* router  , float* gates) {
    const int lane = threadIdx.x & 63; const int gw = (blockIdx.x * 256 + threadIdx.x) >> 6, NGW = gridDim.x * 4;
    for (int row = gw; row < MROWS; row += NGW) {
        const int b = row / SEQ;
        const f32x4* xr = (const f32x4*)(x + (size_t)row * DM) + lane;
        f32x4 v[4]; float s = 0.f;
#pragma unroll
        for (int j = 0; j < 4; ++j) { v[j] = xr[64 * j]; s += (v[j].x * v[j].x + v[j].y * v[j].y) + (v[j].z * v[j].z + v[j].w * v[j].w); }
        const float rstd = rsqrtf(wave_sum(s) * (1.0f / DM) + EPS);
        const float* mb = mod_l + (size_t)b * NMOD;
        float lg[8];
#pragma unroll
        for (int e = 0; e < 8; ++e) lg[e] = 0.f;
#pragma unroll
        for (int j = 0; j < 4; ++j) { const int c0 = 4 * lane + 256 * j;
            const f32x4 g = *(const f32x4*)(lng + c0), sc = *(const f32x4*)(mb + sc_off + c0), sh = *(const f32x4*)(mb + sh_off + c0);
            f32x4 h; h = v[j] * rstd * g * (1.0f + sc) + sh;
            uint2 o; o.x = pg8::cvt_pk_bf16(h.x, h.y); o.y = pg8::cvt_pk_bf16(h.z, h.w);
            *(uint2*)(H + (size_t)row * DM + c0) = o;
            if (router) {
#pragma unroll
                for (int i = 0; i < 4; ++i) { const f32x4 r0 = *(const f32x4*)(router + (size_t)(c0 + i) * 8), r1 = *(const f32x4*)(router + (size_t)(c0 + i) * 8 + 4);
                    const float hv = h[i];
                    lg[0] += hv * r0.x; lg[1] += hv * r0.y; lg[2] += hv * r0.z; lg[3] += hv * r0.w; lg[4] += hv * r1.x; lg[5] += hv * r1.y; lg[6] += hv * r1.z; lg[7] += hv * r1.w; }
            }
        }
        if (router) {
#pragma unroll
            for (int e = 0; e < 8; ++e) lg[e] = wave_sum(lg[e]);
            int i0 = 0; float v0 = lg[0];
#pragma unroll
            for (int e = 1; e < 8; ++e) if (lg[e] > v0) { v0 = lg[e]; i0 = e; }
            int i1 = -1; float v1 = -INFINITY;
#pragma unroll
            for (int e = 0; e < 8; ++e) if (e != i0 && lg[e] > v1) { v1 = lg[e]; i1 = e; }
            const float e1 = expf(v1 - v0), w0 = 1.0f / (1.0f + e1), w1 = e1 / (1.0f + e1);
            if (lane < 8) gates[(size_t)row * 8 + lane] = (lane == i0) ? w0 : (lane == i1) ? w1 : 0.f;
        }
    }
}
__global__ void __launch_bounds__(256) k_final(float* x, const float* g) {
    const int lane = threadIdx.x & 63; const int gw = (blockIdx.x * 256 + threadIdx.x) >> 6, NGW = gridDim.x * 4;
    for (int row = gw; row < MROWS; row += NGW) {
        f32x4* xr = (f32x4*)(x + (size_t)row * DM) + lane;
        f32x4 v[4]; float s = 0.f;
#pragma unroll
        for (int j = 0; j < 4; ++j) { v[j] = xr[64 * j]; s += (v[j].x * v[j].x + v[j].y * v[j].y) + (v[j].z * v[j].z + v[j].w * v[j].w); }
        const float rstd = rsqrtf(wave_sum(s) * (1.0f / DM) + EPS);
#pragma unroll
        for (int j = 0; j < 4; ++j) { const f32x4 gg = *(const f32x4*)(g + 4 * lane + 256 * j); xr[64 * j] = v[j] * rstd * gg; }
    }
}

__global__ void __launch_bounds__(256) k_rope_naive(bf16* Z, const float2* tbl) {
    const size_t gid = (size_t)blockIdx.x * 256 + threadIdx.x; if (gid >= (size_t)MROWS * 16 * 32) return;
    const int i = gid & 31, s = (gid >> 5) & 15; const size_t row = gid >> 9;
    bf16* p = Z + row * DIN + ZC_Q + s * 64;
    const float2 cs = tbl[row * 32 + i];
    const float x1 = bf2f(p[i]), x2 = bf2f(p[i + 32]);
    p[i] = f2bf(x1 * cs.x - x2 * cs.y); p[i + 32] = f2bf(x2 * cs.x + x1 * cs.y);
}
__global__ void __launch_bounds__(256) k_conv_naive(const bf16* Z, const float* cw, const float* cb, float* XC) {
    const size_t gid = (size_t)blockIdx.x * 256 + threadIdx.x; if (gid >= (size_t)MROWS * LRU_W) return;
    const int c = gid % LRU_W; const size_t row = gid / LRU_W; const int t = row % SEQ;
    float acc = cb[c];
#pragma unroll
    for (int j = 0; j < 4; ++j) { const int tt = t - 3 + j; if (tt >= 0) acc += cw[j * LRU_W + c] * bf2f(Z[(row - 3 + j) * DIN + ZC_XR + c]); }
    XC[gid] = acc;
}
__global__ void __launch_bounds__(64) k_lru_naive(const float* XC, const bf16* Z, const float* wa, const float* ba, const float* wx, const float* bx, const float* lam, bf16* MIX) {
    const int b = blockIdx.x / 8, n = blockIdx.x % 8, k = threadIdx.x, c = n * 64 + k;
    float war[64], wxr[64];
#pragma unroll
    for (int h = 0; h < 64; ++h) { war[h] = wa[(size_t)(n * 64 + h) * 64 + k]; wxr[h] = wx[(size_t)(n * 64 + h) * 64 + k]; }
    const float bav = ba[c], bxv = bx[c];
    const float L = lam[c]; const float sp = (L > 15.f) ? expf(-L) : log1pf(expf(-L));
    float h = 0.f;
    const size_t row0 = (size_t)b * SEQ;
    float xk = XC[row0 * LRU_W + c];
    for (int t = 0; t < SEQ; ++t) {
        const size_t row = row0 + t;
        const float xnext = (t + 1 < SEQ) ? XC[(row + 1) * LRU_W + c] : 0.f;
        float ar = bav, ai = bxv;
#pragma unroll
        for (int hh = 0; hh < 64; ++hh) { const float xv = __shfl(xk, hh); ar += xv * war[hh]; ai += xv * wxr[hh]; }
        const float r = 1.0f / (1.0f + expf(-ar)), ig = 1.0f / (1.0f + expf(-ai));
        const float log_a = -8.0f * r * sp; const float a = expf(log_a); const float mult = sqrtf(-expm1f(2.0f * log_a));
        h = a * h + mult * (ig * xk);
        const float y = bf2f(Z[row * DIN + ZC_YR + c]);
        MIX[row * DM + c] = f2bf(h * gelu_tanh(y));
        xk = xnext;
    }
}
__global__ void __launch_bounds__(256) k_attn_naive(const bf16* Z, const int* pos, bf16* MIX, const float* lq1, const float* lk1, const float* lq2, const float* lk2, const float* subg, float lambda_init) {
    __shared__ float qs[4][128];
    const int lane = threadIdx.x & 63, w = threadIdx.x >> 6; const int gw = blockIdx.x * 4 + w;
    const int q = gw % SEQ, h = (gw / SEQ) % 4, b = gw / (SEQ * 4);
    const size_t rowb = (size_t)b * SEQ, row = rowb + q;
    const float lam = expf(wave_sum(lq1[lane] * lk1[lane])) - expf(wave_sum(lq2[lane] * lk2[lane])) + lambda_init;
    qs[w][lane] = bf2f(Z[row * DIN + ZC_Q + h * 128 + lane]); qs[w][64 + lane] = bf2f(Z[row * DIN + ZC_Q + h * 128 + 64 + lane]);
    __syncthreads();
    const int pq = pos[row], cq = pq >> 6, p0 = pos[rowb];
    int kend = ((cq + 1) << 6) - 1 - p0; if (kend > SEQ - 1) kend = SEQ - 1;
    const int nch = kend / 64 + 1;
    float m1 = -INFINITY, m2 = -INFINITY, l1 = 0.f, l2 = 0.f, o1a = 0.f, o1b = 0.f, o2a = 0.f, o2b = 0.f;
    for (int ch = 0; ch < nch; ++ch) {
        const int key = ch * 64 + lane;
        const bool valid = (pos[rowb + key] >> 6) <= cq;
        const bf16* kr = Z + (rowb + key) * DIN + ZC_K + h * 128;
        float s1 = 0.f, s2 = 0.f;
#pragma unroll 8
        for (int d = 0; d < 64; d += 2) { const unsigned u1 = *(const unsigned*)(kr + d), u2 = *(const unsigned*)(kr + 64 + d);
            s1 += qs[w][d] * __uint_as_float(u1 << 16) + qs[w][d + 1] * __uint_as_float(u1 & 0xffff0000u);
            s2 += qs[w][64 + d] * __uint_as_float(u2 << 16) + qs[w][64 + d + 1] * __uint_as_float(u2 & 0xffff0000u); }
        s1 = valid ? s1 * 0.125f : -INFINITY; s2 = valid ? s2 * 0.125f : -INFINITY;
        const float m1n = fmaxf(m1, wave_max(s1)), m2n = fmaxf(m2, wave_max(s2));
        const float f1 = expf(m1 - m1n), f2 = expf(m2 - m2n);
        const float p1 = expf(s1 - m1n), p2 = expf(s2 - m2n);
        l1 = l1 * f1 + wave_sum(p1); l2 = l2 * f2 + wave_sum(p2);
        o1a *= f1; o1b *= f1; o2a *= f2; o2b *= f2; m1 = m1n; m2 = m2n;
        const bf16* vr = Z + (rowb + (size_t)ch * 64) * DIN + ZC_V + h * 128 + 2 * lane;
#pragma unroll 8
        for (int j = 0; j < 64; ++j) { const unsigned vv = *(const unsigned*)(vr + (size_t)j * DIN); const float va = __uint_as_float(vv << 16), vb = __uint_as_float(vv & 0xffff0000u);
            const float pj1 = __shfl(p1, j), pj2 = __shfl(p2, j);
            o1a += pj1 * va; o1b += pj1 * vb; o2a += pj2 * va; o2b += pj2 * vb; }
    }
    const float oa = o1a / l1 - lam * (o2a / l2), ob = o1b / l1 - lam * (o2b / l2);
    const float ms = wave_sum(oa * oa + ob * ob) * (1.0f / 128.0f);
    const float rs = rsqrtf(ms + EPS) * (1.0f - lambda_init);
    const unsigned o = pg8::cvt_pk_bf16(oa * rs * subg[2 * lane], ob * rs * subg[2 * lane + 1]);
    *(unsigned*)(MIX + row * DM + 512 + h * 128 + 2 * lane) = o;
}

template <class Epi>
__global__ void __launch_bounds__(512, 2) k_gemm(pg8::Gemm g, Epi E) {
    extern __shared__ __attribute__((aligned(16))) unsigned char lds[];
    pg8::StaticOrder S; S.init(g.M, g.N, gridDim.x, blockIdx.x);
    pg8::gemm_phase<Epi, pg8::StaticOrder, true, true>((PG8_LAS unsigned char*)lds, g, S, E);
}

extern "C" void kernel_launch(void* const* d_in, const int* in_sizes, int n_in, void* d_out, int out_size, void* d_ws, size_t ws_size, hipStream_t stream) {
    static int grid = 0;
    if (grid == 0) {
        if (n_in != 29 || in_sizes[0] != MROWS * DM || out_size != MROWS * DM || ws_size < WS_END) { fprintf(stderr, "kernel_launch: unexpected shapes / workspace (n_in %d, ws %zu); nothing launched\n", n_in, ws_size); grid = -1; return; }
        int dev = 0, cus = 0;
        if (hipGetDevice(&dev) != hipSuccess || hipDeviceGetAttribute(&cus, hipDeviceAttributeMultiprocessorCount, dev) != hipSuccess) { grid = -1; return; }
        hipFuncSetAttribute((const void*)k_gemm<pg8::EpiStoreBf16>, hipFuncAttributeMaxDynamicSharedMemorySize, GEMM_LDS);
        hipFuncSetAttribute((const void*)k_gemm<pg8::EpiSwiglu>, hipFuncAttributeMaxDynamicSharedMemorySize, GEMM_LDS);
        hipFuncSetAttribute((const void*)k_gemm<pg8::EpiResid>, hipFuncAttributeMaxDynamicSharedMemorySize, GEMM_LDS);
        grid = cus;
    }
    if (grid < 0) return;
    const float* x_in = (const float*)d_in[0]; const float* c_in = (const float*)d_in[1]; const int* pos = (const int*)d_in[2];
    const float* ada_w = (const float*)d_in[3]; const float* ada_b = (const float*)d_in[4]; const float* ln1_g = (const float*)d_in[5]; const float* ln2_g = (const float*)d_in[6];
    const float* w_in = (const float*)d_in[7]; const float* conv_w = (const float*)d_in[8]; const float* conv_b = (const float*)d_in[9];
    const float* gate_a_w = (const float*)d_in[10]; const float* gate_a_b = (const float*)d_in[11]; const float* gate_x_w = (const float*)d_in[12]; const float* gate_x_b = (const float*)d_in[13];
    const float* lru_lambda = (const float*)d_in[14]; const float* lam_q1 = (const float*)d_in[15]; const float* lam_k1 = (const float*)d_in[16]; const float* lam_q2 = (const float*)d_in[17]; const float* lam_k2 = (const float*)d_in[18];
    const float* subln_g = (const float*)d_in[19]; const float* w_out = (const float*)d_in[20];
    const float* ffn_wg = (const float*)d_in[21]; const float* ffn_wu = (const float*)d_in[22]; const float* ffn_wd = (const float*)d_in[23];
    const float* moe_router = (const float*)d_in[24]; const float* moe_wg = (const float*)d_in[25]; const float* moe_wu = (const float*)d_in[26]; const float* moe_wd = (const float*)d_in[27];
    const float* final_g = (const float*)d_in[28];
    unsigned char* ws = (unsigned char*)d_ws; float* xr = (float*)d_out;
    bf16* Win = (bf16*)(ws + WS_WIN); bf16* Wout = (bf16*)(ws + WS_WOUT); bf16* Wgu = (bf16*)(ws + WS_WGU); bf16* Wd = (bf16*)(ws + WS_WD); bf16* Mgu = (bf16*)(ws + WS_MGU); bf16* Md = (bf16*)(ws + WS_MD);
    float* MOD = (float*)(ws + WS_MOD); float2* ROPE = (float2*)(ws + WS_ROPE); float* GATES = (float*)(ws + WS_GATES);
    bf16* HB = (bf16*)(ws + WS_HB); float* XC = (float*)(ws + WS_HB); bf16* ZB = (bf16*)(ws + WS_ZB); bf16* MIX = (bf16*)(ws + WS_MIX); bf16* ACT = (bf16*)(ws + WS_ACT);
    const int TG = 1024;
    for (int l = 0; l < DEPTH; ++l) {
        k_transpose<<<TG, 256, 0, stream>>>(w_in + (size_t)l * DM * DIN, DM, DIN, Win + (size_t)l * DIN * DM, 0);
        k_transpose<<<TG, 256, 0, stream>>>(w_out + (size_t)l * DM * DM, DM, DM, Wout + (size_t)l * DM * DM, 0);
    }
    k_transpose<<<TG, 256, 0, stream>>>(ffn_wg, DM, DFF, Wgu, 1);
    k_transpose<<<TG, 256, 0, stream>>>(ffn_wu, DM, DFF, Wgu, 2);
    k_transpose<<<TG, 256, 0, stream>>>(ffn_wd, DFF, DM, Wd, 0);
    for (int e = 0; e < NEXP; ++e) {
        k_transpose<<<TG, 256, 0, stream>>>(moe_wg + (size_t)e * DM * DFF, DM, DFF, Mgu + (size_t)e * 2 * DFF * DM, 1);
        k_transpose<<<TG, 256, 0, stream>>>(moe_wu + (size_t)e * DM * DFF, DM, DFF, Mgu + (size_t)e * 2 * DFF * DM, 2);
        k_transpose<<<TG, 256, 0, stream>>>(moe_wd + (size_t)e * DFF * DM, DFF, DM, Md + (size_t)e * DM * DFF, 0);
    }
    k_mod<<<(DEPTH * NMOD + 255) / 256, 256, 0, stream>>>(c_in, ada_w, ada_b, MOD);
    k_rope_tbl<<<MROWS * 32 / 256, 256, 0, stream>>>(pos, ROPE);
    const float* xcur = x_in;
    for (int l = 0; l < DEPTH; ++l) {
        const float lambda_init = 0.8f - 0.6f * expf(-0.3f * (float)l);
        const float* modl = MOD + (size_t)l * NB * NMOD;
        k_norm_mod<<<2048, 256, 0, stream>>>(xcur, ln1_g + l * DM, modl, 0, DM, HB, nullptr, nullptr);
        { pg8::Gemm g{HB, Win + (size_t)l * DIN * DM, MROWS, DIN, DM, 0}; pg8::EpiStoreBf16 E{ZB, DIN, 0};
          k_gemm<pg8::EpiStoreBf16><<<grid, 512, GEMM_LDS, stream>>>(g, E); }
        k_rope_naive<<<MROWS * 16 * 32 / 256, 256, 0, stream>>>(ZB, ROPE);
        k_conv_naive<<<MROWS * LRU_W / 256, 256, 0, stream>>>(ZB, conv_w + l * 4 * LRU_W, conv_b + l * LRU_W, XC);
        k_lru_naive<<<NB * 8, 64, 0, stream>>>(XC, ZB, gate_a_w + (size_t)l * 8 * 64 * 64, gate_a_b + l * LRU_W, gate_x_w + (size_t)l * 8 * 64 * 64, gate_x_b + l * LRU_W, lru_lambda + l * LRU_W, MIX);
        k_attn_naive<<<NB * 4 * SEQ / 4, 256, 0, stream>>>(ZB, pos, MIX, lam_q1 + l * 64, lam_k1 + l * 64, lam_q2 + l * 64, lam_k2 + l * 64, subln_g + l * 128, lambda_init);
        { pg8::Gemm g{MIX, Wout + (size_t)l * DM * DM, MROWS, DM, DM, 0}; pg8::EpiResid E{xcur, xr, modl + 2 * DM, nullptr, DM, NMOD, SEQ, 0};
          k_gemm<pg8::EpiResid><<<grid, 512, GEMM_LDS, stream>>>(g, E); }
        xcur = xr;
        if (l % 2 == 0) {
            k_norm_mod<<<2048, 256, 0, stream>>>(xr, ln2_g + l * DM, modl, 3 * DM, 4 * DM, HB, nullptr, nullptr);
            { pg8::Gemm g{HB, Wgu, MROWS, 2 * DFF, DM, 0}; pg8::EpiSwiglu E{ACT, DFF, 0};
              k_gemm<pg8::EpiSwiglu><<<grid, 512, GEMM_LDS, stream>>>(g, E); }
            { pg8::Gemm g{ACT, Wd, MROWS, DM, DFF, 0}; pg8::EpiResid E{xr, xr, modl + 5 * DM, nullptr, DM, NMOD, SEQ, 0};
              k_gemm<pg8::EpiResid><<<grid, 512, GEMM_LDS, stream>>>(g, E); }
        } else {
            const int j = l / 2;
            k_norm_mod<<<2048, 256, 0, stream>>>(xr, ln2_g + l * DM, modl, 3 * DM, 4 * DM, HB, moe_router + (size_t)j * DM * NEXP, GATES);
            for (int e = 0; e < NEXP; ++e) {
                { pg8::Gemm g{HB, Mgu + (size_t)e * 2 * DFF * DM, MROWS, 2 * DFF, DM, 0}; pg8::EpiSwiglu E{ACT, DFF, 0};
                  k_gemm<pg8::EpiSwiglu><<<grid, 512, GEMM_LDS, stream>>>(g, E); }
                { pg8::Gemm g{ACT, Md + (size_t)e * DM * DFF, MROWS, DM, DFF, 0}; pg8::EpiResid E{xr, xr, modl + 5 * DM, GATES + e, DM, NMOD, SEQ, NEXP};
                  k_gemm<pg8::EpiResid><<<grid, 512, GEMM_LDS, stream>>>(g, E); }
            }
        }
    }
    k_final<<<2048, 256, 0, stream>>>(xr, final_g);
}
```

```cpp
#include <hip/hip_runtime.h>
#include <cstdio>
#include <cstdint>

namespace pg8 {
#define PG8_LAS __attribute__((address_space(3)))
typedef unsigned short bf16_t;
typedef short bf16x8 __attribute__((ext_vector_type(8)));
typedef float f32x4 __attribute__((ext_vector_type(4)));
typedef unsigned u32x4 __attribute__((ext_vector_type(4)));
constexpr int BM = 256, BK = 64, HALF = 128, HTB = HALF * BK * 2, STAGE_BYTES = 8 * HTB, NXCD = 8, WGM = 8;

__host__ __device__ __forceinline__ int lds_byte(int r, int c) { const int st = (r >> 4) * 2 + (c >> 5), rr = r & 15, cc = c & 31, ob = rr * 64 + cc * 2; return st * 1024 + (ob ^ (((ob >> 9) & 1) << 5)); }
__host__ __device__ __forceinline__ void stage_rc(int b, int& R, int& C) { const int st = b / 1024, sb = b % 1024, swz = sb ^ (((sb >> 9) & 1) << 5); R = (st >> 1) * 16 + swz / 64; C = (st & 1) * 32 + (swz % 64) / 2; }
__host__ __device__ __forceinline__ int perm32(int rho) { const int n = rho >> 4, i = rho & 15; return 8 * (i >> 2) + 4 * n + (i & 3); }

struct Unit { int pm, pn; };
struct Gemm { const bf16_t* A; const bf16_t* Bt; int M, N, K, pad; };

struct StaticOrder {
    int nM, nN, nwg, G, c;
    __host__ __device__ void init(int M, int N, int G_, int c_) { nM = M / BM; nN = N / BM; nwg = nM * nN; G = G_; c = c_; }
    __host__ __device__ bool next(int i, Unit& u) const {
        const long L = (long)i * G + c; if (L >= nwg) return false;
        int wgid = (int)L; { const int q = nwg / NXCD, r = nwg % NXCD, xcd = wgid % NXCD, off = wgid / NXCD; wgid = (xcd < r ? xcd * (q + 1) : r * (q + 1) + (xcd - r) * q) + off; }
        const int nig = WGM * nN, gid = wgid / nig, fm = gid * WGM, gsz = (nM - fm) < WGM ? (nM - fm) : WGM;
        u.pm = fm + ((wgid % nig) % gsz); u.pn = (wgid % nig) / gsz; return true;
    }
    __device__ __forceinline__ void a_ready(const Unit&) const {}
    __device__ __forceinline__ void done(const Unit&) const {}
};

typedef float f32x2_t __attribute__((ext_vector_type(2))); typedef __bf16 bf16x2_t __attribute__((ext_vector_type(2)));
__device__ __forceinline__ unsigned cvt_pk_bf16(float lo, float hi) { f32x2_t v = {lo, hi}; bf16x2_t b = __builtin_convertvector(v, bf16x2_t); return __builtin_bit_cast(unsigned, b); }

struct EpiStoreBf16 {
    static constexpr bool PERM = true, AFTER_DRAIN = false;
    bf16_t* O; int ldc; int pad;
    __device__ __forceinline__ void operator()(const f32x4 (&acc)[2][2][4][2], const Unit& u, int wr, int wc, int fr, int fq) const {
        const int row0 = u.pm * BM + wr * 64 + fr; const int col0 = u.pn * BM + wc * 32 + 8 * fq;
#pragma unroll
        for (int ai = 0; ai < 2; ++ai)
#pragma unroll
            for (int m = 0; m < 4; ++m) { bf16_t* rowp = O + (size_t)(row0 + ai * HALF + m * 16) * ldc + col0;
#pragma unroll
                for (int bj = 0; bj < 2; ++bj) { const f32x4 v0 = acc[ai][bj][m][0], v1 = acc[ai][bj][m][1];
                    u32x4 w; w.x = cvt_pk_bf16(v0[0], v0[1]); w.y = cvt_pk_bf16(v0[2], v0[3]); w.z = cvt_pk_bf16(v1[0], v1[1]); w.w = cvt_pk_bf16(v1[2], v1[3]);
                    *(u32x4*)(rowp + bj * HALF) = w; } }
    }
};
__device__ __forceinline__ float silu_f(float x) { return x / (1.0f + __expf(-x)); }
struct EpiSwiglu {
    static constexpr bool PERM = true, AFTER_DRAIN = false;
    bf16_t* O; int ldc; int pad;
    __device__ __forceinline__ void operator()(const f32x4 (&acc)[2][2][4][2], const Unit& u, int wr, int wc, int fr, int fq) const {
        const int row0 = u.pm * BM + wr * 64 + fr; const int col0 = u.pn * HALF + wc * 32 + 8 * fq;
#pragma unroll
        for (int ai = 0; ai < 2; ++ai)
#pragma unroll
            for (int m = 0; m < 4; ++m) { bf16_t* rowp = O + (size_t)(row0 + ai * HALF + m * 16) * ldc + col0;
                float r[8];
#pragma unroll
                for (int n = 0; n < 2; ++n)
#pragma unroll
                    for (int i = 0; i < 4; ++i) r[n * 4 + i] = silu_f(acc[ai][0][m][n][i]) * acc[ai][1][m][n][i];
                u32x4 w; w.x = cvt_pk_bf16(r[0], r[1]); w.y = cvt_pk_bf16(r[2], r[3]); w.z = cvt_pk_bf16(r[4], r[5]); w.w = cvt_pk_bf16(r[6], r[7]);
                *(u32x4*)rowp = w; }
    }
};
struct EpiResid {
    static constexpr bool PERM = true, AFTER_DRAIN = false;
    const float* base; float* out; const float* gvec; const float* rowscale; int ldc; int gstride; int rows_per_batch; int rs_stride;
    __device__ __forceinline__ void operator()(const f32x4 (&acc)[2][2][4][2], const Unit& u, int wr, int wc, int fr, int fq) const {
        const int row0 = u.pm * BM + wr * 64 + fr; const int col0 = u.pn * BM + wc * 32 + 8 * fq;
        const float* gv = gvec + (size_t)((u.pm * BM) / rows_per_batch) * gstride + col0;
        f32x4 g[2][2];
#pragma unroll
        for (int bj = 0; bj < 2; ++bj)
#pragma unroll
            for (int n = 0; n < 2; ++n) g[bj][n] = *(const f32x4*)(gv + bj * HALF + 4 * n);
#pragma unroll
        for (int ai = 0; ai < 2; ++ai)
#pragma unroll
            for (int m = 0; m < 4; ++m) { const int row = row0 + ai * HALF + m * 16; const size_t off = (size_t)row * ldc + col0;
                const float rs = rowscale ? rowscale[(size_t)row * rs_stride] : 1.0f;
#pragma unroll
                for (int bj = 0; bj < 2; ++bj)
#pragma unroll
                    for (int n = 0; n < 2; ++n) { const f32x4 b = *(const f32x4*)(base + off + bj * HALF + 4 * n);
                        *(f32x4*)(out + off + bj * HALF + 4 * n) = b + g[bj][n] * rs * acc[ai][bj][m][n]; } }
    }
};

template <class Epi, class Sched, bool ALIGN_EPI = false, bool SP2 = false>
__device__ __forceinline__ void gemm_phase(PG8_LAS unsigned char* lds, const Gemm g, const Sched& S, const Epi& E) {
    const int tid = threadIdx.x, wid = __builtin_amdgcn_readfirstlane(tid >> 6), lane = tid & 63, wr = wid >> 2, wc = wid & 3, fr = lane & 15, fq = lane >> 4;
    const int K = g.K, nt = K / BK;
    unsigned voffA[2], voffB[2];
#pragma unroll
    for (int i = 0; i < 2; ++i) { int R, C; stage_rc(tid * 16 + i * 8192, R, C); const int Rb = Epi::PERM ? ((R & ~31) + perm32(R & 31)) : R;
        voffA[i] = (unsigned)(R * K + C) * 2u; voffB[i] = (unsigned)(Rb * K + C) * 2u; }
    const size_t kstep = (size_t)(BK * 2);
    const size_t hstep = (size_t)HALF * K * 2;
    const size_t tstep = 2 * hstep;
    const unsigned ldsw = (unsigned)wid * 1024u;
    const int aoff = lds_byte(wr * 64 + fr, fq * 8), boff = lds_byte(wc * 32 + fr, fq * 8);
#define PG8_SA(b, h) (((b) * 2 + (h)) * HTB)
#define PG8_SB(b, h) ((4 + (b) * 2 + (h)) * HTB)
#define PG8_STAGE(bufoff, gbase, voff) do { _Pragma("unroll") for (int _i = 0; _i < 2; ++_i) \
        __builtin_amdgcn_global_load_lds((const unsigned*)((const char*)(gbase) + (voff)[_i]), (PG8_LAS unsigned*)(lds + (bufoff) + ldsw + _i * 8192), 16, 0, 0); } while (0)
#define PG8_LDA(dst, b, h) do { _Pragma("unroll") for (int m = 0; m < 4; ++m) _Pragma("unroll") for (int k = 0; k < 2; ++k) dst[m][k] = *(const PG8_LAS bf16x8*)(lds + PG8_SA(b, h) + aoff + m * 2048 + k * 1024); } while (0)
#define PG8_LDB(dst, b, h) do { _Pragma("unroll") for (int n = 0; n < 2; ++n) _Pragma("unroll") for (int k = 0; k < 2; ++k) dst[n][k] = *(const PG8_LAS bf16x8*)(lds + PG8_SB(b, h) + boff + n * 2048 + k * 1024); } while (0)
#define PG8_MMA(ai, bj, At, Bt) do { __builtin_amdgcn_s_setprio(1); _Pragma("unroll") for (int m = 0; m < 4; ++m) _Pragma("unroll") for (int n = 0; n < 2; ++n) _Pragma("unroll") for (int k = 0; k < 2; ++k) \
        acc[ai][bj][m][n] = __builtin_amdgcn_mfma_f32_16x16x32_bf16(Bt[n][k], At[m][k], acc[ai][bj][m][n], 0, 0, 0); __builtin_amdgcn_s_setprio(0); } while (0)
#define PG8_WAIT_V(n) asm volatile("s_waitcnt vmcnt(" #n ")" ::: "memory")
#define PG8_WAIT_L(n) asm volatile("s_waitcnt lgkmcnt(" #n ")" ::: "memory")
#define PG8_BAR __builtin_amdgcn_s_barrier()
#define PG8_SCHED __builtin_amdgcn_sched_barrier(0)
    Unit cur, nxt; int ui = 0;
    if (!S.next(0, cur)) return;
    f32x4 acc[2][2][4][2];
#pragma unroll
    for (int a = 0; a < 2; ++a)
#pragma unroll
        for (int b = 0; b < 2; ++b)
#pragma unroll
            for (int m = 0; m < 4; ++m)
#pragma unroll
                for (int n = 0; n < 2; ++n) acc[a][b][m][n] = (f32x4){0.f, 0.f, 0.f, 0.f};
    bf16x8 At[4][2], B0[2][2], B1[2][2];
    const char* cA = (const char*)g.A + (size_t)cur.pm * tstep; const char* cB = (const char*)g.Bt + (size_t)cur.pn * tstep;
    S.a_ready(cur);
    if constexpr (SP2) {
        PG8_STAGE(PG8_SB(0, 0), cB, voffB); PG8_STAGE(PG8_SB(0, 1), cB + hstep, voffB); PG8_STAGE(PG8_SA(0, 0), cA, voffA); PG8_STAGE(PG8_SA(0, 1), cA + hstep, voffA);
        if (wr == 1) PG8_BAR;
        PG8_WAIT_V(2); PG8_BAR;
        PG8_STAGE(PG8_SB(1, 0), cB + kstep, voffB); PG8_STAGE(PG8_SA(1, 0), cA + kstep, voffA); PG8_STAGE(PG8_SB(1, 1), cB + hstep + kstep, voffB);
        PG8_WAIT_V(6); PG8_BAR;
    } else {
        PG8_STAGE(PG8_SB(0, 0), cB, voffB); PG8_STAGE(PG8_SA(0, 0), cA, voffA); PG8_STAGE(PG8_SB(0, 1), cB + hstep, voffB); PG8_STAGE(PG8_SA(0, 1), cA + hstep, voffA);
        if (wr == 1) PG8_BAR;
        PG8_WAIT_V(4); PG8_BAR;
        PG8_STAGE(PG8_SB(1, 0), cB + kstep, voffB); PG8_STAGE(PG8_SA(1, 0), cA + kstep, voffA); PG8_STAGE(PG8_SB(1, 1), cB + hstep + kstep, voffB);
        PG8_WAIT_V(6); PG8_BAR;
    }
    for (;;) {
        const bool has_next = S.next(ui + 1, nxt);
        const char* nA = has_next ? (const char*)g.A + (size_t)nxt.pm * tstep : cA; const char* nB = has_next ? (const char*)g.Bt + (size_t)nxt.pn * tstep : cB;
        for (int t = 0; t < nt; t += 2) {
            const bool last = (t == nt - 2);
            const char* a1 = cA + (size_t)(t + 1) * kstep;
            const char* a2 = last ? nA : cA + (size_t)(t + 2) * kstep; const char* b2 = last ? nB : cB + (size_t)(t + 2) * kstep;
            const char* a3 = a2 + kstep; const char* b3 = b2 + kstep;
            if (last && has_next) S.a_ready(nxt);
            if constexpr (SP2) {
            PG8_LDB(B0, 0, 0); PG8_LDB(B1, 0, 1); PG8_SCHED; PG8_LDA(At, 0, 0); PG8_STAGE(PG8_SA(1, 1), a1 + hstep, voffA);
            PG8_WAIT_V(8); PG8_WAIT_L(0); PG8_BAR; PG8_MMA(0, 0, At, B0); PG8_MMA(0, 1, At, B1); PG8_BAR; PG8_SCHED;
            PG8_LDA(At, 0, 1); PG8_STAGE(PG8_SB(0, 0), b2, voffB); PG8_STAGE(PG8_SB(0, 1), b2 + hstep, voffB); PG8_STAGE(PG8_SA(0, 0), a2, voffA);
            PG8_WAIT_V(8); PG8_WAIT_L(0); PG8_BAR; PG8_MMA(1, 0, At, B0); PG8_MMA(1, 1, At, B1); PG8_BAR; PG8_SCHED;
            PG8_LDB(B0, 1, 0); PG8_LDB(B1, 1, 1); PG8_SCHED; PG8_LDA(At, 1, 0); PG8_STAGE(PG8_SA(0, 1), a2 + hstep, voffA);
            PG8_WAIT_V(8); PG8_WAIT_L(0); PG8_BAR; PG8_MMA(0, 0, At, B0); PG8_MMA(0, 1, At, B1); PG8_BAR; PG8_SCHED;
            PG8_LDA(At, 1, 1); PG8_STAGE(PG8_SB(1, 0), b3, voffB); PG8_STAGE(PG8_SB(1, 1), b3 + hstep, voffB); PG8_STAGE(PG8_SA(1, 0), a3, voffA);
            PG8_WAIT_V(8); PG8_WAIT_L(0); PG8_BAR; PG8_MMA(1, 0, At, B0); PG8_MMA(1, 1, At, B1); PG8_BAR; PG8_SCHED;
            } else {
            PG8_LDB(B0, 0, 0); PG8_SCHED; PG8_LDA(At, 0, 0); PG8_STAGE(PG8_SA(1, 1), a1 + hstep, voffA);
            PG8_WAIT_L(8); PG8_BAR; PG8_WAIT_L(0); PG8_MMA(0, 0, At, B0); PG8_BAR; PG8_SCHED;
            PG8_LDB(B1, 0, 1); PG8_STAGE(PG8_SB(0, 0), b2, voffB);
            PG8_BAR; PG8_WAIT_L(0); PG8_MMA(0, 1, At, B1); PG8_BAR;
            PG8_LDA(At, 0, 1); PG8_STAGE(PG8_SA(0, 0), a2, voffA);
            PG8_BAR; PG8_WAIT_L(0); PG8_MMA(1, 0, At, B0); PG8_BAR; PG8_SCHED;
            PG8_STAGE(PG8_SB(0, 1), b2 + hstep, voffB);
            PG8_WAIT_V(6); PG8_BAR; PG8_MMA(1, 1, At, B1); PG8_BAR;
            PG8_LDB(B0, 1, 0); PG8_SCHED; PG8_LDA(At, 1, 0); PG8_STAGE(PG8_SA(0, 1), a2 + hstep, voffA);
            PG8_WAIT_L(8); PG8_BAR; PG8_WAIT_L(0); PG8_MMA(0, 0, At, B0); PG8_BAR; PG8_SCHED;
            PG8_LDB(B1, 1, 1); PG8_STAGE(PG8_SB(1, 0), b3, voffB);
            PG8_BAR; PG8_WAIT_L(0); PG8_MMA(0, 1, At, B1); PG8_BAR;
            PG8_LDA(At, 1, 1); PG8_STAGE(PG8_SA(1, 0), a3, voffA);
            PG8_BAR; PG8_WAIT_L(0); PG8_MMA(1, 0, At, B0); PG8_BAR; PG8_SCHED;
            PG8_STAGE(PG8_SB(1, 1), b3 + hstep, voffB);
            PG8_WAIT_V(6); PG8_BAR; PG8_MMA(1, 1, At, B1); PG8_BAR;
            }
        }
        if constexpr (ALIGN_EPI) { if (wr == 0) PG8_BAR; }
        if constexpr (!Epi::AFTER_DRAIN) { E(acc, cur, wr, wc, fr, fq); S.done(cur); }
        if (!has_next) break;
#pragma unroll
        for (int a = 0; a < 2; ++a)
#pragma unroll
            for (int b = 0; b < 2; ++b)
#pragma unroll
                for (int m = 0; m < 4; ++m)
#pragma unroll
                    for (int n = 0; n < 2; ++n) acc[a][b][m][n] = (f32x4){0.f, 0.f, 0.f, 0.f};
        cur = nxt; cA = nA; cB = nB; ++ui;
        if constexpr (ALIGN_EPI) { if (wr == 1) PG8_BAR; }
    }
    PG8_WAIT_V(0);
    if constexpr (!ALIGN_EPI) { if (wr == 0) PG8_BAR; }
    PG8_BAR;
#undef PG8_SA
#undef PG8_SB
#undef PG8_STAGE
#undef PG8_LDA
#undef PG8_LDB
#undef PG8_MMA
#undef PG8_WAIT_V
#undef PG8_WAIT_L
#undef PG8_BAR
#undef PG8_SCHED
}
}

typedef unsigned short bf16;
#define GAS __attribute__((address_space(1)))
#define LAS __attribute__((address_space(3)))
typedef unsigned v4u __attribute__((ext_vector_type(4)));
typedef float f32x4 __attribute__((ext_vector_type(4)));
typedef unsigned u32x4_t __attribute__((ext_vector_type(4)));

constexpr int DM = 1024, NB = 4, SEQ = 8192, MROWS = NB * SEQ, DEPTH = 2;
constexpr int LRU_W = 512, DIN = 2560, DFF = 3072, NEXP = 8, NMOD = 6 * DM;
constexpr int ZC_XR = 0, ZC_YR = 512, ZC_Q = 1024, ZC_K = 1536, ZC_V = 2048;
constexpr float EPS = 1e-6f;
constexpr int NWAVES = 8;
constexpr int GEMM_LDS = 131072;

constexpr size_t MiB = 1u << 20;
constexpr size_t WS_CTL = 0;
constexpr size_t WS_WIN = 2 * MiB;
constexpr size_t WS_WOUT = 12 * MiB;
constexpr size_t WS_WGU = 16 * MiB;
constexpr size_t WS_WD = 28 * MiB;
constexpr size_t WS_MGU = 34 * MiB;
constexpr size_t WS_MD = 130 * MiB;
constexpr size_t WS_MOD = 178 * MiB;
constexpr size_t WS_ROPE = 180 * MiB;
constexpr size_t WS_GATES = 188 * MiB;
constexpr size_t WS_HB = 192 * MiB;
constexpr size_t WS_ZB = 256 * MiB;
constexpr size_t WS_MIX = 416 * MiB;
constexpr size_t WS_ACT = 256 * MiB;
constexpr size_t WS_END = 480 * MiB;

__device__ __forceinline__ float bf2f(bf16 v) { return __uint_as_float((unsigned)v << 16); }
__device__ __forceinline__ bf16 f2bf(float f) { return (bf16)(pg8::cvt_pk_bf16(f, 0.f) & 0xffffu); }
__device__ __forceinline__ float wave_sum(float v) {
#pragma unroll
    for (int o = 1; o < 64; o <<= 1) v += __shfl_xor(v, o);
    return v;
}
__device__ __forceinline__ float wave_max(float v) {
#pragma unroll
    for (int o = 1; o < 64; o <<= 1) v = fmaxf(v, __shfl_xor(v, o));
    return v;
}
__device__ __forceinline__ float gelu_tanh(float y) { const float u = 0.7978845608028654f * (y + 0.044715f * y * y * y); const float t = 1.0f - 2.0f / (1.0f + __expf(2.0f * u)); return 0.5f * y * (1.0f + t); }

__device__ __forceinline__ void transpose_item(const float* W, int K, int N, bf16* WT, int dest_row0, LAS float* scr, int k0, int n0, int lane) {
#pragma unroll 8
    for (int i = 0; i < 32; ++i) { const int kk = 2 * i + (lane >> 5); scr[kk * 33 + (lane & 31)] = W[(size_t)(k0 + kk) * N + n0 + (lane & 31)]; }
    asm volatile("s_waitcnt lgkmcnt(0)" ::: "memory");
    const int c = lane & 7;
#pragma unroll
    for (int j = 0; j < 4; ++j) { const int n = (lane >> 3) + 8 * j; const LAS float* s = scr + (8 * c) * 33 + n;
        v4u o; o.x = pg8::cvt_pk_bf16(s[0 * 33], s[1 * 33]); o.y = pg8::cvt_pk_bf16(s[2 * 33], s[3 * 33]); o.z = pg8::cvt_pk_bf16(s[4 * 33], s[5 * 33]); o.w = pg8::cvt_pk_bf16(s[6 * 33], s[7 * 33]);
        *(GAS v4u*)(WT + (size_t)(dest_row0 + n) * K + k0 + 8 * c) = o; }
    asm volatile("s_waitcnt lgkmcnt(0)" ::: "memory");
}
__global__ void __launch_bounds__(256) k_transpose(const float* W, int K, int N, bf16* WT, int mode) {
    __shared__ float scr_all[4][64 * 33];
    const int lane = threadIdx.x & 63, w = threadIdx.x >> 6;
    LAS float* scr = (LAS float*)&scr_all[w][0];
    const int nblk = N / 32, nitems = (K / 64) * nblk;
    for (int it = blockIdx.x * 4 + w; it < nitems; it += gridDim.x * 4) {
        const int kb = it / nblk, nb = it % nblk, k0 = 64 * kb, n0 = 32 * nb;
        int d0 = n0; if (mode == 1) d0 = 256 * (n0 / 128) + (n0 % 128); else if (mode == 2) d0 = 256 * (n0 / 128) + 128 + (n0 % 128);
        transpose_item(W, K, N, WT, d0, scr, k0, n0, lane);
    }
}
__global__ void __launch_bounds__(256) k_mod(const float* c, const float* ada_w, const float* ada_b, float* mod) {
    __shared__ float sc[NB][DM];
    for (int i = threadIdx.x; i < NB * DM; i += 256) { const float v = c[i]; sc[i / DM][i % DM] = v / (1.0f + expf(-v)); }
    __syncthreads();
    const int gid = blockIdx.x * 256 + threadIdx.x; if (gid >= DEPTH * NMOD) return;
    const int l = gid / NMOD, n = gid % NMOD;
    const float* w = ada_w + (size_t)l * DM * NMOD + n;
    float a0 = 0.f, a1 = 0.f, a2 = 0.f, a3 = 0.f;
    for (int k = 0; k < DM; ++k) { const float wv = w[(size_t)k * NMOD]; a0 += sc[0][k] * wv; a1 += sc[1][k] * wv; a2 += sc[2][k] * wv; a3 += sc[3][k] * wv; }
    const float bb = ada_b[l * NMOD + n];
    mod[((size_t)l * NB + 0) * NMOD + n] = a0 + bb; mod[((size_t)l * NB + 1) * NMOD + n] = a1 + bb;
    mod[((size_t)l * NB + 2) * NMOD + n] = a2 + bb; mod[((size_t)l * NB + 3) * NMOD + n] = a3 + bb;
}
__constant__ float c_inv[32] = {1.000000000e+00f, 7.498942018e-01f, 5.623413324e-01f, 4.216965139e-01f, 3.162277639e-01f, 2.371373773e-01f, 1.778279394e-01f, 1.333521456e-01f, 1.000000015e-01f, 7.498942316e-02f, 5.623413250e-02f, 4.216964915e-02f, 3.162277490e-02f, 2.371373773e-02f, 1.778279431e-02f, 1.333521400e-02f, 9.999999776e-03f, 7.498942316e-03f, 5.623413250e-03f, 4.216964822e-03f, 3.162277630e-03f, 2.371373819e-03f, 1.778279431e-03f, 1.333521446e-03f, 1.000000047e-03f, 7.498941850e-04f, 5.623413017e-04f, 4.216965172e-04f, 3.162277571e-04f, 2.371373703e-04f, 1.778279402e-04f, 1.333521504e-04f};
__device__ __forceinline__ void sincos_acc(float angf, float& cs, float& sn) {
    const double x = (double)angf;
    const double k = rint(x * 0.63661977236758134308);
    const double r = fma(-k, 6.123233995736766036e-17, fma(-k, 1.57079632679489655800, x));
    const double r2 = r * r;
    double s = -7.6471637318198164759e-13; s = fma(s, r2, 1.6059043836821614599e-10); s = fma(s, r2, -2.5052108385441718775e-08); s = fma(s, r2, 2.7557319223985890653e-06);
    s = fma(s, r2, -1.9841269841269841270e-04); s = fma(s, r2, 8.3333333333333333333e-03); s = fma(s, r2, -1.6666666666666666667e-01); s = fma(s * r2, r, r);
    double c = 4.7794773323873852974e-14; c = fma(c, r2, -1.1470745597729724714e-11); c = fma(c, r2, 2.0876756987868098979e-09); c = fma(c, r2, -2.7557319223985890653e-07);
    c = fma(c, r2, 2.4801587301587301587e-05); c = fma(c, r2, -1.3888888888888888889e-03); c = fma(c, r2, 4.1666666666666666667e-02); c = fma(c, r2, -0.5); c = fma(c, r2, 1.0);
    const int q = ((int)(long long)k) & 3;
    const double sv = (q == 0) ? s : (q == 1) ? c : (q == 2) ? -s : -c;
    const double cv = (q == 0) ? c : (q == 1) ? -s : (q == 2) ? -c : s;
    cs = (float)cv; sn = (float)sv;
}
__global__ void __launch_bounds__(256) k_rope_tbl(const int* pos, float2* tbl) {
    const int gid = blockIdx.x * 256 + threadIdx.x; if (gid >= MROWS * 32) return;
    const int row = gid >> 5, i = gid & 31;
    const float ang = __fmul_rn((float)pos[row], c_inv[i]);
    float cs, sn; sincos_acc(ang, cs, sn);
    tbl[gid] = make_float2(cs, sn);
}

__global__ void __launch_bounds__(256) k_norm_mod(const float* x, const float* lng, const float* mod_l  , int sh_off, int sc_off, bf16* H, const float* router  , float* gates) {
    const int lane = threadIdx.x & 63; const int gw = (blockIdx.x * 256 + threadIdx.x) >> 6, NGW = gridDim.x * 4;
    for (int row = gw; row < MROWS; row += NGW) {
        const int b = row / SEQ;
        const f32x4* xr = (const f32x4*)(x + (size_t)row * DM) + lane;
        f32x4 v[4]; float s = 0.f;
#pragma unroll
        for (int j = 0; j < 4; ++j) { v[j] = xr[64 * j]; s += (v[j].x * v[j].x + v[j].y * v[j].y) + (v[j].z * v[j].z + v[j].w * v[j].w); }
        const float rstd = rsqrtf(wave_sum(s) * (1.0f / DM) + EPS);
        const float* mb = mod_l + (size_t)b * NMOD;
        float lg[8];
#pragma unroll
        for (int e = 0; e < 8; ++e) lg[e] = 0.f;
#pragma unroll
        for (int j = 0; j < 4; ++j) { const int c0 = 4 * lane + 256 * j;
            const f32x4 g = *(const f32x4*)(lng + c0), sc = *(const f32x4*)(mb + sc_off + c0), sh = *(const f32x4*)(mb + sh_off + c0);
            f32x4 h; h = v[j] * rstd * g * (1.0f + sc) + sh;
            uint2 o; o.x = pg8::cvt_pk_bf16(h.x, h.y); o.y = pg8::cvt_pk_bf16(h.z, h.w);
            *(uint2*)(H + (size_t)row * DM + c0) = o;
            if (router) {
#pragma unroll
                for (int i = 0; i < 4; ++i) { const f32x4 r0 = *(const f32x4*)(router + (size_t)(c0 + i) * 8), r1 = *(const f32x4*)(router + (size_t)(c0 + i) * 8 + 4);
                    const float hv = h[i];
                    lg[0] += hv * r0.x; lg[1] += hv * r0.y; lg[2] += hv * r0.z; lg[3] += hv * r0.w; lg[4] += hv * r1.x; lg[5] += hv * r1.y; lg[6] += hv * r1.z; lg[7] += hv * r1.w; }
            }
        }
        if (router) {
#pragma unroll
            for (int e = 0; e < 8; ++e) lg[e] = wave_sum(lg[e]);
            int i0 = 0; float v0 = lg[0];
#pragma unroll
            for (int e = 1; e < 8; ++e) if (lg[e] > v0) { v0 = lg[e]; i0 = e; }
            int i1 = -1; float v1 = -INFINITY;
#pragma unroll
            for (int e = 0; e < 8; ++e) if (e != i0 && lg[e] > v1) { v1 = lg[e]; i1 = e; }
            const float e1 = expf(v1 - v0), w0 = 1.0f / (1.0f + e1), w1 = e1 / (1.0f + e1);
            if (lane < 8) gates[(size_t)row * 8 + lane] = (lane == i0) ? w0 : (lane == i1) ? w1 : 0.f;
        }
    }
}
__global__ void __launch_bounds__(256) k_final(float* x, const float* g) {
    const int lane = threadIdx.x & 63; const int gw = (blockIdx.x * 256 + threadIdx.x) >> 6, NGW = gridDim.x * 4;
    for (int row = gw; row < MROWS; row += NGW) {
        f32x4* xr = (f32x4*)(x + (size_t)row * DM) + lane;
        f32x4 v[4]; float s = 0.f;
#pragma unroll
        for (int j = 0; j < 4; ++j) { v[j] = xr[64 * j]; s += (v[j].x * v[j].x + v[j].y * v[j].y) + (v[j].z * v[j].z + v[j].w * v[j].w); }
        const float rstd = rsqrtf(wave_sum(s) * (1.0f / DM) + EPS);
#pragma unroll
        for (int j = 0; j < 4; ++j) { const f32x4 gg = *(const f32x4*)(g + 4 * lane + 256 * j); xr[64 * j] = v[j] * rstd * gg; }
    }
}

__global__ void __launch_bounds__(256) k_rope_naive(bf16* Z, const float2* tbl) {
    const size_t gid = (size_t)blockIdx.x * 256 + threadIdx.x; if (gid >= (size_t)MROWS * 16 * 32) return;
    const int i = gid & 31, s = (gid >> 5) & 15; const size_t row = gid >> 9;
    bf16* p = Z + row * DIN + ZC_Q + s * 64;
    const float2 cs = tbl[row * 32 + i];
    const float x1 = bf2f(p[i]), x2 = bf2f(p[i + 32]);
    const float sc = (s < 8) ? 0.125f * 1.4426950408889634f : 1.0f;
    p[i] = f2bf((x1 * cs.x - x2 * cs.y) * sc); p[i + 32] = f2bf((x2 * cs.x + x1 * cs.y) * sc);
}
__global__ void __launch_bounds__(256) k_conv_naive(const bf16* Z, const float* cw, const float* cb, float* XC) {
    const size_t gid = (size_t)blockIdx.x * 256 + threadIdx.x; if (gid >= (size_t)MROWS * LRU_W) return;
    const int c = gid % LRU_W; const size_t row = gid / LRU_W; const int t = row % SEQ;
    float acc = cb[c];
#pragma unroll
    for (int j = 0; j < 4; ++j) { const int tt = t - 3 + j; if (tt >= 0) acc += cw[j * LRU_W + c] * bf2f(Z[(row - 3 + j) * DIN + ZC_XR + c]); }
    XC[gid] = acc;
}
__global__ void __launch_bounds__(64) k_lru_naive(const float* XC, const bf16* Z, const float* wa, const float* ba, const float* wx, const float* bx, const float* lam, bf16* MIX) {
    const int b = blockIdx.x / 8, n = blockIdx.x % 8, k = threadIdx.x, c = n * 64 + k;
    float war[64], wxr[64];
#pragma unroll
    for (int h = 0; h < 64; ++h) { war[h] = wa[(size_t)(n * 64 + h) * 64 + k]; wxr[h] = wx[(size_t)(n * 64 + h) * 64 + k]; }
    const float bav = ba[c], bxv = bx[c];
    const float L = lam[c]; const float sp = (L > 15.f) ? expf(-L) : log1pf(expf(-L));
    float h = 0.f;
    const size_t row0 = (size_t)b * SEQ;
    float xk = XC[row0 * LRU_W + c];
    for (int t = 0; t < SEQ; ++t) {
        const size_t row = row0 + t;
        const float xnext = (t + 1 < SEQ) ? XC[(row + 1) * LRU_W + c] : 0.f;
        float ar = bav, ai = bxv;
#pragma unroll
        for (int hh = 0; hh < 64; ++hh) { const float xv = __shfl(xk, hh); ar += xv * war[hh]; ai += xv * wxr[hh]; }
        const float r = 1.0f / (1.0f + expf(-ar)), ig = 1.0f / (1.0f + expf(-ai));
        const float log_a = -8.0f * r * sp; const float a = expf(log_a); const float mult = sqrtf(-expm1f(2.0f * log_a));
        h = a * h + mult * (ig * xk);
        const float y = bf2f(Z[row * DIN + ZC_YR + c]);
        MIX[row * DM + c] = f2bf(h * gelu_tanh(y));
        xk = xnext;
    }
}
__global__ void __launch_bounds__(256) k_attn_naive(const bf16* Z, const int* pos, bf16* MIX, const float* lq1, const float* lk1, const float* lq2, const float* lk2, const float* subg, float lambda_init) {
    __shared__ float qs[4][128];
    const int lane = threadIdx.x & 63, w = threadIdx.x >> 6; const int gw = blockIdx.x * 4 + w;
    const int q = gw % SEQ, h = (gw / SEQ) % 4, b = gw / (SEQ * 4);
    const size_t rowb = (size_t)b * SEQ, row = rowb + q;
    const float lam = expf(wave_sum(lq1[lane] * lk1[lane])) - expf(wave_sum(lq2[lane] * lk2[lane])) + lambda_init;
    qs[w][lane] = bf2f(Z[row * DIN + ZC_Q + h * 128 + lane]); qs[w][64 + lane] = bf2f(Z[row * DIN + ZC_Q + h * 128 + 64 + lane]);
    __syncthreads();
    const int pq = pos[row], cq = pq >> 6, p0 = pos[rowb];
    int kend = ((cq + 1) << 6) - 1 - p0; if (kend > SEQ - 1) kend = SEQ - 1;
    const int nch = kend / 64 + 1;
    float m1 = -INFINITY, m2 = -INFINITY, l1 = 0.f, l2 = 0.f, o1a = 0.f, o1b = 0.f, o2a = 0.f, o2b = 0.f;
    for (int ch = 0; ch < nch; ++ch) {
        const int key = ch * 64 + lane;
        const bool valid = (pos[rowb + key] >> 6) <= cq;
        const bf16* kr = Z + (rowb + key) * DIN + ZC_K + h * 128;
        float s1 = 0.f, s2 = 0.f;
#pragma unroll 8
        for (int d = 0; d < 64; d += 2) { const unsigned u1 = *(const unsigned*)(kr + d), u2 = *(const unsigned*)(kr + 64 + d);
            s1 += qs[w][d] * __uint_as_float(u1 << 16) + qs[w][d + 1] * __uint_as_float(u1 & 0xffff0000u);
            s2 += qs[w][64 + d] * __uint_as_float(u2 << 16) + qs[w][64 + d + 1] * __uint_as_float(u2 & 0xffff0000u); }
        s1 = valid ? s1 * 0.125f : -INFINITY; s2 = valid ? s2 * 0.125f : -INFINITY;
        const float m1n = fmaxf(m1, wave_max(s1)), m2n = fmaxf(m2, wave_max(s2));
        const float f1 = expf(m1 - m1n), f2 = expf(m2 - m2n);
        const float p1 = expf(s1 - m1n), p2 = expf(s2 - m2n);
        l1 = l1 * f1 + wave_sum(p1); l2 = l2 * f2 + wave_sum(p2);
        o1a *= f1; o1b *= f1; o2a *= f2; o2b *= f2; m1 = m1n; m2 = m2n;
        const bf16* vr = Z + (rowb + (size_t)ch * 64) * DIN + ZC_V + h * 128 + 2 * lane;
#pragma unroll 8
        for (int j = 0; j < 64; ++j) { const unsigned vv = *(const unsigned*)(vr + (size_t)j * DIN); const float va = __uint_as_float(vv << 16), vb = __uint_as_float(vv & 0xffff0000u);
            const float pj1 = __shfl(p1, j), pj2 = __shfl(p2, j);
            o1a += pj1 * va; o1b += pj1 * vb; o2a += pj2 * va; o2b += pj2 * vb; }
    }
    const float oa = o1a / l1 - lam * (o2a / l2), ob = o1b / l1 - lam * (o2b / l2);
    const float ms = wave_sum(oa * oa + ob * ob) * (1.0f / 128.0f);
    const float rs = rsqrtf(ms + EPS) * (1.0f - lambda_init);
    const unsigned o = pg8::cvt_pk_bf16(oa * rs * subg[2 * lane], ob * rs * subg[2 * lane + 1]);
    *(unsigned*)(MIX + row * DM + 512 + h * 128 + 2 * lane) = o;
}


namespace att {
typedef short bf16x8 __attribute__((ext_vector_type(8)));
typedef short s16x4 __attribute__((ext_vector_type(4)));
typedef float f32x16 __attribute__((ext_vector_type(16)));
typedef LAS const unsigned char* lds_cptr;
constexpr int KSLOT = 8192, VSLOT = 16384, NSLOT = 3;
constexpr int L_K = 0, L_V = NSLOT * KSLOT, L_WS = L_V + NSLOT * VSLOT, L_O0 = L_WS + NWAVES * 256, L_END = L_O0 + NWAVES * 8192;
constexpr float C2 = 0.125f * 1.4426950408889634f;
constexpr float THR = 8.0f;
__device__ __forceinline__ int crow(int r, int hi) { return (r & 3) + 8 * (r >> 2) + 4 * hi; }
__device__ __forceinline__ void glds16(const void* gsrc, unsigned lds_dst) { unsigned keep;
    asm volatile("s_mov_b32 %0, m0\n\ts_mov_b32 m0, %2\n\ts_nop 0\n\tglobal_load_lds_dwordx4 %1, off\n\ts_mov_b32 m0, %0" : "=&s"(keep) : "v"(gsrc), "s"(lds_dst) : "memory"); }
#define ATT_WAIT_BAR(N) asm volatile("s_waitcnt vmcnt(" #N ") lgkmcnt(0)\n\ts_barrier" ::: "memory")
__device__ __forceinline__ float merge_max32(float m) { auto rr = __builtin_amdgcn_permlane32_swap(__float_as_uint(m), __float_as_uint(m), false, false); return fmaxf(__uint_as_float(rr[0]), __uint_as_float(rr[1])); }
__device__ __forceinline__ float merge_sum32(float m) { auto rr = __builtin_amdgcn_permlane32_swap(__float_as_uint(m), __float_as_uint(m), false, false); return __uint_as_float(rr[0]) + __uint_as_float(rr[1]); }
__device__ __forceinline__ s16x4 vtr(lds_cptr p) { typedef short v4i16_t __attribute__((ext_vector_type(4))); return __builtin_bit_cast(s16x4, __builtin_amdgcn_ds_read_tr16_b64_v4i16((LAS v4i16_t*)p)); }

__device__ __forceinline__ void attn_pass(f32x16 (&o)[4], const bf16* Qw, const bf16* Kh, const bf16* Vh, LAS unsigned char* shm, int NT, int tmax, int wid, int lane) {
    const int r32 = lane & 31, hi = lane >> 5;
    const unsigned lds0 = (unsigned)(size_t)shm;
    LAS float* wsf = (LAS float*)(shm + L_WS) + wid * 64;
    const bf16* ksrc = Kh + (size_t)lane * DIN + wid * 8;
    const bf16* vsrc = Vh + (size_t)(16 * (wid & 3) + (lane >> 2)) * DIN + (wid >> 2) * 32 + (lane & 3) * 8;
    const unsigned kdst = lds0 + L_K + wid * 1024, vdst = lds0 + L_V + wid * 1024;
#define ATT_DMA(t, slot) do { const size_t go_ = (size_t)(t) * 64 * DIN; \
        glds16(ksrc + go_, (unsigned)__builtin_amdgcn_readfirstlane(kdst + (slot) * KSLOT)); \
        glds16(vsrc + go_, (unsigned)__builtin_amdgcn_readfirstlane(vdst + (slot) * VSLOT)); \
        glds16(vsrc + go_ + 64, (unsigned)__builtin_amdgcn_readfirstlane(vdst + (slot) * VSLOT + 8192)); } while (0)
    ATT_DMA(0, 0); ATT_DMA(1, 1);
    bf16x8 qr[4];
#pragma unroll
    for (int d0 = 0; d0 < 4; ++d0) qr[d0] = *(const bf16x8*)(Qw + d0 * 16 + hi * 8);
    float mhat = 0.f, l_reg = 0.f;
    f32x16 negm = {};
#pragma unroll
    for (int db = 0; db < 4; ++db) o[db] = f32x16{};
    int slot = 0;
    const lds_cptr kp0 = (lds_cptr)shm + L_K + hi * 1024 + r32 * 16;
    const lds_cptr vp0 = (lds_cptr)shm + L_V + ((lane >> 4) & 1) * 32 + (lane & 3) * 8 + (4 * hi + ((lane & 15) >> 2)) * 64;
    for (int t = 0; t < NT; ++t) {
        if (t + 1 < NT) ATT_WAIT_BAR(3); else ATT_WAIT_BAR(0);
        if (t + 2 < NT) { const int s2 = (slot + 2 >= NSLOT) ? slot + 2 - NSLOT : slot + 2; ATT_DMA(t + 2, s2); }
        if (t <= tmax) {
            const lds_cptr kp = kp0 + slot * KSLOT;
            f32x16 p0 = negm, p1 = negm;
#pragma unroll
            for (int d0 = 0; d0 < 4; ++d0) {
                const bf16x8 b0 = *(const LAS bf16x8*)(kp + d0 * 2048), b1 = *(const LAS bf16x8*)(kp + d0 * 2048 + 512);
                p0 = __builtin_amdgcn_mfma_f32_32x32x16_bf16(b0, qr[d0], p0, 0, 0, 0);
                p1 = __builtin_amdgcn_mfma_f32_32x32x16_bf16(b1, qr[d0], p1, 0, 0, 0);
            }
            float rm = fmaxf(p0[0], p1[0]);
#pragma unroll
            for (int r = 1; r < 16; ++r) rm = fmaxf(rm, fmaxf(p0[r], p1[r]));
            rm = merge_max32(rm);
            const bool first = (t == 0);
            if (first || __any(rm > THR)) {
                const float dl = first ? rm : fmaxf(rm, 0.f);
                mhat += dl;
#pragma unroll
                for (int r = 0; r < 16; ++r) { p0[r] -= dl; p1[r] -= dl; negm[r] = -mhat; }
                if (!first) {
                    const float f = __builtin_amdgcn_exp2f(-dl); l_reg *= f;
                    if (hi == 0) wsf[r32] = f;
                    asm volatile("s_waitcnt lgkmcnt(0)" ::: "memory");
#pragma unroll
                    for (int g = 0; g < 4; ++g) { const f32x4 fv = *(const LAS f32x4*)(wsf + 8 * g + 4 * hi);
#pragma unroll
                        for (int i = 0; i < 4; ++i)
#pragma unroll
                            for (int db = 0; db < 4; ++db) o[db][4 * g + i] *= fv[i]; }
                }
            }
            float sacc = 0.f;
#pragma unroll
            for (int r = 0; r < 16; ++r) { p0[r] = __builtin_amdgcn_exp2f(p0[r]); p1[r] = __builtin_amdgcn_exp2f(p1[r]); sacc += p0[r] + p1[r]; }
            l_reg += sacc;
            bf16x8 pa[4];
#pragma unroll
            for (int s = 0; s < 4; ++s) { u32x4_t w;
                if (s < 2) { w.x = pg8::cvt_pk_bf16(p0[8 * s + 0], p0[8 * s + 1]); w.y = pg8::cvt_pk_bf16(p0[8 * s + 2], p0[8 * s + 3]); w.z = pg8::cvt_pk_bf16(p0[8 * s + 4], p0[8 * s + 5]); w.w = pg8::cvt_pk_bf16(p0[8 * s + 6], p0[8 * s + 7]); }
                else { const int q = s - 2; w.x = pg8::cvt_pk_bf16(p1[8 * q + 0], p1[8 * q + 1]); w.y = pg8::cvt_pk_bf16(p1[8 * q + 2], p1[8 * q + 3]); w.z = pg8::cvt_pk_bf16(p1[8 * q + 4], p1[8 * q + 5]); w.w = pg8::cvt_pk_bf16(p1[8 * q + 6], p1[8 * q + 7]); }
                pa[s] = __builtin_bit_cast(bf16x8, w); }
            const lds_cptr vp = vp0 + slot * VSLOT;
#pragma unroll
            for (int db = 0; db < 4; ++db)
#pragma unroll
                for (int ks = 0; ks < 4; ++ks) {
                    const s16x4 lo = vtr(vp + db * 4096 + ks * 1024), hh = vtr(vp + db * 4096 + ks * 1024 + 512);
                    const bf16x8 vf = {lo[0], lo[1], lo[2], lo[3], hh[0], hh[1], hh[2], hh[3]};
                    o[db] = __builtin_amdgcn_mfma_f32_32x32x16_bf16(pa[ks], vf, o[db], 0, 0, 0);
                }
        }
        slot = (slot + 1 == NSLOT) ? 0 : slot + 1;
    }
    ATT_WAIT_BAR(0);
    l_reg = merge_sum32(l_reg);
    if (hi == 0) wsf[32 + r32] = 1.0f / l_reg;
    asm volatile("s_waitcnt lgkmcnt(0)" ::: "memory");
#pragma unroll
    for (int g = 0; g < 4; ++g) { const f32x4 fv = *(const LAS f32x4*)(wsf + 32 + 8 * g + 4 * hi);
#pragma unroll
        for (int i = 0; i < 4; ++i)
#pragma unroll
            for (int db = 0; db < 4; ++db) o[db][4 * g + i] *= fv[i]; }
    asm volatile("s_waitcnt lgkmcnt(0)" ::: "memory");
#undef ATT_DMA
}

__device__ __forceinline__ void attn_unit(int b, int h, int qb, const bf16* Z, bf16* MIX, LAS unsigned char* shm, float lam, float out_scale, const float* subg) {
    const int tid = threadIdx.x, lane = tid & 63, r32 = lane & 31, hi = lane >> 5; const int wid = __builtin_amdgcn_readfirstlane(tid >> 6);
    const size_t rowbase = (size_t)b * SEQ; const int q0 = qb * 256;
    const int NT = 4 * qb + 4, tmax = 4 * qb + (wid >> 1);
    const bf16* Qw = Z + (rowbase + q0 + wid * 32 + r32) * DIN + ZC_Q + h * 128;
    const bf16* Kh = Z + rowbase * DIN + ZC_K + h * 128;
    const bf16* Vh = Z + rowbase * DIN + ZC_V + h * 128;
    LAS unsigned* sv = (LAS unsigned*)(shm + L_O0 + wid * 8192);
    f32x16 o[4];
    attn_pass(o, Qw, Kh, Vh, shm, NT, tmax, wid, lane);
#pragma unroll
    for (int db = 0; db < 4; ++db)
#pragma unroll
        for (int r2 = 0; r2 < 8; ++r2) sv[(db * 8 + r2) * 64 + lane] = pg8::cvt_pk_bf16(o[db][2 * r2], o[db][2 * r2 + 1]);
    attn_pass(o, Qw + 64, Kh + 64, Vh, shm, NT, tmax, wid, lane);
    asm volatile("s_waitcnt lgkmcnt(0)" ::: "memory");
    float ssq[16];
#pragma unroll
    for (int r = 0; r < 16; ++r) ssq[r] = 0.f;
#pragma unroll
    for (int db = 0; db < 4; ++db)
#pragma unroll
        for (int r2 = 0; r2 < 8; ++r2) { const unsigned w = sv[(db * 8 + r2) * 64 + lane];
            const float a0 = __uint_as_float(w << 16), a1 = __uint_as_float(w & 0xffff0000u);
            const float v0 = a0 - lam * o[db][2 * r2], v1 = a1 - lam * o[db][2 * r2 + 1];
            o[db][2 * r2] = v0; o[db][2 * r2 + 1] = v1; ssq[2 * r2] += v0 * v0; ssq[2 * r2 + 1] += v1 * v1; }
#pragma unroll
    for (int r = 0; r < 16; ++r) {
#pragma unroll
        for (int off = 1; off < 32; off <<= 1) ssq[r] += __shfl_xor(ssq[r], off);
        ssq[r] = rsqrtf(ssq[r] * (1.0f / 128.0f) + EPS) * out_scale; }
    bf16* Ow = MIX + (rowbase + q0 + wid * 32) * DM + 512 + h * 128 + r32;
#pragma unroll
    for (int db = 0; db < 4; ++db) { const float gsc = subg[32 * db + r32];
#pragma unroll
        for (int r = 0; r < 16; ++r) Ow[(size_t)crow(r, hi) * DM + 32 * db] = f2bf(o[db][r] * ssq[r] * gsc); }
    asm volatile("s_waitcnt lgkmcnt(0)" ::: "memory");
}
#undef ATT_WAIT_BAR
}

constexpr int PK_LDS = 147456;
__global__ void __launch_bounds__(512, 2) k_attn(const bf16* Z, bf16* MIX, const float* lq1, const float* lk1, const float* lq2, const float* lk2, const float* subg, float lambda_init) {
    extern __shared__ __attribute__((aligned(16))) unsigned char lds[];
    const int lane = threadIdx.x & 63; const int G = gridDim.x, bx = blockIdx.x;
    const int vcu = (G % 8 == 0) ? (bx % 8) * (G / 8) + bx / 8 : bx;
    const float lam = expf(wave_sum(lq1[lane] * lk1[lane])) - expf(wave_sum(lq2[lane] * lk2[lane])) + lambda_init;
    for (int p = vcu; p < 256; p += G) {
        const int bh = p >> 4, s = p & 15;
        att::attn_unit(bh >> 2, bh & 3, s, Z, MIX, (LAS unsigned char*)lds, lam, 1.0f - lambda_init, subg);
        att::attn_unit(bh >> 2, bh & 3, 31 - s, Z, MIX, (LAS unsigned char*)lds, lam, 1.0f - lambda_init, subg);
    }
}

template <class Epi>
__global__ void __launch_bounds__(512, 2) k_gemm(pg8::Gemm g, Epi E) {
    extern __shared__ __attribute__((aligned(16))) unsigned char lds[];
    pg8::StaticOrder S; S.init(g.M, g.N, gridDim.x, blockIdx.x);
    pg8::gemm_phase<Epi, pg8::StaticOrder, true, true>((PG8_LAS unsigned char*)lds, g, S, E);
}

extern "C" void kernel_launch(void* const* d_in, const int* in_sizes, int n_in, void* d_out, int out_size, void* d_ws, size_t ws_size, hipStream_t stream) {
    static int grid = 0;
    if (grid == 0) {
        if (n_in != 29 || in_sizes[0] != MROWS * DM || out_size != MROWS * DM || ws_size < WS_END) { fprintf(stderr, "kernel_launch: unexpected shapes / workspace (n_in %d, ws %zu); nothing launched\n", n_in, ws_size); grid = -1; return; }
        int dev = 0, cus = 0;
        if (hipGetDevice(&dev) != hipSuccess || hipDeviceGetAttribute(&cus, hipDeviceAttributeMultiprocessorCount, dev) != hipSuccess) { grid = -1; return; }
        (void)hipFuncSetAttribute((const void*)k_gemm<pg8::EpiStoreBf16>, hipFuncAttributeMaxDynamicSharedMemorySize, GEMM_LDS);
        (void)hipFuncSetAttribute((const void*)k_gemm<pg8::EpiSwiglu>, hipFuncAttributeMaxDynamicSharedMemorySize, GEMM_LDS);
        (void)hipFuncSetAttribute((const void*)k_gemm<pg8::EpiResid>, hipFuncAttributeMaxDynamicSharedMemorySize, GEMM_LDS);
        (void)hipFuncSetAttribute((const void*)k_attn, hipFuncAttributeMaxDynamicSharedMemorySize, PK_LDS);
        grid = cus;
    }
    if (grid < 0) return;
    const float* x_in = (const float*)d_in[0]; const float* c_in = (const float*)d_in[1]; const int* pos = (const int*)d_in[2];
    const float* ada_w = (const float*)d_in[3]; const float* ada_b = (const float*)d_in[4]; const float* ln1_g = (const float*)d_in[5]; const float* ln2_g = (const float*)d_in[6];
    const float* w_in = (const float*)d_in[7]; const float* conv_w = (const float*)d_in[8]; const float* conv_b = (const float*)d_in[9];
    const float* gate_a_w = (const float*)d_in[10]; const float* gate_a_b = (const float*)d_in[11]; const float* gate_x_w = (const float*)d_in[12]; const float* gate_x_b = (const float*)d_in[13];
    const float* lru_lambda = (const float*)d_in[14]; const float* lam_q1 = (const float*)d_in[15]; const float* lam_k1 = (const float*)d_in[16]; const float* lam_q2 = (const float*)d_in[17]; const float* lam_k2 = (const float*)d_in[18];
    const float* subln_g = (const float*)d_in[19]; const float* w_out = (const float*)d_in[20];
    const float* ffn_wg = (const float*)d_in[21]; const float* ffn_wu = (const float*)d_in[22]; const float* ffn_wd = (const float*)d_in[23];
    const float* moe_router = (const float*)d_in[24]; const float* moe_wg = (const float*)d_in[25]; const float* moe_wu = (const float*)d_in[26]; const float* moe_wd = (const float*)d_in[27];
    const float* final_g = (const float*)d_in[28];
    unsigned char* ws = (unsigned char*)d_ws; float* xr = (float*)d_out;
    bf16* Win = (bf16*)(ws + WS_WIN); bf16* Wout = (bf16*)(ws + WS_WOUT); bf16* Wgu = (bf16*)(ws + WS_WGU); bf16* Wd = (bf16*)(ws + WS_WD); bf16* Mgu = (bf16*)(ws + WS_MGU); bf16* Md = (bf16*)(ws + WS_MD);
    float* MOD = (float*)(ws + WS_MOD); float2* ROPE = (float2*)(ws + WS_ROPE); float* GATES = (float*)(ws + WS_GATES);
    bf16* HB = (bf16*)(ws + WS_HB); float* XC = (float*)(ws + WS_HB); bf16* ZB = (bf16*)(ws + WS_ZB); bf16* MIX = (bf16*)(ws + WS_MIX); bf16* ACT = (bf16*)(ws + WS_ACT);
    const int TG = 1024;
    for (int l = 0; l < DEPTH; ++l) {
        k_transpose<<<TG, 256, 0, stream>>>(w_in + (size_t)l * DM * DIN, DM, DIN, Win + (size_t)l * DIN * DM, 0);
        k_transpose<<<TG, 256, 0, stream>>>(w_out + (size_t)l * DM * DM, DM, DM, Wout + (size_t)l * DM * DM, 0);
    }
    k_transpose<<<TG, 256, 0, stream>>>(ffn_wg, DM, DFF, Wgu, 1);
    k_transpose<<<TG, 256, 0, stream>>>(ffn_wu, DM, DFF, Wgu, 2);
    k_transpose<<<TG, 256, 0, stream>>>(ffn_wd, DFF, DM, Wd, 0);
    for (int e = 0; e < NEXP; ++e) {
        k_transpose<<<TG, 256, 0, stream>>>(moe_wg + (size_t)e * DM * DFF, DM, DFF, Mgu + (size_t)e * 2 * DFF * DM, 1);
        k_transpose<<<TG, 256, 0, stream>>>(moe_wu + (size_t)e * DM * DFF, DM, DFF, Mgu + (size_t)e * 2 * DFF * DM, 2);
        k_transpose<<<TG, 256, 0, stream>>>(moe_wd + (size_t)e * DFF * DM, DFF, DM, Md + (size_t)e * DM * DFF, 0);
    }
    k_mod<<<(DEPTH * NMOD + 255) / 256, 256, 0, stream>>>(c_in, ada_w, ada_b, MOD);
    k_rope_tbl<<<MROWS * 32 / 256, 256, 0, stream>>>(pos, ROPE);
    const float* xcur = x_in;
    for (int l = 0; l < DEPTH; ++l) {
        const float lambda_init = 0.8f - 0.6f * expf(-0.3f * (float)l);
        const float* modl = MOD + (size_t)l * NB * NMOD;
        k_norm_mod<<<2048, 256, 0, stream>>>(xcur, ln1_g + l * DM, modl, 0, DM, HB, nullptr, nullptr);
        { pg8::Gemm g{HB, Win + (size_t)l * DIN * DM, MROWS, DIN, DM, 0}; pg8::EpiStoreBf16 E{ZB, DIN, 0};
          k_gemm<pg8::EpiStoreBf16><<<grid, 512, GEMM_LDS, stream>>>(g, E); }
        k_rope_naive<<<MROWS * 16 * 32 / 256, 256, 0, stream>>>(ZB, ROPE);
        k_conv_naive<<<MROWS * LRU_W / 256, 256, 0, stream>>>(ZB, conv_w + l * 4 * LRU_W, conv_b + l * LRU_W, XC);
        k_lru_naive<<<NB * 8, 64, 0, stream>>>(XC, ZB, gate_a_w + (size_t)l * 8 * 64 * 64, gate_a_b + l * LRU_W, gate_x_w + (size_t)l * 8 * 64 * 64, gate_x_b + l * LRU_W, lru_lambda + l * LRU_W, MIX);
        k_attn<<<grid, 512, PK_LDS, stream>>>(ZB, MIX, lam_q1 + l * 64, lam_k1 + l * 64, lam_q2 + l * 64, lam_k2 + l * 64, subln_g + l * 128, lambda_init);
        { pg8::Gemm g{MIX, Wout + (size_t)l * DM * DM, MROWS, DM, DM, 0}; pg8::EpiResid E{xcur, xr, modl + 2 * DM, nullptr, DM, NMOD, SEQ, 0};
          k_gemm<pg8::EpiResid><<<grid, 512, GEMM_LDS, stream>>>(g, E); }
        xcur = xr;
        if (l % 2 == 0) {
            k_norm_mod<<<2048, 256, 0, stream>>>(xr, ln2_g + l * DM, modl, 3 * DM, 4 * DM, HB, nullptr, nullptr);
            { pg8::Gemm g{HB, Wgu, MROWS, 2 * DFF, DM, 0}; pg8::EpiSwiglu E{ACT, DFF, 0};
              k_gemm<pg8::EpiSwiglu><<<grid, 512, GEMM_LDS, stream>>>(g, E); }
            { pg8::Gemm g{ACT, Wd, MROWS, DM, DFF, 0}; pg8::EpiResid E{xr, xr, modl + 5 * DM, nullptr, DM, NMOD, SEQ, 0};
              k_gemm<pg8::EpiResid><<<grid, 512, GEMM_LDS, stream>>>(g, E); }
        } else {
            const int j = l / 2;
            k_norm_mod<<<2048, 256, 0, stream>>>(xr, ln2_g + l * DM, modl, 3 * DM, 4 * DM, HB, moe_router + (size_t)j * DM * NEXP, GATES);
            for (int e = 0; e < NEXP; ++e) {
                { pg8::Gemm g{HB, Mgu + (size_t)e * 2 * DFF * DM, MROWS, 2 * DFF, DM, 0}; pg8::EpiSwiglu E{ACT, DFF, 0};
                  k_gemm<pg8::EpiSwiglu><<<grid, 512, GEMM_LDS, stream>>>(g, E); }
                { pg8::Gemm g{ACT, Md + (size_t)e * DM * DFF, MROWS, DM, DFF, 0}; pg8::EpiResid E{xr, xr, modl + 5 * DM, GATES + e, DM, NMOD, SEQ, NEXP};
                  k_gemm<pg8::EpiResid><<<grid, 512, GEMM_LDS, stream>>>(g, E); }
            }
        }
    }
    k_final<<<2048, 256, 0, stream>>>(xr, final_g);
}
```

```cpp
#include <hip/hip_runtime.h>
#include <cstdio>
#include <cstdint>

namespace pg8 {
#define PG8_LAS __attribute__((address_space(3)))
typedef unsigned short bf16_t;
typedef short bf16x8 __attribute__((ext_vector_type(8)));
typedef float f32x4 __attribute__((ext_vector_type(4)));
typedef unsigned u32x4 __attribute__((ext_vector_type(4)));
constexpr int BM = 256, BK = 64, HALF = 128, HTB = HALF * BK * 2, STAGE_BYTES = 8 * HTB, NXCD = 8, WGM = 8;

__host__ __device__ __forceinline__ int lds_byte(int r, int c) { const int st = (r >> 4) * 2 + (c >> 5), rr = r & 15, cc = c & 31, ob = rr * 64 + cc * 2; return st * 1024 + (ob ^ (((ob >> 9) & 1) << 5)); }
__host__ __device__ __forceinline__ void stage_rc(int b, int& R, int& C) { const int st = b / 1024, sb = b % 1024, swz = sb ^ (((sb >> 9) & 1) << 5); R = (st >> 1) * 16 + swz / 64; C = (st & 1) * 32 + (swz % 64) / 2; }
__host__ __device__ __forceinline__ int perm32(int rho) { const int n = rho >> 4, i = rho & 15; return 8 * (i >> 2) + 4 * n + (i & 3); }

struct Unit { int pm, pn; };
struct Gemm { const bf16_t* A; const bf16_t* Bt; int M, N, K, pad; };

struct StaticOrder {
    int nM, nN, nwg, G, c;
    __host__ __device__ void init(int M, int N, int G_, int c_) { nM = M / BM; nN = N / BM; nwg = nM * nN; G = G_; c = c_; }
    __host__ __device__ bool next(int i, Unit& u) const {
        const long L = (long)i * G + c; if (L >= nwg) return false;
        int wgid = (int)L; { const int q = nwg / NXCD, r = nwg % NXCD, xcd = wgid % NXCD, off = wgid / NXCD; wgid = (xcd < r ? xcd * (q + 1) : r * (q + 1) + (xcd - r) * q) + off; }
        const int nig = WGM * nN, gid = wgid / nig, fm = gid * WGM, gsz = (nM - fm) < WGM ? (nM - fm) : WGM;
        u.pm = fm + ((wgid % nig) % gsz); u.pn = (wgid % nig) / gsz; return true;
    }
    __device__ __forceinline__ void a_ready(const Unit&) const {}
    __device__ __forceinline__ void done(const Unit&) const {}
};

typedef float f32x2_t __attribute__((ext_vector_type(2))); typedef __bf16 bf16x2_t __attribute__((ext_vector_type(2)));
__device__ __forceinline__ unsigned cvt_pk_bf16(float lo, float hi) { f32x2_t v = {lo, hi}; bf16x2_t b = __builtin_convertvector(v, bf16x2_t); return __builtin_bit_cast(unsigned, b); }

struct EpiStoreBf16 {
    static constexpr bool PERM = true, AFTER_DRAIN = false;
    bf16_t* O; int ldc; int pad;
    __device__ __forceinline__ void operator()(const f32x4 (&acc)[2][2][4][2], const Unit& u, int wr, int wc, int fr, int fq) const {
        const int row0 = u.pm * BM + wr * 64 + fr; const int col0 = u.pn * BM + wc * 32 + 8 * fq;
#pragma unroll
        for (int ai = 0; ai < 2; ++ai)
#pragma unroll
            for (int m = 0; m < 4; ++m) { bf16_t* rowp = O + (size_t)(row0 + ai * HALF + m * 16) * ldc + col0;
#pragma unroll
                for (int bj = 0; bj < 2; ++bj) { const f32x4 v0 = acc[ai][bj][m][0], v1 = acc[ai][bj][m][1];
                    u32x4 w; w.x = cvt_pk_bf16(v0[0], v0[1]); w.y = cvt_pk_bf16(v0[2], v0[3]); w.z = cvt_pk_bf16(v1[0], v1[1]); w.w = cvt_pk_bf16(v1[2], v1[3]);
                    *(u32x4*)(rowp + bj * HALF) = w; } }
    }
};
__device__ __forceinline__ float silu_f(float x) { return x / (1.0f + __expf(-x)); }
struct EpiSwiglu {
    static constexpr bool PERM = true, AFTER_DRAIN = false;
    bf16_t* O; int ldc; int pad;
    __device__ __forceinline__ void operator()(const f32x4 (&acc)[2][2][4][2], const Unit& u, int wr, int wc, int fr, int fq) const {
        const int row0 = u.pm * BM + wr * 64 + fr; const int col0 = u.pn * HALF + wc * 32 + 8 * fq;
#pragma unroll
        for (int ai = 0; ai < 2; ++ai)
#pragma unroll
            for (int m = 0; m < 4; ++m) { bf16_t* rowp = O + (size_t)(row0 + ai * HALF + m * 16) * ldc + col0;
                float r[8];
#pragma unroll
                for (int n = 0; n < 2; ++n)
#pragma unroll
                    for (int i = 0; i < 4; ++i) r[n * 4 + i] = silu_f(acc[ai][0][m][n][i]) * acc[ai][1][m][n][i];
                u32x4 w; w.x = cvt_pk_bf16(r[0], r[1]); w.y = cvt_pk_bf16(r[2], r[3]); w.z = cvt_pk_bf16(r[4], r[5]); w.w = cvt_pk_bf16(r[6], r[7]);
                *(u32x4*)rowp = w; }
    }
};
struct EpiResid {
    static constexpr bool PERM = true, AFTER_DRAIN = false;
    const float* base; float* out; const float* gvec; const float* rowscale; int ldc; int gstride; int rows_per_batch; int rs_stride;
    __device__ __forceinline__ void operator()(const f32x4 (&acc)[2][2][4][2], const Unit& u, int wr, int wc, int fr, int fq) const {
        const int row0 = u.pm * BM + wr * 64 + fr; const int col0 = u.pn * BM + wc * 32 + 8 * fq;
        const float* gv = gvec + (size_t)((u.pm * BM) / rows_per_batch) * gstride + col0;
        f32x4 g[2][2];
#pragma unroll
        for (int bj = 0; bj < 2; ++bj)
#pragma unroll
            for (int n = 0; n < 2; ++n) g[bj][n] = *(const f32x4*)(gv + bj * HALF + 4 * n);
#pragma unroll
        for (int ai = 0; ai < 2; ++ai)
#pragma unroll
            for (int m = 0; m < 4; ++m) { const int row = row0 + ai * HALF + m * 16; const size_t off = (size_t)row * ldc + col0;
                const float rs = rowscale ? rowscale[(size_t)row * rs_stride] : 1.0f;
#pragma unroll
                for (int bj = 0; bj < 2; ++bj)
#pragma unroll
                    for (int n = 0; n < 2; ++n) { const f32x4 b = *(const f32x4*)(base + off + bj * HALF + 4 * n);
                        *(f32x4*)(out + off + bj * HALF + 4 * n) = b + g[bj][n] * rs * acc[ai][bj][m][n]; } }
    }
};

template <class Epi, class Sched, bool ALIGN_EPI = false, bool SP2 = false>
__device__ __forceinline__ void gemm_phase(PG8_LAS unsigned char* lds, const Gemm g, const Sched& S, const Epi& E) {
    const int tid = threadIdx.x, wid = __builtin_amdgcn_readfirstlane(tid >> 6), lane = tid & 63, wr = wid >> 2, wc = wid & 3, fr = lane & 15, fq = lane >> 4;
    const int K = g.K, nt = K / BK;
    unsigned voffA[2], voffB[2];
#pragma unroll
    for (int i = 0; i < 2; ++i) { int R, C; stage_rc(tid * 16 + i * 8192, R, C); const int Rb = Epi::PERM ? ((R & ~31) + perm32(R & 31)) : R;
        voffA[i] = (unsigned)(R * K + C) * 2u; voffB[i] = (unsigned)(Rb * K + C) * 2u; }
    const size_t kstep = (size_t)(BK * 2);
    const size_t hstep = (size_t)HALF * K * 2;
    const size_t tstep = 2 * hstep;
    const unsigned ldsw = (unsigned)wid * 1024u;
    const int aoff = lds_byte(wr * 64 + fr, fq * 8), boff = lds_byte(wc * 32 + fr, fq * 8);
#define PG8_SA(b, h) (((b) * 2 + (h)) * HTB)
#define PG8_SB(b, h) ((4 + (b) * 2 + (h)) * HTB)
#define PG8_STAGE(bufoff, gbase, voff) do { _Pragma("unroll") for (int _i = 0; _i < 2; ++_i) \
        __builtin_amdgcn_global_load_lds((const unsigned*)((const char*)(gbase) + (voff)[_i]), (PG8_LAS unsigned*)(lds + (bufoff) + ldsw + _i * 8192), 16, 0, 0); } while (0)
#define PG8_LDA(dst, b, h) do { _Pragma("unroll") for (int m = 0; m < 4; ++m) _Pragma("unroll") for (int k = 0; k < 2; ++k) dst[m][k] = *(const PG8_LAS bf16x8*)(lds + PG8_SA(b, h) + aoff + m * 2048 + k * 1024); } while (0)
#define PG8_LDB(dst, b, h) do { _Pragma("unroll") for (int n = 0; n < 2; ++n) _Pragma("unroll") for (int k = 0; k < 2; ++k) dst[n][k] = *(const PG8_LAS bf16x8*)(lds + PG8_SB(b, h) + boff + n * 2048 + k * 1024); } while (0)
#define PG8_MMA(ai, bj, At, Bt) do { __builtin_amdgcn_s_setprio(1); _Pragma("unroll") for (int m = 0; m < 4; ++m) _Pragma("unroll") for (int n = 0; n < 2; ++n) _Pragma("unroll") for (int k = 0; k < 2; ++k) \
        acc[ai][bj][m][n] = __builtin_amdgcn_mfma_f32_16x16x32_bf16(Bt[n][k], At[m][k], acc[ai][bj][m][n], 0, 0, 0); __builtin_amdgcn_s_setprio(0); } while (0)
#define PG8_WAIT_V(n) asm volatile("s_waitcnt vmcnt(" #n ")" ::: "memory")
#define PG8_WAIT_L(n) asm volatile("s_waitcnt lgkmcnt(" #n ")" ::: "memory")
#define PG8_BAR __builtin_amdgcn_s_barrier()
#define PG8_SCHED __builtin_amdgcn_sched_barrier(0)
    Unit cur, nxt; int ui = 0;
    if (!S.next(0, cur)) return;
    f32x4 acc[2][2][4][2];
#pragma unroll
    for (int a = 0; a < 2; ++a)
#pragma unroll
        for (int b = 0; b < 2; ++b)
#pragma unroll
            for (int m = 0; m < 4; ++m)
#pragma unroll
                for (int n = 0; n < 2; ++n) acc[a][b][m][n] = (f32x4){0.f, 0.f, 0.f, 0.f};
    bf16x8 At[4][2], B0[2][2], B1[2][2];
    const char* cA = (const char*)g.A + (size_t)cur.pm * tstep; const char* cB = (const char*)g.Bt + (size_t)cur.pn * tstep;
    S.a_ready(cur);
    if constexpr (SP2) {
        PG8_STAGE(PG8_SB(0, 0), cB, voffB); PG8_STAGE(PG8_SB(0, 1), cB + hstep, voffB); PG8_STAGE(PG8_SA(0, 0), cA, voffA); PG8_STAGE(PG8_SA(0, 1), cA + hstep, voffA);
        if (wr == 1) PG8_BAR;
        PG8_WAIT_V(2); PG8_BAR;
        PG8_STAGE(PG8_SB(1, 0), cB + kstep, voffB); PG8_STAGE(PG8_SA(1, 0), cA + kstep, voffA); PG8_STAGE(PG8_SB(1, 1), cB + hstep + kstep, voffB);
        PG8_WAIT_V(6); PG8_BAR;
    } else {
        PG8_STAGE(PG8_SB(0, 0), cB, voffB); PG8_STAGE(PG8_SA(0, 0), cA, voffA); PG8_STAGE(PG8_SB(0, 1), cB + hstep, voffB); PG8_STAGE(PG8_SA(0, 1), cA + hstep, voffA);
        if (wr == 1) PG8_BAR;
        PG8_WAIT_V(4); PG8_BAR;
        PG8_STAGE(PG8_SB(1, 0), cB + kstep, voffB); PG8_STAGE(PG8_SA(1, 0), cA + kstep, voffA); PG8_STAGE(PG8_SB(1, 1), cB + hstep + kstep, voffB);
        PG8_WAIT_V(6); PG8_BAR;
    }
    for (;;) {
        const bool has_next = S.next(ui + 1, nxt);
        const char* nA = has_next ? (const char*)g.A + (size_t)nxt.pm * tstep : cA; const char* nB = has_next ? (const char*)g.Bt + (size_t)nxt.pn * tstep : cB;
        for (int t = 0; t < nt; t += 2) {
            const bool last = (t == nt - 2);
            const char* a1 = cA + (size_t)(t + 1) * kstep;
            const char* a2 = last ? nA : cA + (size_t)(t + 2) * kstep; const char* b2 = last ? nB : cB + (size_t)(t + 2) * kstep;
            const char* a3 = a2 + kstep; const char* b3 = b2 + kstep;
            if (last && has_next) S.a_ready(nxt);
            if constexpr (SP2) {
            PG8_LDB(B0, 0, 0); PG8_LDB(B1, 0, 1); PG8_SCHED; PG8_LDA(At, 0, 0); PG8_STAGE(PG8_SA(1, 1), a1 + hstep, voffA);
            PG8_WAIT_V(8); PG8_WAIT_L(0); PG8_BAR; PG8_MMA(0, 0, At, B0); PG8_MMA(0, 1, At, B1); PG8_BAR; PG8_SCHED;
            PG8_LDA(At, 0, 1); PG8_STAGE(PG8_SB(0, 0), b2, voffB); PG8_STAGE(PG8_SB(0, 1), b2 + hstep, voffB); PG8_STAGE(PG8_SA(0, 0), a2, voffA);
            PG8_WAIT_V(8); PG8_WAIT_L(0); PG8_BAR; PG8_MMA(1, 0, At, B0); PG8_MMA(1, 1, At, B1); PG8_BAR; PG8_SCHED;
            PG8_LDB(B0, 1, 0); PG8_LDB(B1, 1, 1); PG8_SCHED; PG8_LDA(At, 1, 0); PG8_STAGE(PG8_SA(0, 1), a2 + hstep, voffA);
            PG8_WAIT_V(8); PG8_WAIT_L(0); PG8_BAR; PG8_MMA(0, 0, At, B0); PG8_MMA(0, 1, At, B1); PG8_BAR; PG8_SCHED;
            PG8_LDA(At, 1, 1); PG8_STAGE(PG8_SB(1, 0), b3, voffB); PG8_STAGE(PG8_SB(1, 1), b3 + hstep, voffB); PG8_STAGE(PG8_SA(1, 0), a3, voffA);
            PG8_WAIT_V(8); PG8_WAIT_L(0); PG8_BAR; PG8_MMA(1, 0, At, B0); PG8_MMA(1, 1, At, B1); PG8_BAR; PG8_SCHED;
            } else {
            PG8_LDB(B0, 0, 0); PG8_SCHED; PG8_LDA(At, 0, 0); PG8_STAGE(PG8_SA(1, 1), a1 + hstep, voffA);
            PG8_WAIT_L(8); PG8_BAR; PG8_WAIT_L(0); PG8_MMA(0, 0, At, B0); PG8_BAR; PG8_SCHED;
            PG8_LDB(B1, 0, 1); PG8_STAGE(PG8_SB(0, 0), b2, voffB);
            PG8_BAR; PG8_WAIT_L(0); PG8_MMA(0, 1, At, B1); PG8_BAR;
            PG8_LDA(At, 0, 1); PG8_STAGE(PG8_SA(0, 0), a2, voffA);
            PG8_BAR; PG8_WAIT_L(0); PG8_MMA(1, 0, At, B0); PG8_BAR; PG8_SCHED;
            PG8_STAGE(PG8_SB(0, 1), b2 + hstep, voffB);
            PG8_WAIT_V(6); PG8_BAR; PG8_MMA(1, 1, At, B1); PG8_BAR;
            PG8_LDB(B0, 1, 0); PG8_SCHED; PG8_LDA(At, 1, 0); PG8_STAGE(PG8_SA(0, 1), a2 + hstep, voffA);
            PG8_WAIT_L(8); PG8_BAR; PG8_WAIT_L(0); PG8_MMA(0, 0, At, B0); PG8_BAR; PG8_SCHED;
            PG8_LDB(B1, 1, 1); PG8_STAGE(PG8_SB(1, 0), b3, voffB);
            PG8_BAR; PG8_WAIT_L(0); PG8_MMA(0, 1, At, B1); PG8_BAR;
            PG8_LDA(At, 1, 1); PG8_STAGE(PG8_SA(1, 0), a3, voffA);
            PG8_BAR; PG8_WAIT_L(0); PG8_MMA(1, 0, At, B0); PG8_BAR; PG8_SCHED;
            PG8_STAGE(PG8_SB(1, 1), b3 + hstep, voffB);
            PG8_WAIT_V(6); PG8_BAR; PG8_MMA(1, 1, At, B1); PG8_BAR;
            }
        }
        if constexpr (ALIGN_EPI) { if (wr == 0) PG8_BAR; }
        if constexpr (!Epi::AFTER_DRAIN) { E(acc, cur, wr, wc, fr, fq); S.done(cur); }
        if (!has_next) break;
#pragma unroll
        for (int a = 0; a < 2; ++a)
#pragma unroll
            for (int b = 0; b < 2; ++b)
#pragma unroll
                for (int m = 0; m < 4; ++m)
#pragma unroll
                    for (int n = 0; n < 2; ++n) acc[a][b][m][n] = (f32x4){0.f, 0.f, 0.f, 0.f};
        cur = nxt; cA = nA; cB = nB; ++ui;
        if constexpr (ALIGN_EPI) { if (wr == 1) PG8_BAR; }
    }
    PG8_WAIT_V(0);
    if constexpr (!ALIGN_EPI) { if (wr == 0) PG8_BAR; }
    PG8_BAR;
#undef PG8_SA
#undef PG8_SB
#undef PG8_STAGE
#undef PG8_LDA
#undef PG8_LDB
#undef PG8_MMA
#undef PG8_WAIT_V
#undef PG8_WAIT_L
#undef PG8_BAR
#undef PG8_SCHED
}
}

typedef unsigned short bf16;
#define GAS __attribute__((address_space(1)))
#define LAS __attribute__((address_space(3)))
typedef unsigned v4u __attribute__((ext_vector_type(4)));
typedef float f32x4 __attribute__((ext_vector_type(4)));
typedef unsigned u32x4_t __attribute__((ext_vector_type(4)));

constexpr int DM = 1024, NB = 4, SEQ = 8192, MROWS = NB * SEQ, DEPTH = 2;
constexpr int LRU_W = 512, DIN = 2560, DFF = 3072, NEXP = 8, NMOD = 6 * DM;
constexpr int ZC_XR = 0, ZC_YR = 512, ZC_Q = 1024, ZC_K = 1536, ZC_V = 2048;
constexpr float EPS = 1e-6f;
constexpr int NWAVES = 8;
constexpr int GEMM_LDS = 131072;

constexpr size_t MiB = 1u << 20;
constexpr size_t WS_CTL = 0;
constexpr size_t WS_WIN = 2 * MiB;
constexpr size_t WS_WOUT = 12 * MiB;
constexpr size_t WS_WGU = 16 * MiB;
constexpr size_t WS_WD = 28 * MiB;
constexpr size_t WS_MGU = 34 * MiB;
constexpr size_t WS_MD = 130 * MiB;
constexpr size_t WS_MOD = 178 * MiB;
constexpr size_t WS_ROPE = 180 * MiB;
constexpr size_t WS_GATES = 188 * MiB;
constexpr size_t WS_AGG = 189 * MiB;
constexpr size_t WS_HB = 192 * MiB;
constexpr size_t WS_ZB = 256 * MiB;
constexpr size_t WS_MIX = 416 * MiB;
constexpr size_t WS_ACT = 256 * MiB;
constexpr size_t WS_END = 480 * MiB;

__device__ __forceinline__ float bf2f(bf16 v) { return __uint_as_float((unsigned)v << 16); }
__device__ __forceinline__ bf16 f2bf(float f) { return (bf16)(pg8::cvt_pk_bf16(f, 0.f) & 0xffffu); }
__device__ __forceinline__ float wave_sum(float v) {
#pragma unroll
    for (int o = 1; o < 64; o <<= 1) v += __shfl_xor(v, o);
    return v;
}
__device__ __forceinline__ float wave_max(float v) {
#pragma unroll
    for (int o = 1; o < 64; o <<= 1) v = fmaxf(v, __shfl_xor(v, o));
    return v;
}
__device__ __forceinline__ float gelu_tanh(float y) { const float u = 0.7978845608028654f * (y + 0.044715f * y * y * y); const float t = 1.0f - 2.0f / (1.0f + __expf(2.0f * u)); return 0.5f * y * (1.0f + t); }

__device__ __forceinline__ void transpose_item(const float* W, int K, int N, bf16* WT, int dest_row0, LAS float* scr, int k0, int n0, int lane) {
#pragma unroll 8
    for (int i = 0; i < 32; ++i) { const int kk = 2 * i + (lane >> 5); scr[kk * 33 + (lane & 31)] = W[(size_t)(k0 + kk) * N + n0 + (lane & 31)]; }
    asm volatile("s_waitcnt lgkmcnt(0)" ::: "memory");
    const int c = lane & 7;
#pragma unroll
    for (int j = 0; j < 4; ++j) { const int n = (lane >> 3) + 8 * j; const LAS float* s = scr + (8 * c) * 33 + n;
        v4u o; o.x = pg8::cvt_pk_bf16(s[0 * 33], s[1 * 33]); o.y = pg8::cvt_pk_bf16(s[2 * 33], s[3 * 33]); o.z = pg8::cvt_pk_bf16(s[4 * 33], s[5 * 33]); o.w = pg8::cvt_pk_bf16(s[6 * 33], s[7 * 33]);
        *(GAS v4u*)(WT + (size_t)(dest_row0 + n) * K + k0 + 8 * c) = o; }
    asm volatile("s_waitcnt lgkmcnt(0)" ::: "memory");
}
__global__ void __launch_bounds__(256) k_transpose(const float* W, int K, int N, bf16* WT, int mode) {
    __shared__ float scr_all[4][64 * 33];
    const int lane = threadIdx.x & 63, w = threadIdx.x >> 6;
    LAS float* scr = (LAS float*)&scr_all[w][0];
    const int nblk = N / 32, nitems = (K / 64) * nblk;
    for (int it = blockIdx.x * 4 + w; it < nitems; it += gridDim.x * 4) {
        const int kb = it / nblk, nb = it % nblk, k0 = 64 * kb, n0 = 32 * nb;
        int d0 = n0; if (mode == 1) d0 = 256 * (n0 / 128) + (n0 % 128); else if (mode == 2) d0 = 256 * (n0 / 128) + 128 + (n0 % 128);
        transpose_item(W, K, N, WT, d0, scr, k0, n0, lane);
    }
}
__global__ void __launch_bounds__(256) k_mod(const float* c, const float* ada_w, const float* ada_b, float* mod) {
    __shared__ float sc[NB][DM];
    for (int i = threadIdx.x; i < NB * DM; i += 256) { const float v = c[i]; sc[i / DM][i % DM] = v / (1.0f + expf(-v)); }
    __syncthreads();
    const int gid = blockIdx.x * 256 + threadIdx.x; if (gid >= DEPTH * NMOD) return;
    const int l = gid / NMOD, n = gid % NMOD;
    const float* w = ada_w + (size_t)l * DM * NMOD + n;
    float a0 = 0.f, a1 = 0.f, a2 = 0.f, a3 = 0.f;
    for (int k = 0; k < DM; ++k) { const float wv = w[(size_t)k * NMOD]; a0 += sc[0][k] * wv; a1 += sc[1][k] * wv; a2 += sc[2][k] * wv; a3 += sc[3][k] * wv; }
    const float bb = ada_b[l * NMOD + n];
    mod[((size_t)l * NB + 0) * NMOD + n] = a0 + bb; mod[((size_t)l * NB + 1) * NMOD + n] = a1 + bb;
    mod[((size_t)l * NB + 2) * NMOD + n] = a2 + bb; mod[((size_t)l * NB + 3) * NMOD + n] = a3 + bb;
}
__constant__ float c_inv[32] = {1.000000000e+00f, 7.498942018e-01f, 5.623413324e-01f, 4.216965139e-01f, 3.162277639e-01f, 2.371373773e-01f, 1.778279394e-01f, 1.333521456e-01f, 1.000000015e-01f, 7.498942316e-02f, 5.623413250e-02f, 4.216964915e-02f, 3.162277490e-02f, 2.371373773e-02f, 1.778279431e-02f, 1.333521400e-02f, 9.999999776e-03f, 7.498942316e-03f, 5.623413250e-03f, 4.216964822e-03f, 3.162277630e-03f, 2.371373819e-03f, 1.778279431e-03f, 1.333521446e-03f, 1.000000047e-03f, 7.498941850e-04f, 5.623413017e-04f, 4.216965172e-04f, 3.162277571e-04f, 2.371373703e-04f, 1.778279402e-04f, 1.333521504e-04f};
__device__ __forceinline__ void sincos_acc(float angf, float& cs, float& sn) {
    const double x = (double)angf;
    const double k = rint(x * 0.63661977236758134308);
    const double r = fma(-k, 6.123233995736766036e-17, fma(-k, 1.57079632679489655800, x));
    const double r2 = r * r;
    double s = -7.6471637318198164759e-13; s = fma(s, r2, 1.6059043836821614599e-10); s = fma(s, r2, -2.5052108385441718775e-08); s = fma(s, r2, 2.7557319223985890653e-06);
    s = fma(s, r2, -1.9841269841269841270e-04); s = fma(s, r2, 8.3333333333333333333e-03); s = fma(s, r2, -1.6666666666666666667e-01); s = fma(s * r2, r, r);
    double c = 4.7794773323873852974e-14; c = fma(c, r2, -1.1470745597729724714e-11); c = fma(c, r2, 2.0876756987868098979e-09); c = fma(c, r2, -2.7557319223985890653e-07);
    c = fma(c, r2, 2.4801587301587301587e-05); c = fma(c, r2, -1.3888888888888888889e-03); c = fma(c, r2, 4.1666666666666666667e-02); c = fma(c, r2, -0.5); c = fma(c, r2, 1.0);
    const int q = ((int)(long long)k) & 3;
    const double sv = (q == 0) ? s : (q == 1) ? c : (q == 2) ? -s : -c;
    const double cv = (q == 0) ? c : (q == 1) ? -s : (q == 2) ? -c : s;
    cs = (float)cv; sn = (float)sv;
}
__global__ void __launch_bounds__(256) k_rope_tbl(const int* pos, float2* tbl) {
    const int gid = blockIdx.x * 256 + threadIdx.x; if (gid >= MROWS * 32) return;
    const int row = gid >> 5, i = gid & 31;
    const float ang = __fmul_rn((float)pos[row], c_inv[i]);
    float cs, sn; sincos_acc(ang, cs, sn);
    tbl[gid] = make_float2(cs, sn);
}

__global__ void __launch_bounds__(256) k_norm_mod(const float* x, const float* lng, const float* mod_l  , int sh_off, int sc_off, bf16* H, const float* router  , float* gates) {
    const int lane = threadIdx.x & 63; const int gw = (blockIdx.x * 256 + threadIdx.x) >> 6, NGW = gridDim.x * 4;
    for (int row = gw; row < MROWS; row += NGW) {
        const int b = row / SEQ;
        const f32x4* xr = (const f32x4*)(x + (size_t)row * DM) + lane;
        f32x4 v[4]; float s = 0.f;
#pragma unroll
        for (int j = 0; j < 4; ++j) { v[j] = xr[64 * j]; s += (v[j].x * v[j].x + v[j].y * v[j].y) + (v[j].z * v[j].z + v[j].w * v[j].w); }
        const float rstd = rsqrtf(wave_sum(s) * (1.0f / DM) + EPS);
        const float* mb = mod_l + (size_t)b * NMOD;
        float lg[8];
#pragma unroll
        for (int e = 0; e < 8; ++e) lg[e] = 0.f;
#pragma unroll
        for (int j = 0; j < 4; ++j) { const int c0 = 4 * lane + 256 * j;
            const f32x4 g = *(const f32x4*)(lng + c0), sc = *(const f32x4*)(mb + sc_off + c0), sh = *(const f32x4*)(mb + sh_off + c0);
            f32x4 h; h = v[j] * rstd * g * (1.0f + sc) + sh;
            uint2 o; o.x = pg8::cvt_pk_bf16(h.x, h.y); o.y = pg8::cvt_pk_bf16(h.z, h.w);
            *(uint2*)(H + (size_t)row * DM + c0) = o;
            if (router) {
#pragma unroll
                for (int i = 0; i < 4; ++i) { const f32x4 r0 = *(const f32x4*)(router + (size_t)(c0 + i) * 8), r1 = *(const f32x4*)(router + (size_t)(c0 + i) * 8 + 4);
                    const float hv = h[i];
                    lg[0] += hv * r0.x; lg[1] += hv * r0.y; lg[2] += hv * r0.z; lg[3] += hv * r0.w; lg[4] += hv * r1.x; lg[5] += hv * r1.y; lg[6] += hv * r1.z; lg[7] += hv * r1.w; }
            }
        }
        if (router) {
#pragma unroll
            for (int e = 0; e < 8; ++e) lg[e] = wave_sum(lg[e]);
            int i0 = 0; float v0 = lg[0];
#pragma unroll
            for (int e = 1; e < 8; ++e) if (lg[e] > v0) { v0 = lg[e]; i0 = e; }
            int i1 = -1; float v1 = -INFINITY;
#pragma unroll
            for (int e = 0; e < 8; ++e) if (e != i0 && lg[e] > v1) { v1 = lg[e]; i1 = e; }
            const float e1 = expf(v1 - v0), w0 = 1.0f / (1.0f + e1), w1 = e1 / (1.0f + e1);
            if (lane < 8) gates[(size_t)row * 8 + lane] = (lane == i0) ? w0 : (lane == i1) ? w1 : 0.f;
        }
    }
}
__global__ void __launch_bounds__(256) k_final(float* x, const float* g) {
    const int lane = threadIdx.x & 63; const int gw = (blockIdx.x * 256 + threadIdx.x) >> 6, NGW = gridDim.x * 4;
    for (int row = gw; row < MROWS; row += NGW) {
        f32x4* xr = (f32x4*)(x + (size_t)row * DM) + lane;
        f32x4 v[4]; float s = 0.f;
#pragma unroll
        for (int j = 0; j < 4; ++j) { v[j] = xr[64 * j]; s += (v[j].x * v[j].x + v[j].y * v[j].y) + (v[j].z * v[j].z + v[j].w * v[j].w); }
        const float rstd = rsqrtf(wave_sum(s) * (1.0f / DM) + EPS);
#pragma unroll
        for (int j = 0; j < 4; ++j) { const f32x4 gg = *(const f32x4*)(g + 4 * lane + 256 * j); xr[64 * j] = v[j] * rstd * gg; }
    }
}

__global__ void __launch_bounds__(256) k_rope_naive(bf16* Z, const float2* tbl) {
    const size_t gid = (size_t)blockIdx.x * 256 + threadIdx.x; if (gid >= (size_t)MROWS * 16 * 32) return;
    const int i = gid & 31, s = (gid >> 5) & 15; const size_t row = gid >> 9;
    bf16* p = Z + row * DIN + ZC_Q + s * 64;
    const float2 cs = tbl[row * 32 + i];
    const float x1 = bf2f(p[i]), x2 = bf2f(p[i + 32]);
    const float sc = (s < 8) ? 0.125f * 1.4426950408889634f : 1.0f;
    p[i] = f2bf((x1 * cs.x - x2 * cs.y) * sc); p[i + 32] = f2bf((x2 * cs.x + x1 * cs.y) * sc);
}
__global__ void __launch_bounds__(256) k_conv_naive(const bf16* Z, const float* cw, const float* cb, float* XC) {
    const size_t gid = (size_t)blockIdx.x * 256 + threadIdx.x; if (gid >= (size_t)MROWS * LRU_W) return;
    const int c = gid % LRU_W; const size_t row = gid / LRU_W; const int t = row % SEQ;
    float acc = cb[c];
#pragma unroll
    for (int j = 0; j < 4; ++j) { const int tt = t - 3 + j; if (tt >= 0) acc += cw[j * LRU_W + c] * bf2f(Z[(row - 3 + j) * DIN + ZC_XR + c]); }
    XC[gid] = acc;
}
__global__ void __launch_bounds__(64) k_lru_naive(const float* XC, const bf16* Z, const float* wa, const float* ba, const float* wx, const float* bx, const float* lam, bf16* MIX) {
    const int b = blockIdx.x / 8, n = blockIdx.x % 8, k = threadIdx.x, c = n * 64 + k;
    float war[64], wxr[64];
#pragma unroll
    for (int h = 0; h < 64; ++h) { war[h] = wa[(size_t)(n * 64 + h) * 64 + k]; wxr[h] = wx[(size_t)(n * 64 + h) * 64 + k]; }
    const float bav = ba[c], bxv = bx[c];
    const float L = lam[c]; const float sp = (L > 15.f) ? expf(-L) : log1pf(expf(-L));
    float h = 0.f;
    const size_t row0 = (size_t)b * SEQ;
    float xk = XC[row0 * LRU_W + c];
    for (int t = 0; t < SEQ; ++t) {
        const size_t row = row0 + t;
        const float xnext = (t + 1 < SEQ) ? XC[(row + 1) * LRU_W + c] : 0.f;
        float ar = bav, ai = bxv;
#pragma unroll
        for (int hh = 0; hh < 64; ++hh) { const float xv = __shfl(xk, hh); ar += xv * war[hh]; ai += xv * wxr[hh]; }
        const float r = 1.0f / (1.0f + expf(-ar)), ig = 1.0f / (1.0f + expf(-ai));
        const float log_a = -8.0f * r * sp; const float a = expf(log_a); const float mult = sqrtf(-expm1f(2.0f * log_a));
        h = a * h + mult * (ig * xk);
        const float y = bf2f(Z[row * DIN + ZC_YR + c]);
        MIX[row * DM + c] = f2bf(h * gelu_tanh(y));
        xk = xnext;
    }
}
__global__ void __launch_bounds__(256) k_attn_naive(const bf16* Z, const int* pos, bf16* MIX, const float* lq1, const float* lk1, const float* lq2, const float* lk2, const float* subg, float lambda_init) {
    __shared__ float qs[4][128];
    const int lane = threadIdx.x & 63, w = threadIdx.x >> 6; const int gw = blockIdx.x * 4 + w;
    const int q = gw % SEQ, h = (gw / SEQ) % 4, b = gw / (SEQ * 4);
    const size_t rowb = (size_t)b * SEQ, row = rowb + q;
    const float lam = expf(wave_sum(lq1[lane] * lk1[lane])) - expf(wave_sum(lq2[lane] * lk2[lane])) + lambda_init;
    qs[w][lane] = bf2f(Z[row * DIN + ZC_Q + h * 128 + lane]); qs[w][64 + lane] = bf2f(Z[row * DIN + ZC_Q + h * 128 + 64 + lane]);
    __syncthreads();
    const int pq = pos[row], cq = pq >> 6, p0 = pos[rowb];
    int kend = ((cq + 1) << 6) - 1 - p0; if (kend > SEQ - 1) kend = SEQ - 1;
    const int nch = kend / 64 + 1;
    float m1 = -INFINITY, m2 = -INFINITY, l1 = 0.f, l2 = 0.f, o1a = 0.f, o1b = 0.f, o2a = 0.f, o2b = 0.f;
    for (int ch = 0; ch < nch; ++ch) {
        const int key = ch * 64 + lane;
        const bool valid = (pos[rowb + key] >> 6) <= cq;
        const bf16* kr = Z + (rowb + key) * DIN + ZC_K + h * 128;
        float s1 = 0.f, s2 = 0.f;
#pragma unroll 8
        for (int d = 0; d < 64; d += 2) { const unsigned u1 = *(const unsigned*)(kr + d), u2 = *(const unsigned*)(kr + 64 + d);
            s1 += qs[w][d] * __uint_as_float(u1 << 16) + qs[w][d + 1] * __uint_as_float(u1 & 0xffff0000u);
            s2 += qs[w][64 + d] * __uint_as_float(u2 << 16) + qs[w][64 + d + 1] * __uint_as_float(u2 & 0xffff0000u); }
        s1 = valid ? s1 * 0.125f : -INFINITY; s2 = valid ? s2 * 0.125f : -INFINITY;
        const float m1n = fmaxf(m1, wave_max(s1)), m2n = fmaxf(m2, wave_max(s2));
        const float f1 = expf(m1 - m1n), f2 = expf(m2 - m2n);
        const float p1 = expf(s1 - m1n), p2 = expf(s2 - m2n);
        l1 = l1 * f1 + wave_sum(p1); l2 = l2 * f2 + wave_sum(p2);
        o1a *= f1; o1b *= f1; o2a *= f2; o2b *= f2; m1 = m1n; m2 = m2n;
        const bf16* vr = Z + (rowb + (size_t)ch * 64) * DIN + ZC_V + h * 128 + 2 * lane;
#pragma unroll 8
        for (int j = 0; j < 64; ++j) { const unsigned vv = *(const unsigned*)(vr + (size_t)j * DIN); const float va = __uint_as_float(vv << 16), vb = __uint_as_float(vv & 0xffff0000u);
            const float pj1 = __shfl(p1, j), pj2 = __shfl(p2, j);
            o1a += pj1 * va; o1b += pj1 * vb; o2a += pj2 * va; o2b += pj2 * vb; }
    }
    const float oa = o1a / l1 - lam * (o2a / l2), ob = o1b / l1 - lam * (o2b / l2);
    const float ms = wave_sum(oa * oa + ob * ob) * (1.0f / 128.0f);
    const float rs = rsqrtf(ms + EPS) * (1.0f - lambda_init);
    const unsigned o = pg8::cvt_pk_bf16(oa * rs * subg[2 * lane], ob * rs * subg[2 * lane + 1]);
    *(unsigned*)(MIX + row * DM + 512 + h * 128 + 2 * lane) = o;
}


namespace att {
typedef short bf16x8 __attribute__((ext_vector_type(8)));
typedef short s16x4 __attribute__((ext_vector_type(4)));
typedef float f32x16 __attribute__((ext_vector_type(16)));
typedef LAS const unsigned char* lds_cptr;
constexpr int KSLOT = 8192, VSLOT = 16384, NSLOT = 3;
constexpr int L_K = 0, L_V = NSLOT * KSLOT, L_WS = L_V + NSLOT * VSLOT, L_O0 = L_WS + NWAVES * 256, L_END = L_O0 + NWAVES * 8192;
constexpr float C2 = 0.125f * 1.4426950408889634f;
constexpr float THR = 8.0f;
__device__ __forceinline__ int crow(int r, int hi) { return (r & 3) + 8 * (r >> 2) + 4 * hi; }
__device__ __forceinline__ void glds16(const void* gsrc, unsigned lds_dst) { unsigned keep;
    asm volatile("s_mov_b32 %0, m0\n\ts_mov_b32 m0, %2\n\ts_nop 0\n\tglobal_load_lds_dwordx4 %1, off\n\ts_mov_b32 m0, %0" : "=&s"(keep) : "v"(gsrc), "s"(lds_dst) : "memory"); }
#define ATT_WAIT_BAR(N) asm volatile("s_waitcnt vmcnt(" #N ") lgkmcnt(0)\n\ts_barrier" ::: "memory")
__device__ __forceinline__ float merge_max32(float m) { auto rr = __builtin_amdgcn_permlane32_swap(__float_as_uint(m), __float_as_uint(m), false, false); return fmaxf(__uint_as_float(rr[0]), __uint_as_float(rr[1])); }
__device__ __forceinline__ float merge_sum32(float m) { auto rr = __builtin_amdgcn_permlane32_swap(__float_as_uint(m), __float_as_uint(m), false, false); return __uint_as_float(rr[0]) + __uint_as_float(rr[1]); }
__device__ __forceinline__ s16x4 vtr(lds_cptr p) { typedef short v4i16_t __attribute__((ext_vector_type(4))); return __builtin_bit_cast(s16x4, __builtin_amdgcn_ds_read_tr16_b64_v4i16((LAS v4i16_t*)p)); }

__device__ __forceinline__ void attn_pass(f32x16 (&o)[4], const bf16* Qw, const bf16* Kh, const bf16* Vh, LAS unsigned char* shm, int NT, int tmax, int wid, int lane) {
    const int r32 = lane & 31, hi = lane >> 5;
    const unsigned lds0 = (unsigned)(size_t)shm;
    LAS float* wsf = (LAS float*)(shm + L_WS) + wid * 64;
    const bf16* ksrc = Kh + (size_t)lane * DIN + wid * 8;
    const bf16* vsrc = Vh + (size_t)(16 * (wid & 3) + (lane >> 2)) * DIN + (wid >> 2) * 32 + (lane & 3) * 8;
    const unsigned kdst = lds0 + L_K + wid * 1024, vdst = lds0 + L_V + wid * 1024;
#define ATT_DMA(t, slot) do { const size_t go_ = (size_t)(t) * 64 * DIN; \
        glds16(ksrc + go_, (unsigned)__builtin_amdgcn_readfirstlane(kdst + (slot) * KSLOT)); \
        glds16(vsrc + go_, (unsigned)__builtin_amdgcn_readfirstlane(vdst + (slot) * VSLOT)); \
        glds16(vsrc + go_ + 64, (unsigned)__builtin_amdgcn_readfirstlane(vdst + (slot) * VSLOT + 8192)); } while (0)
    ATT_DMA(0, 0); ATT_DMA(1, 1);
    bf16x8 qr[4];
#pragma unroll
    for (int d0 = 0; d0 < 4; ++d0) qr[d0] = *(const bf16x8*)(Qw + d0 * 16 + hi * 8);
    float mhat = 0.f, l_reg = 0.f;
    f32x16 negm = {};
#pragma unroll
    for (int db = 0; db < 4; ++db) o[db] = f32x16{};
    int slot = 0;
    const lds_cptr kp0 = (lds_cptr)shm + L_K + hi * 1024 + r32 * 16;
    const lds_cptr vp0 = (lds_cptr)shm + L_V + ((lane >> 4) & 1) * 32 + (lane & 3) * 8 + (4 * hi + ((lane & 15) >> 2)) * 64;
    for (int t = 0; t < NT; ++t) {
        if (t + 1 < NT) ATT_WAIT_BAR(3); else ATT_WAIT_BAR(0);
        if (t + 2 < NT) { const int s2 = (slot + 2 >= NSLOT) ? slot + 2 - NSLOT : slot + 2; ATT_DMA(t + 2, s2); }
        if (t <= tmax) {
            const lds_cptr kp = kp0 + slot * KSLOT;
            f32x16 p0 = negm, p1 = negm;
#pragma unroll
            for (int d0 = 0; d0 < 4; ++d0) {
                const bf16x8 b0 = *(const LAS bf16x8*)(kp + d0 * 2048), b1 = *(const LAS bf16x8*)(kp + d0 * 2048 + 512);
                p0 = __builtin_amdgcn_mfma_f32_32x32x16_bf16(b0, qr[d0], p0, 0, 0, 0);
                p1 = __builtin_amdgcn_mfma_f32_32x32x16_bf16(b1, qr[d0], p1, 0, 0, 0);
            }
            float rm = fmaxf(p0[0], p1[0]);
#pragma unroll
            for (int r = 1; r < 16; ++r) rm = fmaxf(rm, fmaxf(p0[r], p1[r]));
            rm = merge_max32(rm);
            const bool first = (t == 0);
            if (first || __any(rm > THR)) {
                const float dl = first ? rm : fmaxf(rm, 0.f);
                mhat += dl;
#pragma unroll
                for (int r = 0; r < 16; ++r) { p0[r] -= dl; p1[r] -= dl; negm[r] = -mhat; }
                if (!first) {
                    const float f = __builtin_amdgcn_exp2f(-dl); l_reg *= f;
                    if (hi == 0) wsf[r32] = f;
                    asm volatile("s_waitcnt lgkmcnt(0)" ::: "memory");
#pragma unroll
                    for (int g = 0; g < 4; ++g) { const f32x4 fv = *(const LAS f32x4*)(wsf + 8 * g + 4 * hi);
#pragma unroll
                        for (int i = 0; i < 4; ++i)
#pragma unroll
                            for (int db = 0; db < 4; ++db) o[db][4 * g + i] *= fv[i]; }
                }
            }
            float sacc = 0.f;
#pragma unroll
            for (int r = 0; r < 16; ++r) { p0[r] = __builtin_amdgcn_exp2f(p0[r]); p1[r] = __builtin_amdgcn_exp2f(p1[r]); sacc += p0[r] + p1[r]; }
            l_reg += sacc;
            bf16x8 pa[4];
#pragma unroll
            for (int s = 0; s < 4; ++s) { u32x4_t w;
                if (s < 2) { w.x = pg8::cvt_pk_bf16(p0[8 * s + 0], p0[8 * s + 1]); w.y = pg8::cvt_pk_bf16(p0[8 * s + 2], p0[8 * s + 3]); w.z = pg8::cvt_pk_bf16(p0[8 * s + 4], p0[8 * s + 5]); w.w = pg8::cvt_pk_bf16(p0[8 * s + 6], p0[8 * s + 7]); }
                else { const int q = s - 2; w.x = pg8::cvt_pk_bf16(p1[8 * q + 0], p1[8 * q + 1]); w.y = pg8::cvt_pk_bf16(p1[8 * q + 2], p1[8 * q + 3]); w.z = pg8::cvt_pk_bf16(p1[8 * q + 4], p1[8 * q + 5]); w.w = pg8::cvt_pk_bf16(p1[8 * q + 6], p1[8 * q + 7]); }
                pa[s] = __builtin_bit_cast(bf16x8, w); }
            const lds_cptr vp = vp0 + slot * VSLOT;
#pragma unroll
            for (int db = 0; db < 4; ++db)
#pragma unroll
                for (int ks = 0; ks < 4; ++ks) {
                    const s16x4 lo = vtr(vp + db * 4096 + ks * 1024), hh = vtr(vp + db * 4096 + ks * 1024 + 512);
                    const bf16x8 vf = {lo[0], lo[1], lo[2], lo[3], hh[0], hh[1], hh[2], hh[3]};
                    o[db] = __builtin_amdgcn_mfma_f32_32x32x16_bf16(pa[ks], vf, o[db], 0, 0, 0);
                }
        }
        slot = (slot + 1 == NSLOT) ? 0 : slot + 1;
    }
    ATT_WAIT_BAR(0);
    l_reg = merge_sum32(l_reg);
    if (hi == 0) wsf[32 + r32] = 1.0f / l_reg;
    asm volatile("s_waitcnt lgkmcnt(0)" ::: "memory");
#pragma unroll
    for (int g = 0; g < 4; ++g) { const f32x4 fv = *(const LAS f32x4*)(wsf + 32 + 8 * g + 4 * hi);
#pragma unroll
        for (int i = 0; i < 4; ++i)
#pragma unroll
            for (int db = 0; db < 4; ++db) o[db][4 * g + i] *= fv[i]; }
    asm volatile("s_waitcnt lgkmcnt(0)" ::: "memory");
#undef ATT_DMA
}

__device__ __forceinline__ void attn_unit(int b, int h, int qb, const bf16* Z, bf16* MIX, LAS unsigned char* shm, float lam, float out_scale, const float* subg) {
    const int tid = threadIdx.x, lane = tid & 63, r32 = lane & 31, hi = lane >> 5; const int wid = __builtin_amdgcn_readfirstlane(tid >> 6);
    const size_t rowbase = (size_t)b * SEQ; const int q0 = qb * 256;
    const int NT = 4 * qb + 4, tmax = 4 * qb + (wid >> 1);
    const bf16* Qw = Z + (rowbase + q0 + wid * 32 + r32) * DIN + ZC_Q + h * 128;
    const bf16* Kh = Z + rowbase * DIN + ZC_K + h * 128;
    const bf16* Vh = Z + rowbase * DIN + ZC_V + h * 128;
    LAS unsigned* sv = (LAS unsigned*)(shm + L_O0 + wid * 8192);
    f32x16 o[4];
    attn_pass(o, Qw, Kh, Vh, shm, NT, tmax, wid, lane);
#pragma unroll
    for (int db = 0; db < 4; ++db)
#pragma unroll
        for (int r2 = 0; r2 < 8; ++r2) sv[(db * 8 + r2) * 64 + lane] = pg8::cvt_pk_bf16(o[db][2 * r2], o[db][2 * r2 + 1]);
    attn_pass(o, Qw + 64, Kh + 64, Vh, shm, NT, tmax, wid, lane);
    asm volatile("s_waitcnt lgkmcnt(0)" ::: "memory");
    float ssq[16];
#pragma unroll
    for (int r = 0; r < 16; ++r) ssq[r] = 0.f;
#pragma unroll
    for (int db = 0; db < 4; ++db)
#pragma unroll
        for (int r2 = 0; r2 < 8; ++r2) { const unsigned w = sv[(db * 8 + r2) * 64 + lane];
            const float a0 = __uint_as_float(w << 16), a1 = __uint_as_float(w & 0xffff0000u);
            const float v0 = a0 - lam * o[db][2 * r2], v1 = a1 - lam * o[db][2 * r2 + 1];
            o[db][2 * r2] = v0; o[db][2 * r2 + 1] = v1; ssq[2 * r2] += v0 * v0; ssq[2 * r2 + 1] += v1 * v1; }
#pragma unroll
    for (int r = 0; r < 16; ++r) {
#pragma unroll
        for (int off = 1; off < 32; off <<= 1) ssq[r] += __shfl_xor(ssq[r], off);
        ssq[r] = rsqrtf(ssq[r] * (1.0f / 128.0f) + EPS) * out_scale; }
    bf16* Ow = MIX + (rowbase + q0 + wid * 32) * DM + 512 + h * 128 + r32;
#pragma unroll
    for (int db = 0; db < 4; ++db) { const float gsc = subg[32 * db + r32];
#pragma unroll
        for (int r = 0; r < 16; ++r) Ow[(size_t)crow(r, hi) * DM + 32 * db] = f2bf(o[db][r] * ssq[r] * gsc); }
    asm volatile("s_waitcnt lgkmcnt(0)" ::: "memory");
}
#undef ATT_WAIT_BAR
}

constexpr int PK_LDS = 147456;
__global__ void __launch_bounds__(512, 2) k_attn(const bf16* Z, bf16* MIX, const float* lq1, const float* lk1, const float* lq2, const float* lk2, const float* subg, float lambda_init) {
    extern __shared__ __attribute__((aligned(16))) unsigned char lds[];
    const int lane = threadIdx.x & 63; const int G = gridDim.x, bx = blockIdx.x;
    const int vcu = (G % 8 == 0) ? (bx % 8) * (G / 8) + bx / 8 : bx;
    const float lam = expf(wave_sum(lq1[lane] * lk1[lane])) - expf(wave_sum(lq2[lane] * lk2[lane])) + lambda_init;
    for (int p = vcu; p < 256; p += G) {
        const int bh = p >> 4, s = p & 15;
        att::attn_unit(bh >> 2, bh & 3, s, Z, MIX, (LAS unsigned char*)lds, lam, 1.0f - lambda_init, subg);
        att::attn_unit(bh >> 2, bh & 3, 31 - s, Z, MIX, (LAS unsigned char*)lds, lam, 1.0f - lambda_init, subg);
    }
}


namespace lru {
typedef short bf16x8 __attribute__((ext_vector_type(8)));
typedef float f32x16 __attribute__((ext_vector_type(16)));
constexpr int NCH = SEQ / 64;
constexpr int WLDS = 64 * 144;
constexpr float LOG2E = 1.4426950408889634f;
__device__ __forceinline__ float sigm(float x) { return __builtin_amdgcn_rcpf(1.0f + __builtin_amdgcn_exp2f(-LOG2E * x)); }
__device__ __forceinline__ float one_minus_exp(float x) {
    if (x > -0.25f) { float p = 1.0f + x * (1.0f / 7.0f); p = 1.0f + x * (1.0f / 6.0f) * p; p = 1.0f + x * 0.2f * p; p = 1.0f + x * 0.25f * p; p = 1.0f + x * (1.0f / 3.0f) * p; p = 1.0f + x * 0.5f * p; return -x * p; }
    return 1.0f - __builtin_amdgcn_exp2f(LOG2E * x);
}
struct Par { const float* cw; const float* cb; const float* wa; const float* ba; const float* wx; const float* bx; const float* lam; };
__device__ __forceinline__ void load_gate_frags(bf16x8 (&wf)[8], const float* W  , int lane) {
    const int r32 = lane & 31, hi = lane >> 5;
#pragma unroll
    for (int ks = 0; ks < 4; ++ks)
#pragma unroll
        for (int nb = 0; nb < 2; ++nb) { const float* p = W + (size_t)(16 * ks + 8 * hi) * 64 + 32 * nb + r32; u32x4_t w;
            w.x = pg8::cvt_pk_bf16(p[0 * 64], p[1 * 64]); w.y = pg8::cvt_pk_bf16(p[2 * 64], p[3 * 64]); w.z = pg8::cvt_pk_bf16(p[4 * 64], p[5 * 64]); w.w = pg8::cvt_pk_bf16(p[6 * 64], p[7 * 64]);
            wf[ks * 2 + nb] = __builtin_bit_cast(bf16x8, w); }
}
template <int PASS>
__device__ __forceinline__ void item(int b, int ch, int n, const bf16* Z, const Par& P, const bf16x8 (&wfa)[8], const bf16x8 (&wfx)[8], float2* AGG, bf16* MIX, LAS unsigned char* wl, int lane) {
    const int r32 = lane & 31, hi = lane >> 5, c = n * 64 + lane;
    const size_t row0 = (size_t)b * SEQ + (size_t)ch * 64;
    const float cw0 = P.cw[c], cw1 = P.cw[LRU_W + c], cw2 = P.cw[2 * LRU_W + c], cw3 = P.cw[3 * LRU_W + c], cbv = P.cb[c];
    const float bav = P.ba[c], bxv = P.bx[c];
    const float L = P.lam[c]; const float sp = log1pf(__expf(-L));
    const float ka = -8.0f * sp;
    const bf16* zc = Z + row0 * DIN + ZC_XR + c;
    float xm3 = 0.f, xm2 = 0.f, xm1 = 0.f;
    if (ch > 0) { xm3 = bf2f(zc[-3 * DIN]); xm2 = bf2f(zc[-2 * DIN]); xm1 = bf2f(zc[-1 * DIN]); }
    float carry = 0.f;
    if (PASS == 2) {
        const float2* ag = AGG + ((size_t)b * NCH) * LRU_W + c;
        for (int cc = 0; cc < ch; cc += 8) { float2 v[8];
#pragma unroll
            for (int j = 0; j < 8; ++j) { const int ci = (cc + j < ch) ? cc + j : ch - 1; v[j] = ag[(size_t)ci * LRU_W]; }
#pragma unroll
            for (int j = 0; j < 8; ++j) { const bool ok = cc + j < ch; carry = ok ? v[j].x * carry + v[j].y : carry; } }
    }
    float h = carry, aprod = 1.0f;
    const bf16* yc = Z + row0 * DIN + ZC_YR + c;
    bf16* oc = MIX + row0 * DM + c;
#pragma unroll 1
    for (int th = 0; th < 2; ++th) {
        float xc[32];
#pragma unroll
        for (int t = 0; t < 32; ++t) { const float xv = bf2f(zc[(size_t)(th * 32 + t) * DIN]); xc[t] = cbv + cw0 * xm3 + cw1 * xm2 + cw2 * xm1 + cw3 * xv; xm3 = xm2; xm2 = xm1; xm1 = xv; }
#pragma unroll
        for (int t = 0; t < 32; ++t) ((LAS bf16*)(wl + (th * 32 + t) * 144))[lane] = f2bf(xc[t]);
        asm volatile("s_waitcnt lgkmcnt(0)" ::: "memory");
        f32x16 ga[2], gx[2];
        ga[0] = f32x16{}; ga[1] = f32x16{}; gx[0] = f32x16{}; gx[1] = f32x16{};
#pragma unroll
        for (int ks = 0; ks < 4; ++ks) { const bf16x8 af = *(const LAS bf16x8*)(wl + (th * 32 + r32) * 144 + (ks * 16 + hi * 8) * 2);
#pragma unroll
            for (int nb = 0; nb < 2; ++nb) { ga[nb] = __builtin_amdgcn_mfma_f32_32x32x16_bf16(af, wfa[ks * 2 + nb], ga[nb], 0, 0, 0); gx[nb] = __builtin_amdgcn_mfma_f32_32x32x16_bf16(af, wfx[ks * 2 + nb], gx[nb], 0, 0, 0); } }
#pragma unroll
        for (int r = 0; r < 16; ++r) {
            auto s1 = __builtin_amdgcn_permlane32_swap(__float_as_uint(ga[0][r]), __float_as_uint(ga[1][r]), false, false); ga[0][r] = __uint_as_float(s1[0]); ga[1][r] = __uint_as_float(s1[1]);
            auto s2 = __builtin_amdgcn_permlane32_swap(__float_as_uint(gx[0][r]), __float_as_uint(gx[1][r]), false, false); gx[0][r] = __uint_as_float(s2[0]); gx[1][r] = __uint_as_float(s2[1]); }
#pragma unroll
        for (int g = 0; g < 4; ++g)
#pragma unroll
            for (int hf = 0; hf < 2; ++hf)
#pragma unroll
                for (int i = 0; i < 4; ++i) { const int tl = 8 * g + 4 * hf + i, tok = th * 32 + tl;
                    const float r = sigm(ga[hf][4 * g + i] + bav), ig = sigm(gx[hf][4 * g + i] + bxv);
                    const float la = ka * r; const float a = __builtin_amdgcn_exp2f(LOG2E * la); const float mult = __builtin_amdgcn_sqrtf(one_minus_exp(2.0f * la));
                    h = a * h + mult * (ig * xc[tl]);
                    if (PASS == 1) aprod *= a;
                    else { const float y = bf2f(yc[(size_t)tok * DIN]); oc[(size_t)tok * DM] = f2bf(h * gelu_tanh(y)); } }
    }
    if (PASS == 1) AGG[((size_t)b * NCH + ch) * LRU_W + c] = make_float2(aprod, h);
    asm volatile("s_waitcnt lgkmcnt(0)" ::: "memory");
}
template <int PASS>
__device__ __forceinline__ void phase(const bf16* Z, const Par& P, float2* AGG, bf16* MIX, LAS unsigned char* lds, int vcu, int G) {
    const int lane = threadIdx.x & 63; const int wid = __builtin_amdgcn_readfirstlane(threadIdx.x >> 6);
    bf16x8 wfa[8], wfx[8];
    load_gate_frags(wfa, P.wa + (size_t)wid * 64 * 64, lane); load_gate_frags(wfx, P.wx + (size_t)wid * 64 * 64, lane);
    for (int bc = vcu; bc < NB * NCH; bc += G) item<PASS>(bc / NCH, bc % NCH, wid, Z, P, wfa, wfx, AGG, MIX, lds + wid * WLDS, lane);
}
}
template <int PASS>
__global__ void __launch_bounds__(512, 2) k_lru(const bf16* Z, lru::Par P, float2* AGG, bf16* MIX) {
    extern __shared__ __attribute__((aligned(16))) unsigned char lds[];
    const int G = gridDim.x, bx = blockIdx.x; const int vcu = (G % 8 == 0) ? (bx % 8) * (G / 8) + bx / 8 : bx;
    lru::phase<PASS>(Z, P, AGG, MIX, (LAS unsigned char*)lds, vcu, G);
}

template <class Epi>
__global__ void __launch_bounds__(512, 2) k_gemm(pg8::Gemm g, Epi E) {
    extern __shared__ __attribute__((aligned(16))) unsigned char lds[];
    pg8::StaticOrder S; S.init(g.M, g.N, gridDim.x, blockIdx.x);
    pg8::gemm_phase<Epi, pg8::StaticOrder, true, true>((PG8_LAS unsigned char*)lds, g, S, E);
}

extern "C" void kernel_launch(void* const* d_in, const int* in_sizes, int n_in, void* d_out, int out_size, void* d_ws, size_t ws_size, hipStream_t stream) {
    static int grid = 0;
    if (grid == 0) {
        if (n_in != 29 || in_sizes[0] != MROWS * DM || out_size != MROWS * DM || ws_size < WS_END) { fprintf(stderr, "kernel_launch: unexpected shapes / workspace (n_in %d, ws %zu); nothing launched\n", n_in, ws_size); grid = -1; return; }
        int dev = 0, cus = 0;
        if (hipGetDevice(&dev) != hipSuccess || hipDeviceGetAttribute(&cus, hipDeviceAttributeMultiprocessorCount, dev) != hipSuccess) { grid = -1; return; }
        (void)hipFuncSetAttribute((const void*)k_gemm<pg8::EpiStoreBf16>, hipFuncAttributeMaxDynamicSharedMemorySize, GEMM_LDS);
        (void)hipFuncSetAttribute((const void*)k_gemm<pg8::EpiSwiglu>, hipFuncAttributeMaxDynamicSharedMemorySize, GEMM_LDS);
        (void)hipFuncSetAttribute((const void*)k_gemm<pg8::EpiResid>, hipFuncAttributeMaxDynamicSharedMemorySize, GEMM_LDS);
        (void)hipFuncSetAttribute((const void*)k_attn, hipFuncAttributeMaxDynamicSharedMemorySize, PK_LDS);
        (void)hipFuncSetAttribute((const void*)k_lru<1>, hipFuncAttributeMaxDynamicSharedMemorySize, PK_LDS);
        (void)hipFuncSetAttribute((const void*)k_lru<2>, hipFuncAttributeMaxDynamicSharedMemorySize, PK_LDS);
        grid = cus;
    }
    if (grid < 0) return;
    const float* x_in = (const float*)d_in[0]; const float* c_in = (const float*)d_in[1]; const int* pos = (const int*)d_in[2];
    const float* ada_w = (const float*)d_in[3]; const float* ada_b = (const float*)d_in[4]; const float* ln1_g = (const float*)d_in[5]; const float* ln2_g = (const float*)d_in[6];
    const float* w_in = (const float*)d_in[7]; const float* conv_w = (const float*)d_in[8]; const float* conv_b = (const float*)d_in[9];
    const float* gate_a_w = (const float*)d_in[10]; const float* gate_a_b = (const float*)d_in[11]; const float* gate_x_w = (const float*)d_in[12]; const float* gate_x_b = (const float*)d_in[13];
    const float* lru_lambda = (const float*)d_in[14]; const float* lam_q1 = (const float*)d_in[15]; const float* lam_k1 = (const float*)d_in[16]; const float* lam_q2 = (const float*)d_in[17]; const float* lam_k2 = (const float*)d_in[18];
    const float* subln_g = (const float*)d_in[19]; const float* w_out = (const float*)d_in[20];
    const float* ffn_wg = (const float*)d_in[21]; const float* ffn_wu = (const float*)d_in[22]; const float* ffn_wd = (const float*)d_in[23];
    const float* moe_router = (const float*)d_in[24]; const float* moe_wg = (const float*)d_in[25]; const float* moe_wu = (const float*)d_in[26]; const float* moe_wd = (const float*)d_in[27];
    const float* final_g = (const float*)d_in[28];
    unsigned char* ws = (unsigned char*)d_ws; float* xr = (float*)d_out;
    bf16* Win = (bf16*)(ws + WS_WIN); bf16* Wout = (bf16*)(ws + WS_WOUT); bf16* Wgu = (bf16*)(ws + WS_WGU); bf16* Wd = (bf16*)(ws + WS_WD); bf16* Mgu = (bf16*)(ws + WS_MGU); bf16* Md = (bf16*)(ws + WS_MD);
    float* MOD = (float*)(ws + WS_MOD); float2* ROPE = (float2*)(ws + WS_ROPE); float* GATES = (float*)(ws + WS_GATES); float2* AGG = (float2*)(ws + WS_AGG);
    bf16* HB = (bf16*)(ws + WS_HB); float* XC = (float*)(ws + WS_HB); bf16* ZB = (bf16*)(ws + WS_ZB); bf16* MIX = (bf16*)(ws + WS_MIX); bf16* ACT = (bf16*)(ws + WS_ACT);
    const int TG = 1024;
    for (int l = 0; l < DEPTH; ++l) {
        k_transpose<<<TG, 256, 0, stream>>>(w_in + (size_t)l * DM * DIN, DM, DIN, Win + (size_t)l * DIN * DM, 0);
        k_transpose<<<TG, 256, 0, stream>>>(w_out + (size_t)l * DM * DM, DM, DM, Wout + (size_t)l * DM * DM, 0);
    }
    k_transpose<<<TG, 256, 0, stream>>>(ffn_wg, DM, DFF, Wgu, 1);
    k_transpose<<<TG, 256, 0, stream>>>(ffn_wu, DM, DFF, Wgu, 2);
    k_transpose<<<TG, 256, 0, stream>>>(ffn_wd, DFF, DM, Wd, 0);
    for (int e = 0; e < NEXP; ++e) {
        k_transpose<<<TG, 256, 0, stream>>>(moe_wg + (size_t)e * DM * DFF, DM, DFF, Mgu + (size_t)e * 2 * DFF * DM, 1);
        k_transpose<<<TG, 256, 0, stream>>>(moe_wu + (size_t)e * DM * DFF, DM, DFF, Mgu + (size_t)e * 2 * DFF * DM, 2);
        k_transpose<<<TG, 256, 0, stream>>>(moe_wd + (size_t)e * DFF * DM, DFF, DM, Md + (size_t)e * DM * DFF, 0);
    }
    k_mod<<<(DEPTH * NMOD + 255) / 256, 256, 0, stream>>>(c_in, ada_w, ada_b, MOD);
    k_rope_tbl<<<MROWS * 32 / 256, 256, 0, stream>>>(pos, ROPE);
    const float* xcur = x_in;
    for (int l = 0; l < DEPTH; ++l) {
        const float lambda_init = 0.8f - 0.6f * expf(-0.3f * (float)l);
        const float* modl = MOD + (size_t)l * NB * NMOD;
        k_norm_mod<<<2048, 256, 0, stream>>>(xcur, ln1_g + l * DM, modl, 0, DM, HB, nullptr, nullptr);
        { pg8::Gemm g{HB, Win + (size_t)l * DIN * DM, MROWS, DIN, DM, 0}; pg8::EpiStoreBf16 E{ZB, DIN, 0};
          k_gemm<pg8::EpiStoreBf16><<<grid, 512, GEMM_LDS, stream>>>(g, E); }
        k_rope_naive<<<MROWS * 16 * 32 / 256, 256, 0, stream>>>(ZB, ROPE);
        { lru::Par P{conv_w + l * 4 * LRU_W, conv_b + l * LRU_W, gate_a_w + (size_t)l * 8 * 64 * 64, gate_a_b + l * LRU_W, gate_x_w + (size_t)l * 8 * 64 * 64, gate_x_b + l * LRU_W, lru_lambda + l * LRU_W};
          k_lru<1><<<grid, 512, PK_LDS, stream>>>(ZB, P, AGG, MIX);
          k_lru<2><<<grid, 512, PK_LDS, stream>>>(ZB, P, AGG, MIX); }
        k_attn<<<grid, 512, PK_LDS, stream>>>(ZB, MIX, lam_q1 + l * 64, lam_k1 + l * 64, lam_q2 + l * 64, lam_k2 + l * 64, subln_g + l * 128, lambda_init);
        { pg8::Gemm g{MIX, Wout + (size_t)l * DM * DM, MROWS, DM, DM, 0}; pg8::EpiResid E{xcur, xr, modl + 2 * DM, nullptr, DM, NMOD, SEQ, 0};
          k_gemm<pg8::EpiResid><<<grid, 512, GEMM_LDS, stream>>>(g, E); }
        xcur = xr;
        if (l % 2 == 0) {
            k_norm_mod<<<2048, 256, 0, stream>>>(xr, ln2_g + l * DM, modl, 3 * DM, 4 * DM, HB, nullptr, nullptr);
            { pg8::Gemm g{HB, Wgu, MROWS, 2 * DFF, DM, 0}; pg8::EpiSwiglu E{ACT, DFF, 0};
              k_gemm<pg8::EpiSwiglu><<<grid, 512, GEMM_LDS, stream>>>(g, E); }
            { pg8::Gemm g{ACT, Wd, MROWS, DM, DFF, 0}; pg8::EpiResid E{xr, xr, modl + 5 * DM, nullptr, DM, NMOD, SEQ, 0};
              k_gemm<pg8::EpiResid><<<grid, 512, GEMM_LDS, stream>>>(g, E); }
        } else {
            const int j = l / 2;
            k_norm_mod<<<2048, 256, 0, stream>>>(xr, ln2_g + l * DM, modl, 3 * DM, 4 * DM, HB, moe_router + (size_t)j * DM * NEXP, GATES);
            for (int e = 0; e < NEXP; ++e) {
                { pg8::Gemm g{HB, Mgu + (size_t)e * 2 * DFF * DM, MROWS, 2 * DFF, DM, 0}; pg8::EpiSwiglu E{ACT, DFF, 0};
                  k_gemm<pg8::EpiSwiglu><<<grid, 512, GEMM_LDS, stream>>>(g, E); }
                { pg8::Gemm g{ACT, Md + (size_t)e * DM * DFF, MROWS, DM, DFF, 0}; pg8::EpiResid E{xr, xr, modl + 5 * DM, GATES + e, DM, NMOD, SEQ, NEXP};
                  k_gemm<pg8::EpiResid><<<grid, 512, GEMM_LDS, stream>>>(g, E); }
            }
        }
    }
    k_final<<<2048, 256, 0, stream>>>(xr, final_g);
}
```

```cpp
#include <hip/hip_runtime.h>
#include <cstdio>
#include <cstdint>

namespace pg8 {
#define PG8_LAS __attribute__((address_space(3)))
typedef unsigned short bf16_t;
typedef short bf16x8 __attribute__((ext_vector_type(8)));
typedef float f32x4 __attribute__((ext_vector_type(4)));
typedef unsigned u32x4 __attribute__((ext_vector_type(4)));
constexpr int BM = 256, BK = 64, HALF = 128, HTB = HALF * BK * 2, STAGE_BYTES = 8 * HTB, NXCD = 8, WGM = 8;

__host__ __device__ __forceinline__ int lds_byte(int r, int c) { const int st = (r >> 4) * 2 + (c >> 5), rr = r & 15, cc = c & 31, ob = rr * 64 + cc * 2; return st * 1024 + (ob ^ (((ob >> 9) & 1) << 5)); }
__host__ __device__ __forceinline__ void stage_rc(int b, int& R, int& C) { const int st = b / 1024, sb = b % 1024, swz = sb ^ (((sb >> 9) & 1) << 5); R = (st >> 1) * 16 + swz / 64; C = (st & 1) * 32 + (swz % 64) / 2; }
__host__ __device__ __forceinline__ int perm32(int rho) { const int n = rho >> 4, i = rho & 15; return 8 * (i >> 2) + 4 * n + (i & 3); }

struct Unit { int pm, pn, pe; };
struct Gemm { const bf16_t* A; const bf16_t* Bt; size_t estride; int M, N, K, pad; };

struct StaticOrder {
    int nM, nN, nwg, G, c;
    __host__ __device__ void init(int M, int N, int G_, int c_) { nM = M / BM; nN = N / BM; nwg = nM * nN; G = G_; c = c_; }
    __host__ __device__ bool next(int i, Unit& u) const {
        const long L = (long)i * G + c; if (L >= nwg) return false;
        int wgid = (int)L; { const int q = nwg / NXCD, r = nwg % NXCD, xcd = wgid % NXCD, off = wgid / NXCD; wgid = (xcd < r ? xcd * (q + 1) : r * (q + 1) + (xcd - r) * q) + off; }
        const int nig = WGM * nN, gid = wgid / nig, fm = gid * WGM, gsz = (nM - fm) < WGM ? (nM - fm) : WGM;
        u.pm = fm + ((wgid % nig) % gsz); u.pn = (wgid % nig) / gsz; u.pe = 0; return true;
    }
    __device__ __forceinline__ void a_ready(const Unit&) const {}
    __device__ __forceinline__ void done(const Unit&) const {}
};
struct PanelOrder {
    StaticOrder so; const int* tab;
    __device__ void init(int npanels, int N, int G_, int c_, const int* tab_) { so.init(npanels * BM, N, G_, c_); tab = tab_; }
    __device__ bool next(int i, Unit& u) const { if (!so.next(i, u)) return false; u.pe = tab[u.pm]; return true; }
    __device__ __forceinline__ void a_ready(const Unit&) const {}
    __device__ __forceinline__ void done(const Unit&) const {}
};

typedef float f32x2_t __attribute__((ext_vector_type(2))); typedef __bf16 bf16x2_t __attribute__((ext_vector_type(2)));
__device__ __forceinline__ unsigned cvt_pk_bf16(float lo, float hi) { f32x2_t v = {lo, hi}; bf16x2_t b = __builtin_convertvector(v, bf16x2_t); return __builtin_bit_cast(unsigned, b); }

struct EpiStoreBf16 {
    static constexpr bool PERM = true, AFTER_DRAIN = false;
    bf16_t* O; int ldc; int pad;
    __device__ __forceinline__ void operator()(const f32x4 (&acc)[2][2][4][2], const Unit& u, int wr, int wc, int fr, int fq) const {
        const int row0 = u.pm * BM + wr * 64 + fr; const int col0 = u.pn * BM + wc * 32 + 8 * fq;
#pragma unroll
        for (int ai = 0; ai < 2; ++ai)
#pragma unroll
            for (int m = 0; m < 4; ++m) { bf16_t* rowp = O + (size_t)(row0 + ai * HALF + m * 16) * ldc + col0;
#pragma unroll
                for (int bj = 0; bj < 2; ++bj) { const f32x4 v0 = acc[ai][bj][m][0], v1 = acc[ai][bj][m][1];
                    u32x4 w; w.x = cvt_pk_bf16(v0[0], v0[1]); w.y = cvt_pk_bf16(v0[2], v0[3]); w.z = cvt_pk_bf16(v1[0], v1[1]); w.w = cvt_pk_bf16(v1[2], v1[3]);
                    *(u32x4*)(rowp + bj * HALF) = w; } }
    }
};
__device__ __forceinline__ float silu_f(float x) { return x / (1.0f + __expf(-x)); }
struct EpiSwiglu {
    static constexpr bool PERM = true, AFTER_DRAIN = false;
    bf16_t* O; int ldc; int pad;
    __device__ __forceinline__ void operator()(const f32x4 (&acc)[2][2][4][2], const Unit& u, int wr, int wc, int fr, int fq) const {
        const int row0 = u.pm * BM + wr * 64 + fr; const int col0 = u.pn * HALF + wc * 32 + 8 * fq;
#pragma unroll
        for (int ai = 0; ai < 2; ++ai)
#pragma unroll
            for (int m = 0; m < 4; ++m) { bf16_t* rowp = O + (size_t)(row0 + ai * HALF + m * 16) * ldc + col0;
                float r[8];
#pragma unroll
                for (int n = 0; n < 2; ++n)
#pragma unroll
                    for (int i = 0; i < 4; ++i) r[n * 4 + i] = silu_f(acc[ai][0][m][n][i]) * acc[ai][1][m][n][i];
                u32x4 w; w.x = cvt_pk_bf16(r[0], r[1]); w.y = cvt_pk_bf16(r[2], r[3]); w.z = cvt_pk_bf16(r[4], r[5]); w.w = cvt_pk_bf16(r[6], r[7]);
                *(u32x4*)rowp = w; }
    }
};
struct EpiResid {
    static constexpr bool PERM = true, AFTER_DRAIN = false;
    const float* base; float* out; const float* gvec; const float* rowscale; int ldc; int gstride; int rows_per_batch; int rs_stride;
    __device__ __forceinline__ void operator()(const f32x4 (&acc)[2][2][4][2], const Unit& u, int wr, int wc, int fr, int fq) const {
        const int row0 = u.pm * BM + wr * 64 + fr; const int col0 = u.pn * BM + wc * 32 + 8 * fq;
        const float* gv = gvec + (size_t)((u.pm * BM) / rows_per_batch) * gstride + col0;
        f32x4 g[2][2];
#pragma unroll
        for (int bj = 0; bj < 2; ++bj)
#pragma unroll
            for (int n = 0; n < 2; ++n) g[bj][n] = *(const f32x4*)(gv + bj * HALF + 4 * n);
#pragma unroll
        for (int ai = 0; ai < 2; ++ai)
#pragma unroll
            for (int m = 0; m < 4; ++m) { const int row = row0 + ai * HALF + m * 16; const size_t off = (size_t)row * ldc + col0;
                const float rs = rowscale ? rowscale[(size_t)row * rs_stride] : 1.0f;
#pragma unroll
                for (int bj = 0; bj < 2; ++bj)
#pragma unroll
                    for (int n = 0; n < 2; ++n) { const f32x4 b = *(const f32x4*)(base + off + bj * HALF + 4 * n);
                        *(f32x4*)(out + off + bj * HALF + 4 * n) = b + g[bj][n] * rs * acc[ai][bj][m][n]; } }
    }
};

struct EpiScatter {
    static constexpr bool PERM = true, AFTER_DRAIN = false;
    float* out; const float* gvec; const int* slot_tok; const float* slot_w; int ldc; int gstride; int rows_per_batch; int pad;
    __device__ __forceinline__ void operator()(const f32x4 (&acc)[2][2][4][2], const Unit& u, int wr, int wc, int fr, int fq) const {
        const int row0 = u.pm * BM + wr * 64 + fr; const int col0 = u.pn * BM + wc * 32 + 8 * fq;
#pragma unroll
        for (int ai = 0; ai < 2; ++ai)
#pragma unroll
            for (int m = 0; m < 4; ++m) { const int slot = row0 + ai * HALF + m * 16; const int tok = slot_tok[slot];
                if (tok >= 0) { const float w = slot_w[slot]; const float* gv = gvec + (size_t)(tok / rows_per_batch) * gstride + col0; float* xo = out + (size_t)tok * ldc + col0;
#pragma unroll
                    for (int bj = 0; bj < 2; ++bj)
#pragma unroll
                        for (int n = 0; n < 2; ++n) { const f32x4 g = *(const f32x4*)(gv + bj * HALF + 4 * n); const f32x4 b = *(const f32x4*)(xo + bj * HALF + 4 * n);
                            *(f32x4*)(xo + bj * HALF + 4 * n) = b + g * w * acc[ai][bj][m][n]; } } }
    }
};

template <class Epi, class Sched, bool ALIGN_EPI = false, bool SP2 = false>
__device__ __forceinline__ void gemm_phase(PG8_LAS unsigned char* lds, const Gemm g, const Sched& S, const Epi& E) {
    const int tid = threadIdx.x, wid = __builtin_amdgcn_readfirstlane(tid >> 6), lane = tid & 63, wr = wid >> 2, wc = wid & 3, fr = lane & 15, fq = lane >> 4;
    const int K = g.K, nt = K / BK;
    unsigned voffA[2], voffB[2];
#pragma unroll
    for (int i = 0; i < 2; ++i) { int R, C; stage_rc(tid * 16 + i * 8192, R, C); const int Rb = Epi::PERM ? ((R & ~31) + perm32(R & 31)) : R;
        voffA[i] = (unsigned)(R * K + C) * 2u; voffB[i] = (unsigned)(Rb * K + C) * 2u; }
    const size_t kstep = (size_t)(BK * 2);
    const size_t hstep = (size_t)HALF * K * 2;
    const size_t tstep = 2 * hstep;
    const unsigned ldsw = (unsigned)wid * 1024u;
    const int aoff = lds_byte(wr * 64 + fr, fq * 8), boff = lds_byte(wc * 32 + fr, fq * 8);
#define PG8_SA(b, h) (((b) * 2 + (h)) * HTB)
#define PG8_SB(b, h) ((4 + (b) * 2 + (h)) * HTB)
#define PG8_STAGE(bufoff, gbase, voff) do { _Pragma("unroll") for (int _i = 0; _i < 2; ++_i) \
        __builtin_amdgcn_global_load_lds((const unsigned*)((const char*)(gbase) + (voff)[_i]), (PG8_LAS unsigned*)(lds + (bufoff) + ldsw + _i * 8192), 16, 0, 0); } while (0)
#define PG8_LDA(dst, b, h) do { _Pragma("unroll") for (int m = 0; m < 4; ++m) _Pragma("unroll") for (int k = 0; k < 2; ++k) dst[m][k] = *(const PG8_LAS bf16x8*)(lds + PG8_SA(b, h) + aoff + m * 2048 + k * 1024); } while (0)
#define PG8_LDB(dst, b, h) do { _Pragma("unroll") for (int n = 0; n < 2; ++n) _Pragma("unroll") for (int k = 0; k < 2; ++k) dst[n][k] = *(const PG8_LAS bf16x8*)(lds + PG8_SB(b, h) + boff + n * 2048 + k * 1024); } while (0)
#define PG8_MMA(ai, bj, At, Bt) do { __builtin_amdgcn_s_setprio(1); _Pragma("unroll") for (int m = 0; m < 4; ++m) _Pragma("unroll") for (int n = 0; n < 2; ++n) _Pragma("unroll") for (int k = 0; k < 2; ++k) \
        acc[ai][bj][m][n] = __builtin_amdgcn_mfma_f32_16x16x32_bf16(Bt[n][k], At[m][k], acc[ai][bj][m][n], 0, 0, 0); __builtin_amdgcn_s_setprio(0); } while (0)
#define PG8_WAIT_V(n) asm volatile("s_waitcnt vmcnt(" #n ")" ::: "memory")
#define PG8_WAIT_L(n) asm volatile("s_waitcnt lgkmcnt(" #n ")" ::: "memory")
#define PG8_BAR __builtin_amdgcn_s_barrier()
#define PG8_SCHED __builtin_amdgcn_sched_barrier(0)
    Unit cur, nxt; int ui = 0;
    if (!S.next(0, cur)) return;
    f32x4 acc[2][2][4][2];
#pragma unroll
    for (int a = 0; a < 2; ++a)
#pragma unroll
        for (int b = 0; b < 2; ++b)
#pragma unroll
            for (int m = 0; m < 4; ++m)
#pragma unroll
                for (int n = 0; n < 2; ++n) acc[a][b][m][n] = (f32x4){0.f, 0.f, 0.f, 0.f};
    bf16x8 At[4][2], B0[2][2], B1[2][2];
    const char* cA = (const char*)g.A + (size_t)cur.pm * tstep; const char* cB = (const char*)g.Bt + (size_t)cur.pe * g.estride + (size_t)cur.pn * tstep;
    S.a_ready(cur);
    if constexpr (SP2) {
        PG8_STAGE(PG8_SB(0, 0), cB, voffB); PG8_STAGE(PG8_SB(0, 1), cB + hstep, voffB); PG8_STAGE(PG8_SA(0, 0), cA, voffA); PG8_STAGE(PG8_SA(0, 1), cA + hstep, voffA);
        if (wr == 1) PG8_BAR;
        PG8_WAIT_V(2); PG8_BAR;
        PG8_STAGE(PG8_SB(1, 0), cB + kstep, voffB); PG8_STAGE(PG8_SA(1, 0), cA + kstep, voffA); PG8_STAGE(PG8_SB(1, 1), cB + hstep + kstep, voffB);
        PG8_WAIT_V(6); PG8_BAR;
    } else {
        PG8_STAGE(PG8_SB(0, 0), cB, voffB); PG8_STAGE(PG8_SA(0, 0), cA, voffA); PG8_STAGE(PG8_SB(0, 1), cB + hstep, voffB); PG8_STAGE(PG8_SA(0, 1), cA + hstep, voffA);
        if (wr == 1) PG8_BAR;
        PG8_WAIT_V(4); PG8_BAR;
        PG8_STAGE(PG8_SB(1, 0), cB + kstep, voffB); PG8_STAGE(PG8_SA(1, 0), cA + kstep, voffA); PG8_STAGE(PG8_SB(1, 1), cB + hstep + kstep, voffB);
        PG8_WAIT_V(6); PG8_BAR;
    }
    for (;;) {
        const bool has_next = S.next(ui + 1, nxt);
        const char* nA = has_next ? (const char*)g.A + (size_t)nxt.pm * tstep : cA; const char* nB = has_next ? (const char*)g.Bt + (size_t)nxt.pe * g.estride + (size_t)nxt.pn * tstep : cB;
        for (int t = 0; t < nt; t += 2) {
            const bool last = (t == nt - 2);
            const char* a1 = cA + (size_t)(t + 1) * kstep;
            const char* a2 = last ? nA : cA + (size_t)(t + 2) * kstep; const char* b2 = last ? nB : cB + (size_t)(t + 2) * kstep;
            const char* a3 = a2 + kstep; const char* b3 = b2 + kstep;
            if (last && has_next) S.a_ready(nxt);
            if constexpr (SP2) {
            PG8_LDB(B0, 0, 0); PG8_LDB(B1, 0, 1); PG8_SCHED; PG8_LDA(At, 0, 0); PG8_STAGE(PG8_SA(1, 1), a1 + hstep, voffA);
            PG8_WAIT_V(8); PG8_WAIT_L(0); PG8_BAR; PG8_MMA(0, 0, At, B0); PG8_MMA(0, 1, At, B1); PG8_BAR; PG8_SCHED;
            PG8_LDA(At, 0, 1); PG8_STAGE(PG8_SB(0, 0), b2, voffB); PG8_STAGE(PG8_SB(0, 1), b2 + hstep, voffB); PG8_STAGE(PG8_SA(0, 0), a2, voffA);
            PG8_WAIT_V(8); PG8_WAIT_L(0); PG8_BAR; PG8_MMA(1, 0, At, B0); PG8_MMA(1, 1, At, B1); PG8_BAR; PG8_SCHED;
            PG8_LDB(B0, 1, 0); PG8_LDB(B1, 1, 1); PG8_SCHED; PG8_LDA(At, 1, 0); PG8_STAGE(PG8_SA(0, 1), a2 + hstep, voffA);
            PG8_WAIT_V(8); PG8_WAIT_L(0); PG8_BAR; PG8_MMA(0, 0, At, B0); PG8_MMA(0, 1, At, B1); PG8_BAR; PG8_SCHED;
            PG8_LDA(At, 1, 1); PG8_STAGE(PG8_SB(1, 0), b3, voffB); PG8_STAGE(PG8_SB(1, 1), b3 + hstep, voffB); PG8_STAGE(PG8_SA(1, 0), a3, voffA);
            PG8_WAIT_V(8); PG8_WAIT_L(0); PG8_BAR; PG8_MMA(1, 0, At, B0); PG8_MMA(1, 1, At, B1); PG8_BAR; PG8_SCHED;
            } else {
            PG8_LDB(B0, 0, 0); PG8_SCHED; PG8_LDA(At, 0, 0); PG8_STAGE(PG8_SA(1, 1), a1 + hstep, voffA);
            PG8_WAIT_L(8); PG8_BAR; PG8_WAIT_L(0); PG8_MMA(0, 0, At, B0); PG8_BAR; PG8_SCHED;
            PG8_LDB(B1, 0, 1); PG8_STAGE(PG8_SB(0, 0), b2, voffB);
            PG8_BAR; PG8_WAIT_L(0); PG8_MMA(0, 1, At, B1); PG8_BAR;
            PG8_LDA(At, 0, 1); PG8_STAGE(PG8_SA(0, 0), a2, voffA);
            PG8_BAR; PG8_WAIT_L(0); PG8_MMA(1, 0, At, B0); PG8_BAR; PG8_SCHED;
            PG8_STAGE(PG8_SB(0, 1), b2 + hstep, voffB);
            PG8_WAIT_V(6); PG8_BAR; PG8_MMA(1, 1, At, B1); PG8_BAR;
            PG8_LDB(B0, 1, 0); PG8_SCHED; PG8_LDA(At, 1, 0); PG8_STAGE(PG8_SA(0, 1), a2 + hstep, voffA);
            PG8_WAIT_L(8); PG8_BAR; PG8_WAIT_L(0); PG8_MMA(0, 0, At, B0); PG8_BAR; PG8_SCHED;
            PG8_LDB(B1, 1, 1); PG8_STAGE(PG8_SB(1, 0), b3, voffB);
            PG8_BAR; PG8_WAIT_L(0); PG8_MMA(0, 1, At, B1); PG8_BAR;
            PG8_LDA(At, 1, 1); PG8_STAGE(PG8_SA(1, 0), a3, voffA);
            PG8_BAR; PG8_WAIT_L(0); PG8_MMA(1, 0, At, B0); PG8_BAR; PG8_SCHED;
            PG8_STAGE(PG8_SB(1, 1), b3 + hstep, voffB);
            PG8_WAIT_V(6); PG8_BAR; PG8_MMA(1, 1, At, B1); PG8_BAR;
            }
        }
        if constexpr (ALIGN_EPI) { if (wr == 0) PG8_BAR; }
        if constexpr (!Epi::AFTER_DRAIN) { E(acc, cur, wr, wc, fr, fq); S.done(cur); }
        if (!has_next) break;
#pragma unroll
        for (int a = 0; a < 2; ++a)
#pragma unroll
            for (int b = 0; b < 2; ++b)
#pragma unroll
                for (int m = 0; m < 4; ++m)
#pragma unroll
                    for (int n = 0; n < 2; ++n) acc[a][b][m][n] = (f32x4){0.f, 0.f, 0.f, 0.f};
        cur = nxt; cA = nA; cB = nB; ++ui;
        if constexpr (ALIGN_EPI) { if (wr == 1) PG8_BAR; }
    }
    PG8_WAIT_V(0);
    if constexpr (!ALIGN_EPI) { if (wr == 0) PG8_BAR; }
    PG8_BAR;
#undef PG8_SA
#undef PG8_SB
#undef PG8_STAGE
#undef PG8_LDA
#undef PG8_LDB
#undef PG8_MMA
#undef PG8_WAIT_V
#undef PG8_WAIT_L
#undef PG8_BAR
#undef PG8_SCHED
}
}

typedef unsigned short bf16;
#define GAS __attribute__((address_space(1)))
#define LAS __attribute__((address_space(3)))
typedef unsigned v4u __attribute__((ext_vector_type(4)));
typedef float f32x4 __attribute__((ext_vector_type(4)));
typedef unsigned u32x4_t __attribute__((ext_vector_type(4)));

constexpr int DM = 1024, NB = 4, SEQ = 8192, MROWS = NB * SEQ, DEPTH = 2;
constexpr int LRU_W = 512, DIN = 2560, DFF = 3072, NEXP = 8, NMOD = 6 * DM;
constexpr int ZC_XR = 0, ZC_YR = 512, ZC_Q = 1024, ZC_K = 1536, ZC_V = 2048;
constexpr float EPS = 1e-6f;
constexpr int NWAVES = 8;
constexpr int GEMM_LDS = 131072;

constexpr size_t MiB = 1u << 20;
constexpr size_t WS_CTL = 0;
constexpr size_t WS_WIN = 2 * MiB;
constexpr size_t WS_WOUT = 12 * MiB;
constexpr size_t WS_WGU = 16 * MiB;
constexpr size_t WS_WD = 28 * MiB;
constexpr size_t WS_MGU = 34 * MiB;
constexpr size_t WS_MD = 130 * MiB;
constexpr size_t WS_MOD = 178 * MiB;
constexpr size_t WS_ROPE = 180 * MiB;
constexpr size_t WS_AGG = 188 * MiB;
constexpr size_t WS_MOE = 190 * MiB;
constexpr size_t WS_HG = 192 * MiB;
constexpr size_t WS_ACTM = 260 * MiB;
constexpr size_t WS_HB = 192 * MiB;
constexpr size_t WS_ZB = 256 * MiB;
constexpr size_t WS_MIX = 416 * MiB;
constexpr size_t WS_ACT = 256 * MiB;
constexpr size_t WS_END = 480 * MiB;
static_assert(WS_ACTM + (size_t)34816 * 3072 * 2 <= WS_END && WS_HG + (size_t)34816 * 1024 * 2 <= WS_ACTM && WS_MOE + 16384 + 524288 + 4 * 34816 * 4 + 2 * 160 * 4 <= WS_HG, "MoE workspace map");

__device__ __forceinline__ float bf2f(bf16 v) { return __uint_as_float((unsigned)v << 16); }
__device__ __forceinline__ bf16 f2bf(float f) { return (bf16)(pg8::cvt_pk_bf16(f, 0.f) & 0xffffu); }
__device__ __forceinline__ float wave_sum(float v) {
#pragma unroll
    for (int o = 1; o < 64; o <<= 1) v += __shfl_xor(v, o);
    return v;
}
__device__ __forceinline__ float wave_max(float v) {
#pragma unroll
    for (int o = 1; o < 64; o <<= 1) v = fmaxf(v, __shfl_xor(v, o));
    return v;
}
__device__ __forceinline__ float gelu_tanh(float y) { const float u = 0.7978845608028654f * (y + 0.044715f * y * y * y); const float t = 1.0f - 2.0f / (1.0f + __expf(2.0f * u)); return 0.5f * y * (1.0f + t); }

__device__ __forceinline__ void transpose_item(const float* W, int K, int N, bf16* WT, int dest_row0, LAS float* scr, int k0, int n0, int lane) {
#pragma unroll 8
    for (int i = 0; i < 32; ++i) { const int kk = 2 * i + (lane >> 5); scr[kk * 33 + (lane & 31)] = W[(size_t)(k0 + kk) * N + n0 + (lane & 31)]; }
    asm volatile("s_waitcnt lgkmcnt(0)" ::: "memory");
    const int c = lane & 7;
#pragma unroll
    for (int j = 0; j < 4; ++j) { const int n = (lane >> 3) + 8 * j; const LAS float* s = scr + (8 * c) * 33 + n;
        v4u o; o.x = pg8::cvt_pk_bf16(s[0 * 33], s[1 * 33]); o.y = pg8::cvt_pk_bf16(s[2 * 33], s[3 * 33]); o.z = pg8::cvt_pk_bf16(s[4 * 33], s[5 * 33]); o.w = pg8::cvt_pk_bf16(s[6 * 33], s[7 * 33]);
        *(GAS v4u*)(WT + (size_t)(dest_row0 + n) * K + k0 + 8 * c) = o; }
    asm volatile("s_waitcnt lgkmcnt(0)" ::: "memory");
}
__global__ void __launch_bounds__(256) k_transpose(const float* W, int K, int N, bf16* WT, int mode) {
    __shared__ float scr_all[4][64 * 33];
    const int lane = threadIdx.x & 63, w = threadIdx.x >> 6;
    LAS float* scr = (LAS float*)&scr_all[w][0];
    const int nblk = N / 32, nitems = (K / 64) * nblk;
    for (int it = blockIdx.x * 4 + w; it < nitems; it += gridDim.x * 4) {
        const int kb = it / nblk, nb = it % nblk, k0 = 64 * kb, n0 = 32 * nb;
        int d0 = n0; if (mode == 1) d0 = 256 * (n0 / 128) + (n0 % 128); else if (mode == 2) d0 = 256 * (n0 / 128) + 128 + (n0 % 128);
        transpose_item(W, K, N, WT, d0, scr, k0, n0, lane);
    }
}
__global__ void __launch_bounds__(256) k_mod(const float* c, const float* ada_w, const float* ada_b, float* mod) {
    __shared__ float sc[NB][DM];
    for (int i = threadIdx.x; i < NB * DM; i += 256) { const float v = c[i]; sc[i / DM][i % DM] = v / (1.0f + expf(-v)); }
    __syncthreads();
    const int gid = blockIdx.x * 256 + threadIdx.x; if (gid >= DEPTH * NMOD) return;
    const int l = gid / NMOD, n = gid % NMOD;
    const float* w = ada_w + (size_t)l * DM * NMOD + n;
    float a0 = 0.f, a1 = 0.f, a2 = 0.f, a3 = 0.f;
    for (int k = 0; k < DM; ++k) { const float wv = w[(size_t)k * NMOD]; a0 += sc[0][k] * wv; a1 += sc[1][k] * wv; a2 += sc[2][k] * wv; a3 += sc[3][k] * wv; }
    const float bb = ada_b[l * NMOD + n];
    mod[((size_t)l * NB + 0) * NMOD + n] = a0 + bb; mod[((size_t)l * NB + 1) * NMOD + n] = a1 + bb;
    mod[((size_t)l * NB + 2) * NMOD + n] = a2 + bb; mod[((size_t)l * NB + 3) * NMOD + n] = a3 + bb;
}
__constant__ float c_inv[32] = {1.000000000e+00f, 7.498942018e-01f, 5.623413324e-01f, 4.216965139e-01f, 3.162277639e-01f, 2.371373773e-01f, 1.778279394e-01f, 1.333521456e-01f, 1.000000015e-01f, 7.498942316e-02f, 5.623413250e-02f, 4.216964915e-02f, 3.162277490e-02f, 2.371373773e-02f, 1.778279431e-02f, 1.333521400e-02f, 9.999999776e-03f, 7.498942316e-03f, 5.623413250e-03f, 4.216964822e-03f, 3.162277630e-03f, 2.371373819e-03f, 1.778279431e-03f, 1.333521446e-03f, 1.000000047e-03f, 7.498941850e-04f, 5.623413017e-04f, 4.216965172e-04f, 3.162277571e-04f, 2.371373703e-04f, 1.778279402e-04f, 1.333521504e-04f};
__device__ __forceinline__ void sincos_acc(float angf, float& cs, float& sn) {
    const double x = (double)angf;
    const double k = rint(x * 0.63661977236758134308);
    const double r = fma(-k, 6.123233995736766036e-17, fma(-k, 1.57079632679489655800, x));
    const double r2 = r * r;
    double s = -7.6471637318198164759e-13; s = fma(s, r2, 1.6059043836821614599e-10); s = fma(s, r2, -2.5052108385441718775e-08); s = fma(s, r2, 2.7557319223985890653e-06);
    s = fma(s, r2, -1.9841269841269841270e-04); s = fma(s, r2, 8.3333333333333333333e-03); s = fma(s, r2, -1.6666666666666666667e-01); s = fma(s * r2, r, r);
    double c = 4.7794773323873852974e-14; c = fma(c, r2, -1.1470745597729724714e-11); c = fma(c, r2, 2.0876756987868098979e-09); c = fma(c, r2, -2.7557319223985890653e-07);
    c = fma(c, r2, 2.4801587301587301587e-05); c = fma(c, r2, -1.3888888888888888889e-03); c = fma(c, r2, 4.1666666666666666667e-02); c = fma(c, r2, -0.5); c = fma(c, r2, 1.0);
    const int q = ((int)(long long)k) & 3;
    const double sv = (q == 0) ? s : (q == 1) ? c : (q == 2) ? -s : -c;
    const double cv = (q == 0) ? c : (q == 1) ? -s : (q == 2) ? -c : s;
    cs = (float)cv; sn = (float)sv;
}
__global__ void __launch_bounds__(256) k_rope_tbl(const int* pos, float2* tbl) {
    const int gid = blockIdx.x * 256 + threadIdx.x; if (gid >= MROWS * 32) return;
    const int row = gid >> 5, i = gid & 31;
    const float ang = __fmul_rn((float)pos[row], c_inv[i]);
    float cs, sn; sincos_acc(ang, cs, sn);
    tbl[gid] = make_float2(cs, sn);
}

__global__ void __launch_bounds__(256) k_norm_mod(const float* x, const float* lng, const float* mod_l  , int sh_off, int sc_off, bf16* H, const float* router  , float* gates) {
    const int lane = threadIdx.x & 63; const int gw = (blockIdx.x * 256 + threadIdx.x) >> 6, NGW = gridDim.x * 4;
    for (int row = gw; row < MROWS; row += NGW) {
        const int b = row / SEQ;
        const f32x4* xr = (const f32x4*)(x + (size_t)row * DM) + lane;
        f32x4 v[4]; float s = 0.f;
#pragma unroll
        for (int j = 0; j < 4; ++j) { v[j] = xr[64 * j]; s += (v[j].x * v[j].x + v[j].y * v[j].y) + (v[j].z * v[j].z + v[j].w * v[j].w); }
        const float rstd = rsqrtf(wave_sum(s) * (1.0f / DM) + EPS);
        const float* mb = mod_l + (size_t)b * NMOD;
        float lg[8];
#pragma unroll
        for (int e = 0; e < 8; ++e) lg[e] = 0.f;
#pragma unroll
        for (int j = 0; j < 4; ++j) { const int c0 = 4 * lane + 256 * j;
            const f32x4 g = *(const f32x4*)(lng + c0), sc = *(const f32x4*)(mb + sc_off + c0), sh = *(const f32x4*)(mb + sh_off + c0);
            f32x4 h; h = v[j] * rstd * g * (1.0f + sc) + sh;
            uint2 o; o.x = pg8::cvt_pk_bf16(h.x, h.y); o.y = pg8::cvt_pk_bf16(h.z, h.w);
            *(uint2*)(H + (size_t)row * DM + c0) = o;
            if (router) {
#pragma unroll
                for (int i = 0; i < 4; ++i) { const f32x4 r0 = *(const f32x4*)(router + (size_t)(c0 + i) * 8), r1 = *(const f32x4*)(router + (size_t)(c0 + i) * 8 + 4);
                    const float hv = h[i];
                    lg[0] += hv * r0.x; lg[1] += hv * r0.y; lg[2] += hv * r0.z; lg[3] += hv * r0.w; lg[4] += hv * r1.x; lg[5] += hv * r1.y; lg[6] += hv * r1.z; lg[7] += hv * r1.w; }
            }
        }
        if (router) {
#pragma unroll
            for (int e = 0; e < 8; ++e) lg[e] = wave_sum(lg[e]);
            int i0 = 0; float v0 = lg[0];
#pragma unroll
            for (int e = 1; e < 8; ++e) if (lg[e] > v0) { v0 = lg[e]; i0 = e; }
            int i1 = -1; float v1 = -INFINITY;
#pragma unroll
            for (int e = 0; e < 8; ++e) if (e != i0 && lg[e] > v1) { v1 = lg[e]; i1 = e; }
            const float e1 = expf(v1 - v0), w0 = 1.0f / (1.0f + e1), w1 = e1 / (1.0f + e1);
            if (lane < 8) gates[(size_t)row * 8 + lane] = (lane == i0) ? w0 : (lane == i1) ? w1 : 0.f;
        }
    }
}
__global__ void __launch_bounds__(256) k_final(float* x, const float* g) {
    const int lane = threadIdx.x & 63; const int gw = (blockIdx.x * 256 + threadIdx.x) >> 6, NGW = gridDim.x * 4;
    for (int row = gw; row < MROWS; row += NGW) {
        f32x4* xr = (f32x4*)(x + (size_t)row * DM) + lane;
        f32x4 v[4]; float s = 0.f;
#pragma unroll
        for (int j = 0; j < 4; ++j) { v[j] = xr[64 * j]; s += (v[j].x * v[j].x + v[j].y * v[j].y) + (v[j].z * v[j].z + v[j].w * v[j].w); }
        const float rstd = rsqrtf(wave_sum(s) * (1.0f / DM) + EPS);
#pragma unroll
        for (int j = 0; j < 4; ++j) { const f32x4 gg = *(const f32x4*)(g + 4 * lane + 256 * j); xr[64 * j] = v[j] * rstd * gg; }
    }
}

__global__ void __launch_bounds__(256) k_rope_naive(bf16* Z, const float2* tbl) {
    const size_t gid = (size_t)blockIdx.x * 256 + threadIdx.x; if (gid >= (size_t)MROWS * 16 * 32) return;
    const int i = gid & 31, s = (gid >> 5) & 15; const size_t row = gid >> 9;
    bf16* p = Z + row * DIN + ZC_Q + s * 64;
    const float2 cs = tbl[row * 32 + i];
    const float x1 = bf2f(p[i]), x2 = bf2f(p[i + 32]);
    const float sc = (s < 8) ? 0.125f * 1.4426950408889634f : 1.0f;
    p[i] = f2bf((x1 * cs.x - x2 * cs.y) * sc); p[i + 32] = f2bf((x2 * cs.x + x1 * cs.y) * sc);
}
__global__ void __launch_bounds__(256) k_conv_naive(const bf16* Z, const float* cw, const float* cb, float* XC) {
    const size_t gid = (size_t)blockIdx.x * 256 + threadIdx.x; if (gid >= (size_t)MROWS * LRU_W) return;
    const int c = gid % LRU_W; const size_t row = gid / LRU_W; const int t = row % SEQ;
    float acc = cb[c];
#pragma unroll
    for (int j = 0; j < 4; ++j) { const int tt = t - 3 + j; if (tt >= 0) acc += cw[j * LRU_W + c] * bf2f(Z[(row - 3 + j) * DIN + ZC_XR + c]); }
    XC[gid] = acc;
}
__global__ void __launch_bounds__(64) k_lru_naive(const float* XC, const bf16* Z, const float* wa, const float* ba, const float* wx, const float* bx, const float* lam, bf16* MIX) {
    const int b = blockIdx.x / 8, n = blockIdx.x % 8, k = threadIdx.x, c = n * 64 + k;
    float war[64], wxr[64];
#pragma unroll
    for (int h = 0; h < 64; ++h) { war[h] = wa[(size_t)(n * 64 + h) * 64 + k]; wxr[h] = wx[(size_t)(n * 64 + h) * 64 + k]; }
    const float bav = ba[c], bxv = bx[c];
    const float L = lam[c]; const float sp = (L > 15.f) ? expf(-L) : log1pf(expf(-L));
    float h = 0.f;
    const size_t row0 = (size_t)b * SEQ;
    float xk = XC[row0 * LRU_W + c];
    for (int t = 0; t < SEQ; ++t) {
        const size_t row = row0 + t;
        const float xnext = (t + 1 < SEQ) ? XC[(row + 1) * LRU_W + c] : 0.f;
        float ar = bav, ai = bxv;
#pragma unroll
        for (int hh = 0; hh < 64; ++hh) { const float xv = __shfl(xk, hh); ar += xv * war[hh]; ai += xv * wxr[hh]; }
        const float r = 1.0f / (1.0f + expf(-ar)), ig = 1.0f / (1.0f + expf(-ai));
        const float log_a = -8.0f * r * sp; const float a = expf(log_a); const float mult = sqrtf(-expm1f(2.0f * log_a));
        h = a * h + mult * (ig * xk);
        const float y = bf2f(Z[row * DIN + ZC_YR + c]);
        MIX[row * DM + c] = f2bf(h * gelu_tanh(y));
        xk = xnext;
    }
}
__global__ void __launch_bounds__(256) k_attn_naive(const bf16* Z, const int* pos, bf16* MIX, const float* lq1, const float* lk1, const float* lq2, const float* lk2, const float* subg, float lambda_init) {
    __shared__ float qs[4][128];
    const int lane = threadIdx.x & 63, w = threadIdx.x >> 6; const int gw = blockIdx.x * 4 + w;
    const int q = gw % SEQ, h = (gw / SEQ) % 4, b = gw / (SEQ * 4);
    const size_t rowb = (size_t)b * SEQ, row = rowb + q;
    const float lam = expf(wave_sum(lq1[lane] * lk1[lane])) - expf(wave_sum(lq2[lane] * lk2[lane])) + lambda_init;
    qs[w][lane] = bf2f(Z[row * DIN + ZC_Q + h * 128 + lane]); qs[w][64 + lane] = bf2f(Z[row * DIN + ZC_Q + h * 128 + 64 + lane]);
    __syncthreads();
    const int pq = pos[row], cq = pq >> 6, p0 = pos[rowb];
    int kend = ((cq + 1) << 6) - 1 - p0; if (kend > SEQ - 1) kend = SEQ - 1;
    const int nch = kend / 64 + 1;
    float m1 = -INFINITY, m2 = -INFINITY, l1 = 0.f, l2 = 0.f, o1a = 0.f, o1b = 0.f, o2a = 0.f, o2b = 0.f;
    for (int ch = 0; ch < nch; ++ch) {
        const int key = ch * 64 + lane;
        const bool valid = (pos[rowb + key] >> 6) <= cq;
        const bf16* kr = Z + (rowb + key) * DIN + ZC_K + h * 128;
        float s1 = 0.f, s2 = 0.f;
#pragma unroll 8
        for (int d = 0; d < 64; d += 2) { const unsigned u1 = *(const unsigned*)(kr + d), u2 = *(const unsigned*)(kr + 64 + d);
            s1 += qs[w][d] * __uint_as_float(u1 << 16) + qs[w][d + 1] * __uint_as_float(u1 & 0xffff0000u);
            s2 += qs[w][64 + d] * __uint_as_float(u2 << 16) + qs[w][64 + d + 1] * __uint_as_float(u2 & 0xffff0000u); }
        s1 = valid ? s1 * 0.125f : -INFINITY; s2 = valid ? s2 * 0.125f : -INFINITY;
        const float m1n = fmaxf(m1, wave_max(s1)), m2n = fmaxf(m2, wave_max(s2));
        const float f1 = expf(m1 - m1n), f2 = expf(m2 - m2n);
        const float p1 = expf(s1 - m1n), p2 = expf(s2 - m2n);
        l1 = l1 * f1 + wave_sum(p1); l2 = l2 * f2 + wave_sum(p2);
        o1a *= f1; o1b *= f1; o2a *= f2; o2b *= f2; m1 = m1n; m2 = m2n;
        const bf16* vr = Z + (rowb + (size_t)ch * 64) * DIN + ZC_V + h * 128 + 2 * lane;
#pragma unroll 8
        for (int j = 0; j < 64; ++j) { const unsigned vv = *(const unsigned*)(vr + (size_t)j * DIN); const float va = __uint_as_float(vv << 16), vb = __uint_as_float(vv & 0xffff0000u);
            const float pj1 = __shfl(p1, j), pj2 = __shfl(p2, j);
            o1a += pj1 * va; o1b += pj1 * vb; o2a += pj2 * va; o2b += pj2 * vb; }
    }
    const float oa = o1a / l1 - lam * (o2a / l2), ob = o1b / l1 - lam * (o2b / l2);
    const float ms = wave_sum(oa * oa + ob * ob) * (1.0f / 128.0f);
    const float rs = rsqrtf(ms + EPS) * (1.0f - lambda_init);
    const unsigned o = pg8::cvt_pk_bf16(oa * rs * subg[2 * lane], ob * rs * subg[2 * lane + 1]);
    *(unsigned*)(MIX + row * DM + 512 + h * 128 + 2 * lane) = o;
}


namespace att {
typedef short bf16x8 __attribute__((ext_vector_type(8)));
typedef short s16x4 __attribute__((ext_vector_type(4)));
typedef float f32x16 __attribute__((ext_vector_type(16)));
typedef LAS const unsigned char* lds_cptr;
constexpr int KSLOT = 8192, VSLOT = 16384, NSLOT = 3;
constexpr int L_K = 0, L_V = NSLOT * KSLOT, L_WS = L_V + NSLOT * VSLOT, L_O0 = L_WS + NWAVES * 256, L_END = L_O0 + NWAVES * 8192;
constexpr float C2 = 0.125f * 1.4426950408889634f;
constexpr float THR = 8.0f;
__device__ __forceinline__ int crow(int r, int hi) { return (r & 3) + 8 * (r >> 2) + 4 * hi; }
__device__ __forceinline__ void glds16(const void* gsrc, unsigned lds_dst) { unsigned keep;
    asm volatile("s_mov_b32 %0, m0\n\ts_mov_b32 m0, %2\n\ts_nop 0\n\tglobal_load_lds_dwordx4 %1, off\n\ts_mov_b32 m0, %0" : "=&s"(keep) : "v"(gsrc), "s"(lds_dst) : "memory"); }
#define ATT_WAIT_BAR(N) asm volatile("s_waitcnt vmcnt(" #N ") lgkmcnt(0)\n\ts_barrier" ::: "memory")
__device__ __forceinline__ float merge_max32(float m) { auto rr = __builtin_amdgcn_permlane32_swap(__float_as_uint(m), __float_as_uint(m), false, false); return fmaxf(__uint_as_float(rr[0]), __uint_as_float(rr[1])); }
__device__ __forceinline__ float merge_sum32(float m) { auto rr = __builtin_amdgcn_permlane32_swap(__float_as_uint(m), __float_as_uint(m), false, false); return __uint_as_float(rr[0]) + __uint_as_float(rr[1]); }
__device__ __forceinline__ s16x4 vtr(lds_cptr p) { typedef short v4i16_t __attribute__((ext_vector_type(4))); return __builtin_bit_cast(s16x4, __builtin_amdgcn_ds_read_tr16_b64_v4i16((LAS v4i16_t*)p)); }

__device__ __forceinline__ void attn_pass(f32x16 (&o)[4], const bf16* Qw, const bf16* Kh, const bf16* Vh, LAS unsigned char* shm, int NT, int tmax, int wid, int lane) {
    const int r32 = lane & 31, hi = lane >> 5;
    const unsigned lds0 = (unsigned)(size_t)shm;
    LAS float* wsf = (LAS float*)(shm + L_WS) + wid * 64;
    const bf16* ksrc = Kh + (size_t)lane * DIN + wid * 8;
    const bf16* vsrc = Vh + (size_t)(16 * (wid & 3) + (lane >> 2)) * DIN + (wid >> 2) * 32 + (lane & 3) * 8;
    const unsigned kdst = lds0 + L_K + wid * 1024, vdst = lds0 + L_V + wid * 1024;
#define ATT_DMA(t, slot) do { const size_t go_ = (size_t)(t) * 64 * DIN; \
        glds16(ksrc + go_, (unsigned)__builtin_amdgcn_readfirstlane(kdst + (slot) * KSLOT)); \
        glds16(vsrc + go_, (unsigned)__builtin_amdgcn_readfirstlane(vdst + (slot) * VSLOT)); \
        glds16(vsrc + go_ + 64, (unsigned)__builtin_amdgcn_readfirstlane(vdst + (slot) * VSLOT + 8192)); } while (0)
    ATT_DMA(0, 0); ATT_DMA(1, 1);
    bf16x8 qr[4];
#pragma unroll
    for (int d0 = 0; d0 < 4; ++d0) qr[d0] = *(const bf16x8*)(Qw + d0 * 16 + hi * 8);
    float mhat = 0.f, l_reg = 0.f;
    f32x16 negm = {};
#pragma unroll
    for (int db = 0; db < 4; ++db) o[db] = f32x16{};
    int slot = 0;
    const lds_cptr kp0 = (lds_cptr)shm + L_K + hi * 1024 + r32 * 16;
    const lds_cptr vp0 = (lds_cptr)shm + L_V + ((lane >> 4) & 1) * 32 + (lane & 3) * 8 + (4 * hi + ((lane & 15) >> 2)) * 64;
    for (int t = 0; t < NT; ++t) {
        if (t + 1 < NT) ATT_WAIT_BAR(3); else ATT_WAIT_BAR(0);
        if (t + 2 < NT) { const int s2 = (slot + 2 >= NSLOT) ? slot + 2 - NSLOT : slot + 2; ATT_DMA(t + 2, s2); }
        if (t <= tmax) {
            const lds_cptr kp = kp0 + slot * KSLOT;
            f32x16 p0 = negm, p1 = negm;
#pragma unroll
            for (int d0 = 0; d0 < 4; ++d0) {
                const bf16x8 b0 = *(const LAS bf16x8*)(kp + d0 * 2048), b1 = *(const LAS bf16x8*)(kp + d0 * 2048 + 512);
                p0 = __builtin_amdgcn_mfma_f32_32x32x16_bf16(b0, qr[d0], p0, 0, 0, 0);
                p1 = __builtin_amdgcn_mfma_f32_32x32x16_bf16(b1, qr[d0], p1, 0, 0, 0);
            }
            float rm = fmaxf(p0[0], p1[0]);
#pragma unroll
            for (int r = 1; r < 16; ++r) rm = fmaxf(rm, fmaxf(p0[r], p1[r]));
            rm = merge_max32(rm);
            const bool first = (t == 0);
            if (first || __any(rm > THR)) {
                const float dl = first ? rm : fmaxf(rm, 0.f);
                mhat += dl;
#pragma unroll
                for (int r = 0; r < 16; ++r) { p0[r] -= dl; p1[r] -= dl; negm[r] = -mhat; }
                if (!first) {
                    const float f = __builtin_amdgcn_exp2f(-dl); l_reg *= f;
                    if (hi == 0) wsf[r32] = f;
                    asm volatile("s_waitcnt lgkmcnt(0)" ::: "memory");
#pragma unroll
                    for (int g = 0; g < 4; ++g) { const f32x4 fv = *(const LAS f32x4*)(wsf + 8 * g + 4 * hi);
#pragma unroll
                        for (int i = 0; i < 4; ++i)
#pragma unroll
                            for (int db = 0; db < 4; ++db) o[db][4 * g + i] *= fv[i]; }
                }
            }
            float sacc = 0.f;
#pragma unroll
            for (int r = 0; r < 16; ++r) { p0[r] = __builtin_amdgcn_exp2f(p0[r]); p1[r] = __builtin_amdgcn_exp2f(p1[r]); sacc += p0[r] + p1[r]; }
            l_reg += sacc;
            bf16x8 pa[4];
#pragma unroll
            for (int s = 0; s < 4; ++s) { u32x4_t w;
                if (s < 2) { w.x = pg8::cvt_pk_bf16(p0[8 * s + 0], p0[8 * s + 1]); w.y = pg8::cvt_pk_bf16(p0[8 * s + 2], p0[8 * s + 3]); w.z = pg8::cvt_pk_bf16(p0[8 * s + 4], p0[8 * s + 5]); w.w = pg8::cvt_pk_bf16(p0[8 * s + 6], p0[8 * s + 7]); }
                else { const int q = s - 2; w.x = pg8::cvt_pk_bf16(p1[8 * q + 0], p1[8 * q + 1]); w.y = pg8::cvt_pk_bf16(p1[8 * q + 2], p1[8 * q + 3]); w.z = pg8::cvt_pk_bf16(p1[8 * q + 4], p1[8 * q + 5]); w.w = pg8::cvt_pk_bf16(p1[8 * q + 6], p1[8 * q + 7]); }
                pa[s] = __builtin_bit_cast(bf16x8, w); }
            const lds_cptr vp = vp0 + slot * VSLOT;
#pragma unroll
            for (int db = 0; db < 4; ++db)
#pragma unroll
                for (int ks = 0; ks < 4; ++ks) {
                    const s16x4 lo = vtr(vp + db * 4096 + ks * 1024), hh = vtr(vp + db * 4096 + ks * 1024 + 512);
                    const bf16x8 vf = {lo[0], lo[1], lo[2], lo[3], hh[0], hh[1], hh[2], hh[3]};
                    o[db] = __builtin_amdgcn_mfma_f32_32x32x16_bf16(pa[ks], vf, o[db], 0, 0, 0);
                }
        }
        slot = (slot + 1 == NSLOT) ? 0 : slot + 1;
    }
    ATT_WAIT_BAR(0);
    l_reg = merge_sum32(l_reg);
    if (hi == 0) wsf[32 + r32] = 1.0f / l_reg;
    asm volatile("s_waitcnt lgkmcnt(0)" ::: "memory");
#pragma unroll
    for (int g = 0; g < 4; ++g) { const f32x4 fv = *(const LAS f32x4*)(wsf + 32 + 8 * g + 4 * hi);
#pragma unroll
        for (int i = 0; i < 4; ++i)
#pragma unroll
            for (int db = 0; db < 4; ++db) o[db][4 * g + i] *= fv[i]; }
    asm volatile("s_waitcnt lgkmcnt(0)" ::: "memory");
#undef ATT_DMA
}

__device__ __forceinline__ void attn_unit(int b, int h, int qb, const bf16* Z, bf16* MIX, LAS unsigned char* shm, float lam, float out_scale, const float* subg) {
    const int tid = threadIdx.x, lane = tid & 63, r32 = lane & 31, hi = lane >> 5; const int wid = __builtin_amdgcn_readfirstlane(tid >> 6);
    const size_t rowbase = (size_t)b * SEQ; const int q0 = qb * 256;
    const int NT = 4 * qb + 4, tmax = 4 * qb + (wid >> 1);
    const bf16* Qw = Z + (rowbase + q0 + wid * 32 + r32) * DIN + ZC_Q + h * 128;
    const bf16* Kh = Z + rowbase * DIN + ZC_K + h * 128;
    const bf16* Vh = Z + rowbase * DIN + ZC_V + h * 128;
    LAS unsigned* sv = (LAS unsigned*)(shm + L_O0 + wid * 8192);
    f32x16 o[4];
    attn_pass(o, Qw, Kh, Vh, shm, NT, tmax, wid, lane);
#pragma unroll
    for (int db = 0; db < 4; ++db)
#pragma unroll
        for (int r2 = 0; r2 < 8; ++r2) sv[(db * 8 + r2) * 64 + lane] = pg8::cvt_pk_bf16(o[db][2 * r2], o[db][2 * r2 + 1]);
    attn_pass(o, Qw + 64, Kh + 64, Vh, shm, NT, tmax, wid, lane);
    asm volatile("s_waitcnt lgkmcnt(0)" ::: "memory");
    float ssq[16];
#pragma unroll
    for (int r = 0; r < 16; ++r) ssq[r] = 0.f;
#pragma unroll
    for (int db = 0; db < 4; ++db)
#pragma unroll
        for (int r2 = 0; r2 < 8; ++r2) { const unsigned w = sv[(db * 8 + r2) * 64 + lane];
            const float a0 = __uint_as_float(w << 16), a1 = __uint_as_float(w & 0xffff0000u);
            const float v0 = a0 - lam * o[db][2 * r2], v1 = a1 - lam * o[db][2 * r2 + 1];
            o[db][2 * r2] = v0; o[db][2 * r2 + 1] = v1; ssq[2 * r2] += v0 * v0; ssq[2 * r2 + 1] += v1 * v1; }
#pragma unroll
    for (int r = 0; r < 16; ++r) {
#pragma unroll
        for (int off = 1; off < 32; off <<= 1) ssq[r] += __shfl_xor(ssq[r], off);
        ssq[r] = rsqrtf(ssq[r] * (1.0f / 128.0f) + EPS) * out_scale; }
    bf16* Ow = MIX + (rowbase + q0 + wid * 32) * DM + 512 + h * 128 + r32;
#pragma unroll
    for (int db = 0; db < 4; ++db) { const float gsc = subg[32 * db + r32];
#pragma unroll
        for (int r = 0; r < 16; ++r) Ow[(size_t)crow(r, hi) * DM + 32 * db] = f2bf(o[db][r] * ssq[r] * gsc); }
    asm volatile("s_waitcnt lgkmcnt(0)" ::: "memory");
}
#undef ATT_WAIT_BAR
}

constexpr int PK_LDS = 147456;
__global__ void __launch_bounds__(512, 2) k_attn(const bf16* Z, bf16* MIX, const float* lq1, const float* lk1, const float* lq2, const float* lk2, const float* subg, float lambda_init) {
    extern __shared__ __attribute__((aligned(16))) unsigned char lds[];
    const int lane = threadIdx.x & 63; const int G = gridDim.x, bx = blockIdx.x;
    const int vcu = (G % 8 == 0) ? (bx % 8) * (G / 8) + bx / 8 : bx;
    const float lam = expf(wave_sum(lq1[lane] * lk1[lane])) - expf(wave_sum(lq2[lane] * lk2[lane])) + lambda_init;
    for (int p = vcu; p < 256; p += G) {
        const int bh = p >> 4, s = p & 15;
        att::attn_unit(bh >> 2, bh & 3, s, Z, MIX, (LAS unsigned char*)lds, lam, 1.0f - lambda_init, subg);
        att::attn_unit(bh >> 2, bh & 3, 31 - s, Z, MIX, (LAS unsigned char*)lds, lam, 1.0f - lambda_init, subg);
    }
}


namespace lru {
typedef short bf16x8 __attribute__((ext_vector_type(8)));
typedef float f32x16 __attribute__((ext_vector_type(16)));
constexpr int NCH = SEQ / 64;
constexpr int WLDS = 64 * 144;
constexpr float LOG2E = 1.4426950408889634f;
__device__ __forceinline__ float sigm(float x) { return __builtin_amdgcn_rcpf(1.0f + __builtin_amdgcn_exp2f(-LOG2E * x)); }
__device__ __forceinline__ float one_minus_exp(float x) {
    if (x > -0.25f) { float p = 1.0f + x * (1.0f / 7.0f); p = 1.0f + x * (1.0f / 6.0f) * p; p = 1.0f + x * 0.2f * p; p = 1.0f + x * 0.25f * p; p = 1.0f + x * (1.0f / 3.0f) * p; p = 1.0f + x * 0.5f * p; return -x * p; }
    return 1.0f - __builtin_amdgcn_exp2f(LOG2E * x);
}
struct Par { const float* cw; const float* cb; const float* wa; const float* ba; const float* wx; const float* bx; const float* lam; };
__device__ __forceinline__ void load_gate_frags(bf16x8 (&wf)[8], const float* W  , int lane) {
    const int r32 = lane & 31, hi = lane >> 5;
#pragma unroll
    for (int ks = 0; ks < 4; ++ks)
#pragma unroll
        for (int nb = 0; nb < 2; ++nb) { const float* p = W + (size_t)(16 * ks + 8 * hi) * 64 + 32 * nb + r32; u32x4_t w;
            w.x = pg8::cvt_pk_bf16(p[0 * 64], p[1 * 64]); w.y = pg8::cvt_pk_bf16(p[2 * 64], p[3 * 64]); w.z = pg8::cvt_pk_bf16(p[4 * 64], p[5 * 64]); w.w = pg8::cvt_pk_bf16(p[6 * 64], p[7 * 64]);
            wf[ks * 2 + nb] = __builtin_bit_cast(bf16x8, w); }
}
template <int PASS>
__device__ __forceinline__ void item(int b, int ch, int n, const bf16* Z, const Par& P, const bf16x8 (&wfa)[8], const bf16x8 (&wfx)[8], float2* AGG, bf16* MIX, LAS unsigned char* wl, int lane) {
    const int r32 = lane & 31, hi = lane >> 5, c = n * 64 + lane;
    const size_t row0 = (size_t)b * SEQ + (size_t)ch * 64;
    const float cw0 = P.cw[c], cw1 = P.cw[LRU_W + c], cw2 = P.cw[2 * LRU_W + c], cw3 = P.cw[3 * LRU_W + c], cbv = P.cb[c];
    const float bav = P.ba[c], bxv = P.bx[c];
    const float L = P.lam[c]; const float sp = log1pf(__expf(-L));
    const float ka = -8.0f * sp;
    const bf16* zc = Z + row0 * DIN + ZC_XR + c;
    float xm3 = 0.f, xm2 = 0.f, xm1 = 0.f;
    if (ch > 0) { xm3 = bf2f(zc[-3 * DIN]); xm2 = bf2f(zc[-2 * DIN]); xm1 = bf2f(zc[-1 * DIN]); }
    float carry = 0.f;
    if (PASS == 2) {
        const float2* ag = AGG + ((size_t)b * NCH) * LRU_W + c;
        for (int cc = 0; cc < ch; cc += 8) { float2 v[8];
#pragma unroll
            for (int j = 0; j < 8; ++j) { const int ci = (cc + j < ch) ? cc + j : ch - 1; v[j] = ag[(size_t)ci * LRU_W]; }
#pragma unroll
            for (int j = 0; j < 8; ++j) { const bool ok = cc + j < ch; carry = ok ? v[j].x * carry + v[j].y : carry; } }
    }
    float h = carry, aprod = 1.0f;
    const bf16* yc = Z + row0 * DIN + ZC_YR + c;
    bf16* oc = MIX + row0 * DM + c;
#pragma unroll 1
    for (int th = 0; th < 2; ++th) {
        float xc[32];
#pragma unroll
        for (int t = 0; t < 32; ++t) { const float xv = bf2f(zc[(size_t)(th * 32 + t) * DIN]); xc[t] = cbv + cw0 * xm3 + cw1 * xm2 + cw2 * xm1 + cw3 * xv; xm3 = xm2; xm2 = xm1; xm1 = xv; }
#pragma unroll
        for (int t = 0; t < 32; ++t) ((LAS bf16*)(wl + (th * 32 + t) * 144))[lane] = f2bf(xc[t]);
        asm volatile("s_waitcnt lgkmcnt(0)" ::: "memory");
        f32x16 ga[2], gx[2];
        ga[0] = f32x16{}; ga[1] = f32x16{}; gx[0] = f32x16{}; gx[1] = f32x16{};
#pragma unroll
        for (int ks = 0; ks < 4; ++ks) { const bf16x8 af = *(const LAS bf16x8*)(wl + (th * 32 + r32) * 144 + (ks * 16 + hi * 8) * 2);
#pragma unroll
            for (int nb = 0; nb < 2; ++nb) { ga[nb] = __builtin_amdgcn_mfma_f32_32x32x16_bf16(af, wfa[ks * 2 + nb], ga[nb], 0, 0, 0); gx[nb] = __builtin_amdgcn_mfma_f32_32x32x16_bf16(af, wfx[ks * 2 + nb], gx[nb], 0, 0, 0); } }
#pragma unroll
        for (int r = 0; r < 16; ++r) {
            auto s1 = __builtin_amdgcn_permlane32_swap(__float_as_uint(ga[0][r]), __float_as_uint(ga[1][r]), false, false); ga[0][r] = __uint_as_float(s1[0]); ga[1][r] = __uint_as_float(s1[1]);
            auto s2 = __builtin_amdgcn_permlane32_swap(__float_as_uint(gx[0][r]), __float_as_uint(gx[1][r]), false, false); gx[0][r] = __uint_as_float(s2[0]); gx[1][r] = __uint_as_float(s2[1]); }
#pragma unroll
        for (int g = 0; g < 4; ++g)
#pragma unroll
            for (int hf = 0; hf < 2; ++hf)
#pragma unroll
                for (int i = 0; i < 4; ++i) { const int tl = 8 * g + 4 * hf + i, tok = th * 32 + tl;
                    const float r = sigm(ga[hf][4 * g + i] + bav), ig = sigm(gx[hf][4 * g + i] + bxv);
                    const float la = ka * r; const float a = __builtin_amdgcn_exp2f(LOG2E * la); const float mult = __builtin_amdgcn_sqrtf(one_minus_exp(2.0f * la));
                    h = a * h + mult * (ig * xc[tl]);
                    if (PASS == 1) aprod *= a;
                    else { const float y = bf2f(yc[(size_t)tok * DIN]); oc[(size_t)tok * DM] = f2bf(h * gelu_tanh(y)); } }
    }
    if (PASS == 1) AGG[((size_t)b * NCH + ch) * LRU_W + c] = make_float2(aprod, h);
    asm volatile("s_waitcnt lgkmcnt(0)" ::: "memory");
}
template <int PASS>
__device__ __forceinline__ void phase(const bf16* Z, const Par& P, float2* AGG, bf16* MIX, LAS unsigned char* lds, int vcu, int G) {
    const int lane = threadIdx.x & 63; const int wid = __builtin_amdgcn_readfirstlane(threadIdx.x >> 6);
    bf16x8 wfa[8], wfx[8];
    load_gate_frags(wfa, P.wa + (size_t)wid * 64 * 64, lane); load_gate_frags(wfx, P.wx + (size_t)wid * 64 * 64, lane);
    for (int bc = vcu; bc < NB * NCH; bc += G) item<PASS>(bc / NCH, bc % NCH, wid, Z, P, wfa, wfx, AGG, MIX, lds + wid * WLDS, lane);
}
}
template <int PASS>
__global__ void __launch_bounds__(512, 2) k_lru(const bf16* Z, lru::Par P, float2* AGG, bf16* MIX) {
    extern __shared__ __attribute__((aligned(16))) unsigned char lds[];
    const int G = gridDim.x, bx = blockIdx.x; const int vcu = (G % 8 == 0) ? (bx % 8) * (G / 8) + bx / 8 : bx;
    lru::phase<PASS>(Z, P, AGG, MIX, (LAS unsigned char*)lds, vcu, G);
}


namespace moe {
constexpr int MAXP = 136;
constexpr int SLOTS = MAXP * 256;
constexpr int PINFO = 160;
struct Ws { int* cnt; uint4* topk; int* slot_tok; float* slot_w; int* pinfo; bf16* HG; };
__device__ __forceinline__ void norm_row(f32x4 (&h)[4], const float* xrow, const float* lng, const float* mb, int sh_off, int sc_off, int lane) {
    const f32x4* xr = (const f32x4*)xrow + lane; float s = 0.f;
#pragma unroll
    for (int j = 0; j < 4; ++j) { h[j] = xr[64 * j]; s += (h[j].x * h[j].x + h[j].y * h[j].y) + (h[j].z * h[j].z + h[j].w * h[j].w); }
    const float rstd = rsqrtf(wave_sum(s) * (1.0f / DM) + EPS);
#pragma unroll
    for (int j = 0; j < 4; ++j) { const int c0 = 4 * lane + 256 * j;
        const f32x4 g = *(const f32x4*)(lng + c0), sc = *(const f32x4*)(mb + sc_off + c0), sh = *(const f32x4*)(mb + sh_off + c0);
        h[j] = h[j] * rstd * g * (1.0f + sc) + sh; }
}
__device__ __forceinline__ void route_phase(const float* x, const float* lng, const float* modl, const float* router, const Ws& W, LAS unsigned char* lds, int vcu, int G) {
    const int tid = threadIdx.x, lane = tid & 63; const int wid = __builtin_amdgcn_readfirstlane(tid >> 6);
    LAS int* lcnt = (LAS int*)lds;
    if (tid < 16) lcnt[tid] = 0;
    __syncthreads();
    const int rpw = MROWS / G / NWAVES;
    for (int i = 0; i < rpw; ++i) { const int row = vcu * (MROWS / G) + wid * rpw + i;
        f32x4 h[4]; norm_row(h, x + (size_t)row * DM, lng, modl + (size_t)(row / SEQ) * NMOD, 3 * DM, 4 * DM, lane);
        float lg[8];
#pragma unroll
        for (int e = 0; e < 8; ++e) lg[e] = 0.f;
#pragma unroll
        for (int j = 0; j < 4; ++j)
#pragma unroll
            for (int q = 0; q < 4; ++q) { const int c = 4 * lane + 256 * j + q; const f32x4 r0 = *(const f32x4*)(router + (size_t)c * 8), r1 = *(const f32x4*)(router + (size_t)c * 8 + 4); const float hv = h[j][q];
                lg[0] += hv * r0.x; lg[1] += hv * r0.y; lg[2] += hv * r0.z; lg[3] += hv * r0.w; lg[4] += hv * r1.x; lg[5] += hv * r1.y; lg[6] += hv * r1.z; lg[7] += hv * r1.w; }
#pragma unroll
        for (int e = 0; e < 8; ++e) lg[e] = wave_sum(lg[e]);
        int i0 = 0; float v0 = lg[0];
#pragma unroll
        for (int e = 1; e < 8; ++e) if (lg[e] > v0) { v0 = lg[e]; i0 = e; }
        int i1 = -1; float v1 = -INFINITY;
#pragma unroll
        for (int e = 0; e < 8; ++e) if (e != i0 && lg[e] > v1) { v1 = lg[e]; i1 = e; }
        const float e1 = expf(v1 - v0), w0 = 1.0f / (1.0f + e1), w1 = e1 / (1.0f + e1);
        if (lane == 0) { W.topk[row] = make_uint4((unsigned)i0, (unsigned)i1, __float_as_uint(w0), __float_as_uint(w1)); __hip_atomic_fetch_add(&lcnt[i0], 1, __ATOMIC_RELAXED, __HIP_MEMORY_SCOPE_WORKGROUP); __hip_atomic_fetch_add(&lcnt[8 + i1], 1, __ATOMIC_RELAXED, __HIP_MEMORY_SCOPE_WORKGROUP); }
    }
    __syncthreads();
    if (tid < 16) W.cnt[vcu * 16 + tid] = lcnt[tid];
    __syncthreads();
}
__device__ __forceinline__ void gather_phase(int k, const float* x, const float* lng, const float* modl, const Ws& W, LAS unsigned char* lds, int vcu, int G) {
    const int tid = threadIdx.x, lane = tid & 63; const int wid = __builtin_amdgcn_readfirstlane(tid >> 6);
    LAS int* s_tot = (LAS int*)lds; LAS int* s_off = s_tot + 8; LAS int* s_slot = s_tot + 16;
    const int rpg = MROWS / G, rpw = rpg / NWAVES;
    {
        int t = 0, o = 0;
        for (int g = lane; g < G; g += 64) { const int c = W.cnt[g * 16 + k * 8 + wid]; t += c; o += (g < vcu) ? c : 0; }
        t = (int)wave_sum((float)t); o = (int)wave_sum((float)o);
        if (lane == 0) { s_tot[wid] = t; s_off[wid] = o; }
    }
    __syncthreads();
    int base[8], tot[8]; { int b = 0;
#pragma unroll
        for (int e = 0; e < 8; ++e) { tot[e] = s_tot[e]; base[e] = b; b += (tot[e] + 255) & ~255; } }
    if (wid == 0) {
        int run[8];
#pragma unroll
        for (int e = 0; e < 8; ++e) run[e] = 0;
        for (int r0 = 0; r0 < rpg; r0 += 64) { const int row = vcu * rpg + r0 + lane; const uint4 tk = W.topk[row]; const int ek = (k == 0) ? (int)tk.x : (int)tk.y; int slot = 0;
#pragma unroll
            for (int e = 0; e < 8; ++e) { const unsigned long long m = __ballot(ek == e); const int below = __popcll(m & ((1ull << lane) - 1ull));
                if (ek == e) slot = base[e] + s_off[e] + run[e] + below; run[e] += __popcll(m); }
            s_slot[r0 + lane] = slot; }
    }
    if (vcu == 0 && tid == 0) { int np = 0;
        for (int e = 0; e < 8; ++e) { const int n = (tot[e] + 255) >> 8; for (int p = 0; p < n; ++p) W.pinfo[k * PINFO + 1 + np + p] = e; np += n; }
        W.pinfo[k * PINFO] = np; }
    if (vcu < 8) { int te = 0, be = 0;
#pragma unroll
        for (int e = 0; e < 8; ++e) if (e == vcu) { te = tot[e]; be = base[e]; }
        const int pe = (te + 255) & ~255;
        for (int sidx = te + tid; sidx < pe; sidx += NWAVES * 64) W.slot_tok[k * SLOTS + be + sidx] = -1; }
    __syncthreads();
    for (int i = 0; i < rpw; ++i) { const int lr = wid * rpw + i, row = vcu * rpg + lr; const int slot = s_slot[lr];
        f32x4 h[4]; norm_row(h, x + (size_t)row * DM, lng, modl + (size_t)(row / SEQ) * NMOD, 3 * DM, 4 * DM, lane);
#pragma unroll
        for (int j = 0; j < 4; ++j) { uint2 o; o.x = pg8::cvt_pk_bf16(h[j].x, h[j].y); o.y = pg8::cvt_pk_bf16(h[j].z, h[j].w); *(uint2*)(W.HG + (size_t)slot * DM + 4 * lane + 256 * j) = o; }
        if (lane == 0) { const uint4 tk = W.topk[row]; W.slot_tok[k * SLOTS + slot] = row; W.slot_w[k * SLOTS + slot] = __uint_as_float(k == 0 ? tk.z : tk.w); }
    }
    __syncthreads();
}
}
__global__ void __launch_bounds__(512, 2) k_route(const float* x, const float* lng, const float* modl, const float* router, moe::Ws W) {
    extern __shared__ __attribute__((aligned(16))) unsigned char lds[];
    const int G = gridDim.x, bx = blockIdx.x; const int vcu = (G % 8 == 0) ? (bx % 8) * (G / 8) + bx / 8 : bx;
    moe::route_phase(x, lng, modl, router, W, (LAS unsigned char*)lds, vcu, G);
}
__global__ void __launch_bounds__(512, 2) k_gather(int k, const float* x, const float* lng, const float* modl, moe::Ws W) {
    extern __shared__ __attribute__((aligned(16))) unsigned char lds[];
    const int G = gridDim.x, bx = blockIdx.x; const int vcu = (G % 8 == 0) ? (bx % 8) * (G / 8) + bx / 8 : bx;
    moe::gather_phase(k, x, lng, modl, W, (LAS unsigned char*)lds, vcu, G);
}
template <class Epi>
__global__ void __launch_bounds__(512, 2) k_gemm_grouped(pg8::Gemm g, Epi E, const int* pinfo) {
    extern __shared__ __attribute__((aligned(16))) unsigned char lds[];
    pg8::PanelOrder S; S.init(pinfo[0], g.N, gridDim.x, blockIdx.x, pinfo + 1);
    pg8::gemm_phase<Epi, pg8::PanelOrder, true, true>((PG8_LAS unsigned char*)lds, g, S, E);
}

template <class Epi>
__global__ void __launch_bounds__(512, 2) k_gemm(pg8::Gemm g, Epi E) {
    extern __shared__ __attribute__((aligned(16))) unsigned char lds[];
    pg8::StaticOrder S; S.init(g.M, g.N, gridDim.x, blockIdx.x);
    pg8::gemm_phase<Epi, pg8::StaticOrder, true, true>((PG8_LAS unsigned char*)lds, g, S, E);
}

extern "C" void kernel_launch(void* const* d_in, const int* in_sizes, int n_in, void* d_out, int out_size, void* d_ws, size_t ws_size, hipStream_t stream) {
    static int grid = 0;
    if (grid == 0) {
        if (n_in != 29 || in_sizes[0] != MROWS * DM || out_size != MROWS * DM || ws_size < WS_END) { fprintf(stderr, "kernel_launch: unexpected shapes / workspace (n_in %d, ws %zu); nothing launched\n", n_in, ws_size); grid = -1; return; }
        int dev = 0, cus = 0;
        if (hipGetDevice(&dev) != hipSuccess || hipDeviceGetAttribute(&cus, hipDeviceAttributeMultiprocessorCount, dev) != hipSuccess) { grid = -1; return; }
        (void)hipFuncSetAttribute((const void*)k_gemm<pg8::EpiStoreBf16>, hipFuncAttributeMaxDynamicSharedMemorySize, GEMM_LDS);
        (void)hipFuncSetAttribute((const void*)k_gemm<pg8::EpiSwiglu>, hipFuncAttributeMaxDynamicSharedMemorySize, GEMM_LDS);
        (void)hipFuncSetAttribute((const void*)k_gemm<pg8::EpiResid>, hipFuncAttributeMaxDynamicSharedMemorySize, GEMM_LDS);
        (void)hipFuncSetAttribute((const void*)k_attn, hipFuncAttributeMaxDynamicSharedMemorySize, PK_LDS);
        (void)hipFuncSetAttribute((const void*)k_route, hipFuncAttributeMaxDynamicSharedMemorySize, PK_LDS);
        (void)hipFuncSetAttribute((const void*)k_gather, hipFuncAttributeMaxDynamicSharedMemorySize, PK_LDS);
        (void)hipFuncSetAttribute((const void*)k_gemm_grouped<pg8::EpiSwiglu>, hipFuncAttributeMaxDynamicSharedMemorySize, GEMM_LDS);
        (void)hipFuncSetAttribute((const void*)k_gemm_grouped<pg8::EpiScatter>, hipFuncAttributeMaxDynamicSharedMemorySize, GEMM_LDS);
        (void)hipFuncSetAttribute((const void*)k_lru<1>, hipFuncAttributeMaxDynamicSharedMemorySize, PK_LDS);
        (void)hipFuncSetAttribute((const void*)k_lru<2>, hipFuncAttributeMaxDynamicSharedMemorySize, PK_LDS);
        grid = cus;
    }
    if (grid < 0) return;
    const float* x_in = (const float*)d_in[0]; const float* c_in = (const float*)d_in[1]; const int* pos = (const int*)d_in[2];
    const float* ada_w = (const float*)d_in[3]; const float* ada_b = (const float*)d_in[4]; const float* ln1_g = (const float*)d_in[5]; const float* ln2_g = (const float*)d_in[6];
    const float* w_in = (const float*)d_in[7]; const float* conv_w = (const float*)d_in[8]; const float* conv_b = (const float*)d_in[9];
    const float* gate_a_w = (const float*)d_in[10]; const float* gate_a_b = (const float*)d_in[11]; const float* gate_x_w = (const float*)d_in[12]; const float* gate_x_b = (const float*)d_in[13];
    const float* lru_lambda = (const float*)d_in[14]; const float* lam_q1 = (const float*)d_in[15]; const float* lam_k1 = (const float*)d_in[16]; const float* lam_q2 = (const float*)d_in[17]; const float* lam_k2 = (const float*)d_in[18];
    const float* subln_g = (const float*)d_in[19]; const float* w_out = (const float*)d_in[20];
    const float* ffn_wg = (const float*)d_in[21]; const float* ffn_wu = (const float*)d_in[22]; const float* ffn_wd = (const float*)d_in[23];
    const float* moe_router = (const float*)d_in[24]; const float* moe_wg = (const float*)d_in[25]; const float* moe_wu = (const float*)d_in[26]; const float* moe_wd = (const float*)d_in[27];
    const float* final_g = (const float*)d_in[28];
    unsigned char* ws = (unsigned char*)d_ws; float* xr = (float*)d_out;
    bf16* Win = (bf16*)(ws + WS_WIN); bf16* Wout = (bf16*)(ws + WS_WOUT); bf16* Wgu = (bf16*)(ws + WS_WGU); bf16* Wd = (bf16*)(ws + WS_WD); bf16* Mgu = (bf16*)(ws + WS_MGU); bf16* Md = (bf16*)(ws + WS_MD);
    float* MOD = (float*)(ws + WS_MOD); float2* ROPE = (float2*)(ws + WS_ROPE); float2* AGG = (float2*)(ws + WS_AGG);
    bf16* HB = (bf16*)(ws + WS_HB); float* XC = (float*)(ws + WS_HB); bf16* ZB = (bf16*)(ws + WS_ZB); bf16* MIX = (bf16*)(ws + WS_MIX); bf16* ACT = (bf16*)(ws + WS_ACT);
    const int TG = 1024;
    for (int l = 0; l < DEPTH; ++l) {
        k_transpose<<<TG, 256, 0, stream>>>(w_in + (size_t)l * DM * DIN, DM, DIN, Win + (size_t)l * DIN * DM, 0);
        k_transpose<<<TG, 256, 0, stream>>>(w_out + (size_t)l * DM * DM, DM, DM, Wout + (size_t)l * DM * DM, 0);
    }
    k_transpose<<<TG, 256, 0, stream>>>(ffn_wg, DM, DFF, Wgu, 1);
    k_transpose<<<TG, 256, 0, stream>>>(ffn_wu, DM, DFF, Wgu, 2);
    k_transpose<<<TG, 256, 0, stream>>>(ffn_wd, DFF, DM, Wd, 0);
    for (int e = 0; e < NEXP; ++e) {
        k_transpose<<<TG, 256, 0, stream>>>(moe_wg + (size_t)e * DM * DFF, DM, DFF, Mgu + (size_t)e * 2 * DFF * DM, 1);
        k_transpose<<<TG, 256, 0, stream>>>(moe_wu + (size_t)e * DM * DFF, DM, DFF, Mgu + (size_t)e * 2 * DFF * DM, 2);
        k_transpose<<<TG, 256, 0, stream>>>(moe_wd + (size_t)e * DFF * DM, DFF, DM, Md + (size_t)e * DM * DFF, 0);
    }
    k_mod<<<(DEPTH * NMOD + 255) / 256, 256, 0, stream>>>(c_in, ada_w, ada_b, MOD);
    k_rope_tbl<<<MROWS * 32 / 256, 256, 0, stream>>>(pos, ROPE);
    const float* xcur = x_in;
    for (int l = 0; l < DEPTH; ++l) {
        const float lambda_init = 0.8f - 0.6f * expf(-0.3f * (float)l);
        const float* modl = MOD + (size_t)l * NB * NMOD;
        k_norm_mod<<<2048, 256, 0, stream>>>(xcur, ln1_g + l * DM, modl, 0, DM, HB, nullptr, nullptr);
        { pg8::Gemm g{HB, Win + (size_t)l * DIN * DM, 0, MROWS, DIN, DM, 0}; pg8::EpiStoreBf16 E{ZB, DIN, 0};
          k_gemm<pg8::EpiStoreBf16><<<grid, 512, GEMM_LDS, stream>>>(g, E); }
        k_rope_naive<<<MROWS * 16 * 32 / 256, 256, 0, stream>>>(ZB, ROPE);
        { lru::Par P{conv_w + l * 4 * LRU_W, conv_b + l * LRU_W, gate_a_w + (size_t)l * 8 * 64 * 64, gate_a_b + l * LRU_W, gate_x_w + (size_t)l * 8 * 64 * 64, gate_x_b + l * LRU_W, lru_lambda + l * LRU_W};
          k_lru<1><<<grid, 512, PK_LDS, stream>>>(ZB, P, AGG, MIX);
          k_lru<2><<<grid, 512, PK_LDS, stream>>>(ZB, P, AGG, MIX); }
        k_attn<<<grid, 512, PK_LDS, stream>>>(ZB, MIX, lam_q1 + l * 64, lam_k1 + l * 64, lam_q2 + l * 64, lam_k2 + l * 64, subln_g + l * 128, lambda_init);
        { pg8::Gemm g{MIX, Wout + (size_t)l * DM * DM, 0, MROWS, DM, DM, 0}; pg8::EpiResid E{xcur, xr, modl + 2 * DM, nullptr, DM, NMOD, SEQ, 0};
          k_gemm<pg8::EpiResid><<<grid, 512, GEMM_LDS, stream>>>(g, E); }
        xcur = xr;
        if (l % 2 == 0) {
            k_norm_mod<<<2048, 256, 0, stream>>>(xr, ln2_g + l * DM, modl, 3 * DM, 4 * DM, HB, nullptr, nullptr);
            { pg8::Gemm g{HB, Wgu, 0, MROWS, 2 * DFF, DM, 0}; pg8::EpiSwiglu E{ACT, DFF, 0};
              k_gemm<pg8::EpiSwiglu><<<grid, 512, GEMM_LDS, stream>>>(g, E); }
            { pg8::Gemm g{ACT, Wd, 0, MROWS, DM, DFF, 0}; pg8::EpiResid E{xr, xr, modl + 5 * DM, nullptr, DM, NMOD, SEQ, 0};
              k_gemm<pg8::EpiResid><<<grid, 512, GEMM_LDS, stream>>>(g, E); }
        } else {
            const int j = l / 2;
            unsigned char* mb = ws + WS_MOE;
            moe::Ws W{(int*)mb, (uint4*)(mb + 16384), (int*)(mb + 16384 + 524288), (float*)(mb + 16384 + 524288 + 2 * moe::SLOTS * 4), (int*)(mb + 16384 + 524288 + 4 * moe::SLOTS * 4), (bf16*)(ws + WS_HG)};
            bf16* ACTM = (bf16*)(ws + WS_ACTM);
            k_route<<<grid, 512, PK_LDS, stream>>>(xr, ln2_g + l * DM, modl, moe_router + (size_t)j * DM * NEXP, W);
            auto GU = [&](int k) { pg8::Gemm g{W.HG, Mgu, (size_t)2 * DFF * DM * 2, moe::SLOTS, 2 * DFF, DM, 0}; pg8::EpiSwiglu E{ACTM, DFF, 0};
                  k_gemm_grouped<pg8::EpiSwiglu><<<grid, 512, GEMM_LDS, stream>>>(g, E, W.pinfo + k * moe::PINFO); };
            auto DOWN = [&](int k) { pg8::Gemm g{ACTM, Md, (size_t)DM * DFF * 2, moe::SLOTS, DM, DFF, 0}; pg8::EpiScatter E{xr, modl + 5 * DM, W.slot_tok + k * moe::SLOTS, W.slot_w + k * moe::SLOTS, DM, NMOD, SEQ, 0};
                  k_gemm_grouped<pg8::EpiScatter><<<grid, 512, GEMM_LDS, stream>>>(g, E, W.pinfo + k * moe::PINFO); };
            k_gather<<<grid, 512, PK_LDS, stream>>>(0, xr, ln2_g + l * DM, modl, W);
            GU(0);
            k_gather<<<grid, 512, PK_LDS, stream>>>(1, xr, ln2_g + l * DM, modl, W);
            DOWN(0); GU(1); DOWN(1);
        }
    }
    k_final<<<2048, 256, 0, stream>>>(xr, final_g);
}
```

```cpp
#include <hip/hip_runtime.h>
#ifndef FFN0_BF16
#define FFN0_BF16 1
#endif
#include <cstdio>
#include <cstdint>

__device__ __forceinline__ int otid() { int t = threadIdx.x; asm volatile("" : "+v"(t)); return t; }
namespace pg8 {
#define PG8_LAS __attribute__((address_space(3)))
typedef unsigned short bf16_t;
typedef short bf16x8 __attribute__((ext_vector_type(8)));
typedef float f32x4 __attribute__((ext_vector_type(4)));
typedef unsigned u32x4 __attribute__((ext_vector_type(4)));
typedef int i32x4 __attribute__((ext_vector_type(4)));
typedef int i32x8 __attribute__((ext_vector_type(8)));
typedef unsigned u32x2 __attribute__((ext_vector_type(2)));
constexpr int BM = 256, BK = 64, HALF = 128, HTB = HALF * BK * 2, STAGE_BYTES = 8 * HTB, NXCD = 8, WGM = 4;

__host__ __device__ __forceinline__ int lds_byte(int r, int c) { const int st = (r >> 4) * 2 + (c >> 5), rr = r & 15, cc = c & 31, ob = rr * 64 + cc * 2; return st * 1024 + (ob ^ (((ob >> 9) & 1) << 5)); }
__host__ __device__ __forceinline__ void stage_rc(int b, int& R, int& C) { const int st = b / 1024, sb = b % 1024, swz = sb ^ (((sb >> 9) & 1) << 5); R = (st >> 1) * 16 + swz / 64; C = (st & 1) * 32 + (swz % 64) / 2; }
__host__ __device__ __forceinline__ int perm32(int rho) { const int n = rho >> 4, i = rho & 15; return 8 * (i >> 2) + 4 * n + (i & 3); }

struct Unit { int pm, pn, pe; };
struct Gemm { const bf16_t* A; const bf16_t* Bt; size_t estride; int M, N, K, pad; };

struct StaticOrder {
    int nM, nN, nwg, G, c;
    __host__ __device__ void init(int M, int N, int G_, int c_) { nM = M / BM; nN = N / BM; nwg = nM * nN; G = G_; c = c_; }
    __host__ __device__ bool next(int i, Unit& u) const { return at((long)i * G + c, u); }
    __host__ __device__ bool at(long L, Unit& u) const {
        if (L >= nwg) return false;
        int wgid = (int)L; { const int q = nwg / NXCD, r = nwg % NXCD, xcd = wgid % NXCD, off = wgid / NXCD; wgid = (xcd < r ? xcd * (q + 1) : r * (q + 1) + (xcd - r) * q) + off; }
        const int nig = WGM * nN, gid = wgid / nig, fm = gid * WGM, gsz = (nM - fm) < WGM ? (nM - fm) : WGM;
        u.pm = fm + ((wgid % nig) % gsz); u.pn = (wgid % nig) / gsz; u.pe = 0; return true;
    }
    __device__ __forceinline__ void a_ready(const Unit&) const {}
    __device__ __forceinline__ void done(const Unit&) const {}
};
struct PanelOrder {
    StaticOrder so; const int* tab;
    __device__ void init(int npanels, int N, int G_, int c_, const int* tab_) { so.init(npanels * BM, N, G_, c_); tab = tab_; }
    __device__ bool next(int i, Unit& u) const { if (!so.next(i, u)) return false; u.pe = tab[u.pm]; return true; }
    __device__ __forceinline__ void a_ready(const Unit&) const {}
    __device__ __forceinline__ void done(const Unit&) const {}
};
struct DownOrder {
    int nN, G, c, lo, hi, main; const int* tab;
    __device__ void init(int npanels, int nN_, int G_, int c_, const int* tab_, int part  ) {
        nN = nN_; G = G_; c = c_; tab = tab_; const int nu = npanels * nN_; main = (nu / G_) * G_;
        lo = (part == 1) ? main : 0; hi = (part == 0) ? main : nu; }
    __device__ bool next(int i, Unit& u) const {
        const long L = (long)lo + (long)i * G + c; if (L >= hi) return false;
        int w = (int)L; if (w < main) w = (w % NXCD) * (main / NXCD) + w / NXCD;
        u.pm = w / nN; u.pn = w % nN; u.pe = tab[u.pm]; return true; }
    __device__ __forceinline__ void a_ready(const Unit&) const {}
    __device__ __forceinline__ void done(const Unit&) const {}
};
struct GuOverlapOrder {
    PanelOrder po; int left, G, c;
    static constexpr int SKIP = 4;
    __device__ void init(int npanels, int N, int G_, int c_, const int* tab_, int left_) { po.init(npanels, N, G_, c_, tab_); left = left_; G = G_; c = c_; }
    __device__ bool next(int i, Unit& u) const {
        long L = (long)((c < left) ? i + SKIP : i) * G + c;
        if (L >= po.so.nwg) { const long k = L - po.so.nwg; if (k >= (long)left * SKIP) return false; L = (k / left) * G + (k % left); }
        if (!po.so.at(L, u)) return false; u.pe = po.tab[u.pm]; return true; }
    __device__ __forceinline__ void a_ready(const Unit&) const {}
    __device__ __forceinline__ void done(const Unit&) const {}
};

typedef float f32x2_t __attribute__((ext_vector_type(2))); typedef __bf16 bf16x2_t __attribute__((ext_vector_type(2)));
__device__ __forceinline__ unsigned cvt_pk_bf16(float lo, float hi) { f32x2_t v = {lo, hi}; bf16x2_t b = __builtin_convertvector(v, bf16x2_t); return __builtin_bit_cast(unsigned, b); }

struct EpiStoreBf16 {
    static constexpr bool PERM = true, AFTER_DRAIN = false, PREFETCH = false;
    bf16_t* O; int ldc; int pad;
    __device__ __forceinline__ void operator()(const f32x4 (&acc)[2][2][4][2], const Unit& u, int wr, int wc, int fr, int fq) const {
        const int row0 = u.pm * BM + wr * 64 + fr; const int col0 = u.pn * BM + wc * 32 + 8 * fq;
#pragma unroll
        for (int ai = 0; ai < 2; ++ai)
#pragma unroll
            for (int m = 0; m < 4; ++m) { bf16_t* rowp = O + (size_t)(row0 + ai * HALF + m * 16) * ldc + col0;
#pragma unroll
                for (int bj = 0; bj < 2; ++bj) { const f32x4 v0 = acc[ai][bj][m][0], v1 = acc[ai][bj][m][1];
                    u32x4 w; w.x = cvt_pk_bf16(v0[0], v0[1]); w.y = cvt_pk_bf16(v0[2], v0[3]); w.z = cvt_pk_bf16(v1[0], v1[1]); w.w = cvt_pk_bf16(v1[2], v1[3]);
                    *(u32x4*)(rowp + bj * HALF) = w; } }
    }
};
__device__ __forceinline__ float silu_f(float x) { return x * __builtin_amdgcn_rcpf(1.0f + __builtin_amdgcn_exp2f(-1.4426950408889634f * x)); }
struct EpiSwiglu {
    static constexpr bool PERM = true, AFTER_DRAIN = false, PREFETCH = false;
    bf16_t* O; int ldc; int pad;
    __device__ __forceinline__ void operator()(const f32x4 (&acc)[2][2][4][2], const Unit& u, int wr, int wc, int fr, int fq) const {
        const int row0 = u.pm * BM + wr * 64 + fr; const int col0 = u.pn * HALF + wc * 32 + 8 * fq;
#pragma unroll
        for (int ai = 0; ai < 2; ++ai)
#pragma unroll
            for (int m = 0; m < 4; ++m) { bf16_t* rowp = O + (size_t)(row0 + ai * HALF + m * 16) * ldc + col0;
                float r[8];
#pragma unroll
                for (int n = 0; n < 2; ++n)
#pragma unroll
                    for (int i = 0; i < 4; ++i) r[n * 4 + i] = silu_f(acc[ai][0][m][n][i]) * acc[ai][1][m][n][i];
                u32x4 w; w.x = cvt_pk_bf16(r[0], r[1]); w.y = cvt_pk_bf16(r[2], r[3]); w.z = cvt_pk_bf16(r[4], r[5]); w.w = cvt_pk_bf16(r[6], r[7]);
                *(u32x4*)rowp = w; }
    }
};
__device__ __forceinline__ float clamp_f8(float v) { return __builtin_amdgcn_fmed3f(v, -448.0f, 448.0f); }
__device__ __forceinline__ unsigned cvt4_fp8(float a, float b, float c, float d) { int w = 0; w = __builtin_amdgcn_cvt_pk_fp8_f32(clamp_f8(a), clamp_f8(b), w, false); w = __builtin_amdgcn_cvt_pk_fp8_f32(clamp_f8(c), clamp_f8(d), w, true); return (unsigned)w; }
constexpr float ACT_F8_SCALE = 4.0f;
struct EpiSwigluF8 {
    static constexpr bool PERM = true, AFTER_DRAIN = false, PREFETCH = false;
    unsigned char* O; int ldc; float inscale;
    __device__ __forceinline__ void operator()(const f32x4 (&acc)[2][2][4][2], const Unit& u, int wr, int wc, int fr, int fq) const {
        const int row0 = u.pm * BM + wr * 64 + fr; const int col0 = u.pn * HALF + wc * 32 + 8 * fq;
        const float kk = 1.0f / (ACT_F8_SCALE * inscale * inscale), c2 = -1.4426950408889634f * inscale, lk = __builtin_log2f(kk);
#pragma unroll
        for (int ai = 0; ai < 2; ++ai)
#pragma unroll
            for (int m = 0; m < 4; ++m) { unsigned char* rowp = O + (unsigned)((row0 + ai * HALF + m * 16) * ldc + col0);
                float r[8];
#pragma unroll
                for (int n = 0; n < 2; ++n)
#pragma unroll
                    for (int i = 0; i < 4; ++i) {
                        const float gg = acc[ai][0][m][n][i], uu = acc[ai][1][m][n][i];
                        const float e = __builtin_amdgcn_exp2f(__builtin_fmaf(gg, c2, lk));
                        r[n * 4 + i] = (gg * uu) * __builtin_amdgcn_rcpf(e + kk); }
                u32x2 w; w.x = cvt4_fp8(r[0], r[1], r[2], r[3]); w.y = cvt4_fp8(r[4], r[5], r[6], r[7]);
                *(u32x2*)rowp = w; }
    }
};
struct EpiSwigluGuard {
    static constexpr bool PERM = true, AFTER_DRAIN = false, PREFETCH = false;
    EpiSwigluF8 base; unsigned* cnt; int guard_pm; int want;
    __device__ __forceinline__ void operator()(const f32x4 (&acc)[2][2][4][2], const Unit& u, int wr, int wc, int fr, int fq) const {
        if (u.pm >= guard_pm && want > 0) { unsigned sp = 0;
            while ((int)__hip_atomic_load(cnt, __ATOMIC_RELAXED, __HIP_MEMORY_SCOPE_AGENT) < want && ++sp < (1u << 22)) __builtin_amdgcn_s_sleep(2); }
        base(acc, u, wr, wc, fr, fq);
    }
};
struct EpiResid {
    static constexpr bool PERM = true, AFTER_DRAIN = false, PREFETCH = false;
    const float* base; float* out; const float* gvec; const float* rowscale; int ldc; int gstride; int rows_per_batch; int rs_stride; float ascale; int pad;
    __device__ __forceinline__ void operator()(const f32x4 (&acc)[2][2][4][2], const Unit& u, int wr, int wc, int fr, int fq) const {
        const int row0 = u.pm * BM + wr * 64 + fr; const int col0 = u.pn * BM + wc * 32 + 8 * fq;
        const float* gv = gvec + (size_t)((u.pm * BM) / rows_per_batch) * gstride + col0;
        f32x4 g[2][2];
#pragma unroll
        for (int bj = 0; bj < 2; ++bj)
#pragma unroll
            for (int n = 0; n < 2; ++n) g[bj][n] = *(const f32x4*)(gv + bj * HALF + 4 * n);
        f32x4 b[8][2][2]; float rs[8];
#define ER_LOAD(ri) do { const int row = row0 + ((ri) >> 2) * HALF + ((ri) & 3) * 16; const size_t off = (size_t)row * ldc + col0; rs[ri] = (rowscale ? rowscale[(size_t)row * rs_stride] : 1.0f) * ascale; \
        _Pragma("unroll") for (int bj = 0; bj < 2; ++bj) _Pragma("unroll") for (int n = 0; n < 2; ++n) b[ri][bj][n] = *(const f32x4*)(base + off + bj * HALF + 4 * n); } while (0)
        ER_LOAD(0); ER_LOAD(1);
#pragma unroll
        for (int ri = 0; ri < 8; ++ri) { if (ri + 2 < 8) ER_LOAD(ri + 2);
            const int row = row0 + (ri >> 2) * HALF + (ri & 3) * 16; const size_t off = (size_t)row * ldc + col0;
#pragma unroll
            for (int bj = 0; bj < 2; ++bj)
#pragma unroll
                for (int n = 0; n < 2; ++n) *(f32x4*)(out + off + bj * HALF + 4 * n) = b[ri][bj][n] + g[bj][n] * rs[ri] * acc[ri >> 2][bj][ri & 3][n]; }
#undef ER_LOAD
    }
};

__device__ __forceinline__ float xlane(float v, int o, int lane) { return __builtin_bit_cast(float, __builtin_amdgcn_ds_bpermute((lane ^ o) << 2, __builtin_bit_cast(int, v))); }
template <bool QF8>
struct EpiResidQ {
    static constexpr bool PERM = true, AFTER_DRAIN = false, PREFETCH = false;
    const float* base; float* out; const float* gvec; const float* lng; const float* scv; void* Q; float* RP; int ldc; int gstride; int rows_per_batch; float ascale;
    __device__ __forceinline__ void operator()(const f32x4 (&acc)[2][2][4][2], const Unit& u, int wr, int wc, int fr, int fq) const {
        const int row0 = u.pm * BM + wr * 64 + fr; const int col0 = u.pn * BM + wc * 32 + 8 * fq; const int lane = fr + 16 * fq;
        const size_t boff = (size_t)((u.pm * BM) / rows_per_batch) * gstride + col0;
        f32x4 g[2][2], gm[2][2];
#pragma unroll
        for (int bj = 0; bj < 2; ++bj)
#pragma unroll
            for (int n = 0; n < 2; ++n) { g[bj][n] = *(const f32x4*)(gvec + boff + bj * HALF + 4 * n) * ascale;
                gm[bj][n] = *(const f32x4*)(lng + col0 + bj * HALF + 4 * n) * (1.0f + *(const f32x4*)(scv + boff + bj * HALF + 4 * n)); }
#pragma unroll
        for (int ai = 0; ai < 2; ++ai)
#pragma unroll
            for (int m = 0; m < 4; ++m) { const int row = row0 + ai * HALF + m * 16; const unsigned off = (unsigned)(row * ldc + col0); float ss = 0.f;
                f32x4 bb[2][2];
#pragma unroll
                for (int bj = 0; bj < 2; ++bj)
#pragma unroll
                    for (int n = 0; n < 2; ++n) bb[bj][n] = *(const f32x4*)(base + off + bj * HALF + 4 * n);
#pragma unroll
                for (int bj = 0; bj < 2; ++bj) { f32x4 v[2];
#pragma unroll
                    for (int n = 0; n < 2; ++n) { const f32x4 b = bb[bj][n]; v[n] = b + g[bj][n] * acc[ai][bj][m][n];
                        *(f32x4*)(out + off + bj * HALF + 4 * n) = v[n]; ss += (v[n][0] * v[n][0] + v[n][1] * v[n][1]) + (v[n][2] * v[n][2] + v[n][3] * v[n][3]); v[n] = v[n] * gm[bj][n]; }
                    if constexpr (QF8) { u32x2 w; w.x = cvt4_fp8(v[0][0], v[0][1], v[0][2], v[0][3]); w.y = cvt4_fp8(v[1][0], v[1][1], v[1][2], v[1][3]); *(u32x2*)((unsigned char*)Q + off + bj * HALF) = w; }
                    else { u32x4 w; w.x = cvt_pk_bf16(v[0][0], v[0][1]); w.y = cvt_pk_bf16(v[0][2], v[0][3]); w.z = cvt_pk_bf16(v[1][0], v[1][1]); w.w = cvt_pk_bf16(v[1][2], v[1][3]); *(u32x4*)((bf16_t*)Q + off + bj * HALF) = w; } }
                ss += xlane(ss, 16, lane); ss += xlane(ss, 32, lane);
                if (fq == 0) ((bf16_t*)RP)[(unsigned)(row * 16 + u.pn * 4 + wc)] = (bf16_t)(cvt_pk_bf16(ss, 0.f) & 0xffffu); }
    }
};
template <class Base>
struct EpiAffine {
    static constexpr bool PERM = true, AFTER_DRAIN = false, PREFETCH = true;
    static constexpr int BUF = 3072;
    Base inner; const float* RP; const float* bias; int bstride; int rows_per_batch; float inv_n; float eps;
    __device__ __forceinline__ void pf_load(u32x4& pr, u32x4& pb, const Unit& n, int tid) const {
        pr = *(const u32x4*)((const bf16_t*)RP + (unsigned)((n.pm * BM + (tid >> 1)) * 16 + (tid & 1) * 8));
        if (tid < 64) pb = *(const u32x4*)(bias + (unsigned)(((n.pm * BM) / rows_per_batch) * bstride + n.pn * BM + 4 * tid));
    }
    __device__ __forceinline__ void pf_store(const u32x4& pr, const u32x4& pb, PG8_LAS unsigned char* buf, int tid) const {
        float sq = 0.f;
#pragma unroll
        for (int i = 0; i < 4; ++i) sq += __uint_as_float(pr[i] << 16) + __uint_as_float(pr[i] & 0xffff0000u);
        ((PG8_LAS float*)buf)[tid] = sq;
        if (tid < 64) *(PG8_LAS u32x4*)(buf + 2048 + 16 * tid) = pb;
    }
    __device__ __forceinline__ void prefetch_first(PG8_LAS unsigned char* spare, const Unit& u, int tid) const {
        if (RP != nullptr) { u32x4 pr, pb = {0u, 0u, 0u, 0u}; pf_load(pr, pb, u, tid); pf_store(pr, pb, spare, tid); asm volatile("s_waitcnt lgkmcnt(0)" ::: "memory"); }
    }
    __device__ __forceinline__ void operator()(f32x4 (&acc)[2][2][4][2], const Unit& u, int wr, int wc, int fr, int fq, PG8_LAS unsigned char* spare, int buf, bool has_next, const Unit& nxt, int tid) const {
        u32x4 pr = {0u, 0u, 0u, 0u}, pb = {0u, 0u, 0u, 0u};
        if (RP != nullptr) {
            const PG8_LAS unsigned char* cb = spare + buf * BUF;
            __builtin_amdgcn_sched_barrier(0);
            float rstd[2][4]; f32x4 bv[2][2];
#pragma unroll
            for (int ai = 0; ai < 2; ++ai)
#pragma unroll
                for (int m = 0; m < 4; ++m) { const f32x2_t p = *(const PG8_LAS f32x2_t*)(cb + (wr * 64 + fr + ai * HALF + m * 16) * 8); rstd[ai][m] = __builtin_amdgcn_rsqf((p.x + p.y) * inv_n + eps); }
#pragma unroll
            for (int bj = 0; bj < 2; ++bj)
#pragma unroll
                for (int n = 0; n < 2; ++n) bv[bj][n] = *(const PG8_LAS f32x4*)(cb + 2048 + (bj * HALF + wc * 32 + 8 * fq + 4 * n) * 4);
            if (has_next) pf_load(pr, pb, nxt, tid);
#pragma unroll
            for (int bj = 0; bj < 2; ++bj)
#pragma unroll
                for (int n = 0; n < 2; ++n)
#pragma unroll
                    for (int ai = 0; ai < 2; ++ai)
#pragma unroll
                        for (int m = 0; m < 4; ++m) acc[ai][bj][m][n] = acc[ai][bj][m][n] * rstd[ai][m] + bv[bj][n];
            __builtin_amdgcn_sched_barrier(0); }
        inner(acc, u, wr, wc, fr, fq);
        if (RP != nullptr && has_next) { __builtin_amdgcn_sched_barrier(0); pf_store(pr, pb, spare + (buf ^ 1) * BUF, tid); }
    }
};

struct EpiScatter {
    static constexpr bool PERM = true, AFTER_DRAIN = false, PREFETCH = false;
    float* out; const float* gvec; const int* slot_tok; const float* slot_w; int ldc; int gstride; int rows_per_batch; float wscale;
    __device__ __forceinline__ void operator()(const f32x4 (&acc)[2][2][4][2], const Unit& u, int wr, int wc, int fr, int fq) const {
        const int row0 = u.pm * BM + wr * 64 + fr; const int col0 = u.pn * BM + wc * 32 + 8 * fq;
        int tok[2][4]; float w[2][4];
#pragma unroll
        for (int ai = 0; ai < 2; ++ai)
#pragma unroll
            for (int m = 0; m < 4; ++m) { const int slot = row0 + ai * HALF + m * 16; tok[ai][m] = slot_tok[slot]; w[ai][m] = slot_w[slot] * wscale; }
        f32x4 g[8][2][2], b[8][2][2];
#define ES_LOAD(ri) do { const int t_ = tok[(ri) >> 2][(ri) & 3] < 0 ? 0 : tok[(ri) >> 2][(ri) & 3]; const float* gv = gvec + (size_t)(t_ / rows_per_batch) * gstride + col0; const float* xo = out + (size_t)t_ * ldc + col0; \
        _Pragma("unroll") for (int bj = 0; bj < 2; ++bj) _Pragma("unroll") for (int n = 0; n < 2; ++n) { g[ri][bj][n] = *(const f32x4*)(gv + bj * HALF + 4 * n); b[ri][bj][n] = *(const f32x4*)(xo + bj * HALF + 4 * n); } } while (0)
        ES_LOAD(0);
#pragma unroll
        for (int ri = 0; ri < 8; ++ri) { if (ri + 1 < 8) ES_LOAD(ri + 1);
            const int t = tok[ri >> 2][ri & 3];
            if (t >= 0) { const float ww = w[ri >> 2][ri & 3]; float* xo = out + (size_t)t * ldc + col0;
#pragma unroll
                for (int bj = 0; bj < 2; ++bj)
#pragma unroll
                    for (int n = 0; n < 2; ++n) *(f32x4*)(xo + bj * HALF + 4 * n) = b[ri][bj][n] + g[ri][bj][n] * ww * acc[ri >> 2][bj][ri & 3][n]; } }
#undef ES_LOAD
    }
};

struct EpiG1 {
    static constexpr bool PERM = true, AFTER_DRAIN = false, PREFETCH = false;
    bf16_t* O; bf16_t* KT; bf16_t* VT; const float* tbl  ; int ldc; int seq;
    __device__ __forceinline__ void operator()(const f32x4 (&acc)[2][2][4][2], const Unit& u, int wr, int wc, int fr, int fq) const {
        const int row0 = u.pm * BM + wr * 64 + fr;
        if (u.pn >= 4 && u.pn < 8) {
            const bool isq = u.pn < 6;
            const float sc = isq ? 0.125f * 1.4426950408889634f : 1.0f;
#pragma unroll
            for (int ai = 0; ai < 2; ++ai)
#pragma unroll
                for (int m = 0; m < 4; ++m) { const int row = row0 + ai * HALF + m * 16;
                    const f32x4* tp = (const f32x4*)(tbl + (size_t)row * 64 + 16 * fq);
                    float o1[8], o2[8];
#pragma unroll
                    for (int n = 0; n < 2; ++n) { const f32x4 ta = tp[2 * n], tb = tp[2 * n + 1]; const f32x4 x1 = acc[ai][0][m][n], x2 = acc[ai][1][m][n];
                        o1[4 * n + 0] = (x1[0] * ta[0] - x2[0] * ta[1]) * sc; o2[4 * n + 0] = (x2[0] * ta[0] + x1[0] * ta[1]) * sc;
                        o1[4 * n + 1] = (x1[1] * ta[2] - x2[1] * ta[3]) * sc; o2[4 * n + 1] = (x2[1] * ta[2] + x1[1] * ta[3]) * sc;
                        o1[4 * n + 2] = (x1[2] * tb[0] - x2[2] * tb[1]) * sc; o2[4 * n + 2] = (x2[2] * tb[0] + x1[2] * tb[1]) * sc;
                        o1[4 * n + 3] = (x1[3] * tb[2] - x2[3] * tb[3]) * sc; o2[4 * n + 3] = (x2[3] * tb[2] + x1[3] * tb[3]) * sc; }
                    u32x4 w1, w2;
                    w1.x = cvt_pk_bf16(o1[0], o1[1]); w1.y = cvt_pk_bf16(o1[2], o1[3]); w1.z = cvt_pk_bf16(o1[4], o1[5]); w1.w = cvt_pk_bf16(o1[6], o1[7]);
                    w2.x = cvt_pk_bf16(o2[0], o2[1]); w2.y = cvt_pk_bf16(o2[2], o2[3]); w2.z = cvt_pk_bf16(o2[4], o2[5]); w2.w = cvt_pk_bf16(o2[6], o2[7]);
                    if (isq) { bf16_t* rowp = O + (size_t)row * ldc + u.pn * BM + 64 * wc + 8 * fq; *(u32x4*)rowp = w1; *(u32x4*)(rowp + 32) = w2; }
                    else { const int b = row / seq, s = row - b * seq, sub = (u.pn - 6) * 4 + wc;
                        bf16_t* kp = KT + ((size_t)(b * 8 + sub) * seq + (size_t)(s & ~63)) * 64 + (s & 63) * 8;
                        *(u32x4*)(kp + fq * 512) = w1; *(u32x4*)(kp + (4 + fq) * 512) = w2; } }
        } else if (u.pn >= 8) {
#pragma unroll
            for (int ai = 0; ai < 2; ++ai)
#pragma unroll
                for (int m = 0; m < 4; ++m) { const int row = row0 + ai * HALF + m * 16; const int b = row / seq, s = row - b * seq;
#pragma unroll
                    for (int bj = 0; bj < 2; ++bj) { const int h = (u.pn - 8) * 2 + bj; const f32x4 v0 = acc[ai][bj][m][0], v1 = acc[ai][bj][m][1];
                        u32x4 w; w.x = cvt_pk_bf16(v0[0], v0[1]); w.y = cvt_pk_bf16(v0[2], v0[3]); w.z = cvt_pk_bf16(v1[0], v1[1]); w.w = cvt_pk_bf16(v1[2], v1[3]);
                        bf16_t* vp = VT + ((size_t)(b * 4 + h) * seq + (size_t)(s & ~63)) * 128 + wc * 2048 + ((s & 63) >> 4) * 512 + (s & 15) * 32 + 8 * fq;
                        *(u32x4*)vp = w; } }
        } else {
            const int col0 = u.pn * BM + wc * 32 + 8 * fq;
#pragma unroll
            for (int ai = 0; ai < 2; ++ai)
#pragma unroll
                for (int m = 0; m < 4; ++m) { bf16_t* rowp = O + (size_t)(row0 + ai * HALF + m * 16) * ldc + col0;
#pragma unroll
                    for (int bj = 0; bj < 2; ++bj) { const f32x4 v0 = acc[ai][bj][m][0], v1 = acc[ai][bj][m][1];
                        u32x4 w; w.x = cvt_pk_bf16(v0[0], v0[1]); w.y = cvt_pk_bf16(v0[2], v0[3]); w.z = cvt_pk_bf16(v1[0], v1[1]); w.w = cvt_pk_bf16(v1[2], v1[3]);
                        *(u32x4*)(rowp + bj * HALF) = w; } }
        }
    }
};

__device__ __forceinline__ const char* uni_ptr(const char* p) {
    const unsigned long long v = (unsigned long long)p; const unsigned lo = (unsigned)__builtin_amdgcn_readfirstlane((int)(unsigned)v), hi = (unsigned)__builtin_amdgcn_readfirstlane((int)(unsigned)(v >> 32));
    return (const char*)(((unsigned long long)hi << 32) | lo); }
template <class Epi, class Sched, bool ALIGN_EPI = false, bool SP2 = false, bool F8 = false>
__device__ __forceinline__ void gemm_phase(PG8_LAS unsigned char* lds, const Gemm g, const Sched& S, const Epi& E) {
    const int tid = otid(), wid = __builtin_amdgcn_readfirstlane(tid >> 6), lane = tid & 63, wr = wid >> 2, wc = wid & 3, fr = lane & 15, fq = lane >> 4;
    const int K = g.K, nt = K / BK;
    unsigned voffA[2], voffB[2];
#pragma unroll
    for (int i = 0; i < 2; ++i) { int R, C; stage_rc(wid * 2048 + i * 1024 + lane * 16, R, C); const int Rb = Epi::PERM ? ((R & ~31) + perm32(R & 31)) : R;
        voffA[i] = (unsigned)(R * K + C) * 2u + (i == 0 ? 1024u : 0u); voffB[i] = (unsigned)(Rb * K + C) * 2u + (i == 0 ? 1024u : 0u); }
    const size_t kstep = (size_t)(BK * 2);
    const size_t hstep = (size_t)HALF * K * 2;
    const size_t tstep = 2 * hstep;
    const unsigned ldsw = (unsigned)wid * 2048u;
    const int aoff = lds_byte(wr * 64 + fr, fq * 8), boff = lds_byte(wc * 32 + fr, fq * 8);
#define PG8_SA(b, h) (((b) * 2 + (h)) * HTB)
#define PG8_SB(b, h) ((4 + (b) * 2 + (h)) * HTB)
    const unsigned ldsb = (unsigned)__builtin_amdgcn_readfirstlane((int)((unsigned)(size_t)lds + ldsw));
#define PG8_STAGE(bufoff, gbase, voff) asm volatile("s_mov_b32 m0, %3\n\ts_nop 0\n\tglobal_load_lds_dwordx4 %0, %2\n\tglobal_load_lds_dwordx4 %1, %2 offset:1024" \
        :: "v"((voff)[0]), "v"((voff)[1]), "s"((const char*)(gbase) - 1024), "s"(ldsb + (unsigned)(bufoff)) : "memory")
#define PG8_LDA(dst, b, h) do { _Pragma("unroll") for (int m = 0; m < 4; ++m) _Pragma("unroll") for (int k = 0; k < 2; ++k) dst[m][k] = *(const PG8_LAS bf16x8*)(lds + PG8_SA(b, h) + aoff + m * 2048 + k * 1024); } while (0)
#define PG8_LDB(dst, b, h) do { _Pragma("unroll") for (int n = 0; n < 2; ++n) _Pragma("unroll") for (int k = 0; k < 2; ++k) dst[n][k] = *(const PG8_LAS bf16x8*)(lds + PG8_SB(b, h) + boff + n * 2048 + k * 1024); } while (0)
#define PG8_CAT(lo, hi) __builtin_shufflevector(__builtin_bit_cast(i32x4, lo), __builtin_bit_cast(i32x4, hi), 0, 1, 2, 3, 4, 5, 6, 7)
#define PG8_MMA(ai, bj, At, Bt) do { __builtin_amdgcn_s_setprio(1); _Pragma("unroll") for (int m = 0; m < 4; ++m) _Pragma("unroll") for (int n = 0; n < 2; ++n) { \
        if constexpr (F8) asm volatile("v_mfma_f32_16x16x128_f8f6f4 %0, %1, %2, %0" : "+v"(acc[ai][bj][m][n]) : "v"(PG8_CAT(Bt[n][0], Bt[n][1])), "v"(PG8_CAT(At[m][0], At[m][1])));   \
        else { _Pragma("unroll") for (int k = 0; k < 2; ++k) acc[ai][bj][m][n] = __builtin_amdgcn_mfma_f32_16x16x32_bf16(Bt[n][k], At[m][k], acc[ai][bj][m][n], 0, 0, 0); } } __builtin_amdgcn_s_setprio(0); } while (0)
#define PG8_MMA_CORE(ai, bj, At, Bt) do { _Pragma("unroll") for (int m = 0; m < 4; ++m) _Pragma("unroll") for (int n = 0; n < 2; ++n) { \
        if constexpr (F8) asm volatile("v_mfma_f32_16x16x128_f8f6f4 %0, %1, %2, %0" : "+v"(acc[ai][bj][m][n]) : "v"(PG8_CAT(Bt[n][0], Bt[n][1])), "v"(PG8_CAT(At[m][0], At[m][1]))); \
        else { _Pragma("unroll") for (int k = 0; k < 2; ++k) acc[ai][bj][m][n] = __builtin_amdgcn_mfma_f32_16x16x32_bf16(Bt[n][k], At[m][k], acc[ai][bj][m][n], 0, 0, 0); } } } while (0)
#define PG8_MMA2(ai, At, Bx, By) do { __builtin_amdgcn_s_setprio(1); PG8_MMA_CORE(ai, 0, At, Bx); PG8_MMA_CORE(ai, 1, At, By); __builtin_amdgcn_s_setprio(0); } while (0)
#define PG8_WAIT_V(n) asm volatile("s_waitcnt vmcnt(" #n ")" ::: "memory")
#define PG8_WAIT_L(n) do { if ((n) == 0) __builtin_amdgcn_s_waitcnt(0xC07F); else asm volatile("s_waitcnt lgkmcnt(" #n ")" ::: "memory"); } while (0)
#define PG8_BAR __builtin_amdgcn_s_barrier()
#define PG8_SCHED __builtin_amdgcn_sched_barrier(0)
    Unit cur, nxt; int ui = 0;
    if (!S.next(0, cur)) return;
    f32x4 acc[2][2][4][2];
#pragma unroll
    for (int a = 0; a < 2; ++a)
#pragma unroll
        for (int b = 0; b < 2; ++b)
#pragma unroll
            for (int m = 0; m < 4; ++m)
#pragma unroll
                for (int n = 0; n < 2; ++n) acc[a][b][m][n] = (f32x4){0.f, 0.f, 0.f, 0.f};
    bf16x8 At[4][2], B0[2][2], B1[2][2];
    const char* cA = uni_ptr((const char*)g.A + (size_t)cur.pm * tstep); const char* cB = uni_ptr((const char*)g.Bt + (size_t)cur.pe * g.estride + (size_t)cur.pn * tstep);
    S.a_ready(cur);
    if constexpr (Epi::PREFETCH) E.prefetch_first(lds + STAGE_BYTES, cur, tid);
    if constexpr (SP2) {
        PG8_STAGE(PG8_SB(0, 0), cB, voffB); PG8_STAGE(PG8_SB(0, 1), cB + hstep, voffB); PG8_STAGE(PG8_SA(0, 0), cA, voffA); PG8_STAGE(PG8_SA(0, 1), cA + hstep, voffA);
        if (wr == 1) PG8_BAR;
        PG8_WAIT_V(2); PG8_BAR;
        PG8_STAGE(PG8_SB(1, 0), cB + kstep, voffB); PG8_STAGE(PG8_SA(1, 0), cA + kstep, voffA); PG8_STAGE(PG8_SB(1, 1), cB + hstep + kstep, voffB);
        PG8_WAIT_V(6); PG8_BAR;
    } else {
        PG8_STAGE(PG8_SB(0, 0), cB, voffB); PG8_STAGE(PG8_SA(0, 0), cA, voffA); PG8_STAGE(PG8_SB(0, 1), cB + hstep, voffB); PG8_STAGE(PG8_SA(0, 1), cA + hstep, voffA);
        if (wr == 1) PG8_BAR;
        PG8_WAIT_V(4); PG8_BAR;
        PG8_STAGE(PG8_SB(1, 0), cB + kstep, voffB); PG8_STAGE(PG8_SA(1, 0), cA + kstep, voffA); PG8_STAGE(PG8_SB(1, 1), cB + hstep + kstep, voffB);
        PG8_WAIT_V(6); PG8_BAR;
    }
    for (;;) {
        const bool has_next = S.next(ui + 1, nxt);
        const char* nA = uni_ptr(has_next ? (const char*)g.A + (size_t)nxt.pm * tstep : cA); const char* nB = uni_ptr(has_next ? (const char*)g.Bt + (size_t)nxt.pe * g.estride + (size_t)nxt.pn * tstep : cB);
#pragma unroll 1
        for (int t = 0; t < nt; t += 2) {
            const bool last = (t == nt - 2);
            const char* a1 = cA + (size_t)(t + 1) * kstep;
            const char* a2 = last ? nA : cA + (size_t)(t + 2) * kstep; const char* b2 = last ? nB : cB + (size_t)(t + 2) * kstep;
            const char* a3 = a2 + kstep; const char* b3 = b2 + kstep;
            if (last && has_next) S.a_ready(nxt);
            if constexpr (SP2) {
            PG8_LDB(B0, 0, 0); PG8_LDB(B1, 0, 1); PG8_SCHED; PG8_LDA(At, 0, 0); PG8_STAGE(PG8_SA(1, 1), a1 + hstep, voffA);
            PG8_WAIT_V(8); PG8_WAIT_L(0); PG8_BAR; PG8_MMA2(0, At, B0, B1); PG8_BAR; PG8_SCHED;
            PG8_LDA(At, 0, 1); PG8_STAGE(PG8_SB(0, 0), b2, voffB); PG8_STAGE(PG8_SB(0, 1), b2 + hstep, voffB); PG8_STAGE(PG8_SA(0, 0), a2, voffA);
            PG8_WAIT_V(8); PG8_WAIT_L(0); PG8_BAR; PG8_MMA2(1, At, B0, B1); PG8_BAR; PG8_SCHED;
            PG8_LDB(B0, 1, 0); PG8_LDB(B1, 1, 1); PG8_SCHED; PG8_LDA(At, 1, 0); PG8_STAGE(PG8_SA(0, 1), a2 + hstep, voffA);
            PG8_WAIT_V(8); PG8_WAIT_L(0); PG8_BAR; PG8_MMA2(0, At, B0, B1); PG8_BAR; PG8_SCHED;
            PG8_LDA(At, 1, 1); PG8_STAGE(PG8_SB(1, 0), b3, voffB); PG8_STAGE(PG8_SB(1, 1), b3 + hstep, voffB); PG8_STAGE(PG8_SA(1, 0), a3, voffA);
            PG8_WAIT_V(8); PG8_WAIT_L(0); PG8_BAR; PG8_MMA2(1, At, B0, B1); PG8_BAR; PG8_SCHED;
            } else {
            PG8_LDB(B0, 0, 0); PG8_SCHED; PG8_LDA(At, 0, 0); PG8_STAGE(PG8_SA(1, 1), a1 + hstep, voffA);
            PG8_WAIT_L(8); PG8_BAR; PG8_WAIT_L(0); PG8_MMA(0, 0, At, B0); PG8_BAR; PG8_SCHED;
            PG8_LDB(B1, 0, 1); PG8_STAGE(PG8_SB(0, 0), b2, voffB);
            PG8_BAR; PG8_WAIT_L(0); PG8_MMA(0, 1, At, B1); PG8_BAR;
            PG8_LDA(At, 0, 1); PG8_STAGE(PG8_SA(0, 0), a2, voffA);
            PG8_BAR; PG8_WAIT_L(0); PG8_MMA(1, 0, At, B0); PG8_BAR; PG8_SCHED;
            PG8_STAGE(PG8_SB(0, 1), b2 + hstep, voffB);
            PG8_WAIT_V(6); PG8_BAR; PG8_MMA(1, 1, At, B1); PG8_BAR;
            PG8_LDB(B0, 1, 0); PG8_SCHED; PG8_LDA(At, 1, 0); PG8_STAGE(PG8_SA(0, 1), a2 + hstep, voffA);
            PG8_WAIT_L(8); PG8_BAR; PG8_WAIT_L(0); PG8_MMA(0, 0, At, B0); PG8_BAR; PG8_SCHED;
            PG8_LDB(B1, 1, 1); PG8_STAGE(PG8_SB(1, 0), b3, voffB);
            PG8_BAR; PG8_WAIT_L(0); PG8_MMA(0, 1, At, B1); PG8_BAR;
            PG8_LDA(At, 1, 1); PG8_STAGE(PG8_SA(1, 0), a3, voffA);
            PG8_BAR; PG8_WAIT_L(0); PG8_MMA(1, 0, At, B0); PG8_BAR; PG8_SCHED;
            PG8_STAGE(PG8_SB(1, 1), b3 + hstep, voffB);
            PG8_WAIT_V(6); PG8_BAR; PG8_MMA(1, 1, At, B1); PG8_BAR;
            }
        }
        if constexpr (ALIGN_EPI) { if (wr == 0) PG8_BAR; }
        if constexpr (F8) { PG8_SCHED; asm volatile("s_nop 15\n\ts_nop 7" ::: "memory"); PG8_SCHED; }
        if constexpr (!Epi::AFTER_DRAIN) { if constexpr (Epi::PREFETCH) E(acc, cur, wr, wc, fr, fq, lds + STAGE_BYTES, ui & 1, has_next, nxt, tid); else E(acc, cur, wr, wc, fr, fq); S.done(cur); }
        if (!has_next) break;
#pragma unroll
        for (int a = 0; a < 2; ++a)
#pragma unroll
            for (int b = 0; b < 2; ++b)
#pragma unroll
                for (int m = 0; m < 4; ++m)
#pragma unroll
                    for (int n = 0; n < 2; ++n) acc[a][b][m][n] = (f32x4){0.f, 0.f, 0.f, 0.f};
        cur = nxt; cA = nA; cB = nB; ++ui;
        if constexpr (ALIGN_EPI) { if (wr == 1) PG8_BAR; }
    }
    PG8_WAIT_V(0);
    if constexpr (!ALIGN_EPI) { if (wr == 0) PG8_BAR; }
    PG8_BAR;
#undef PG8_SA
#undef PG8_SB
#undef PG8_STAGE
#undef PG8_LDA
#undef PG8_LDB
#undef PG8_MMA
#undef PG8_MMA2
#undef PG8_MMA_CORE
#undef PG8_CAT
#undef PG8_WAIT_V
#undef PG8_WAIT_L
#undef PG8_BAR
#undef PG8_SCHED
}
}

typedef unsigned short bf16;
#define GAS __attribute__((address_space(1)))
#define LAS __attribute__((address_space(3)))
typedef unsigned v4u __attribute__((ext_vector_type(4)));
typedef float f32x4 __attribute__((ext_vector_type(4)));
typedef unsigned u32x4_t __attribute__((ext_vector_type(4)));

constexpr int DM = 1024, NB = 4, SEQ = 8192, MROWS = NB * SEQ, DEPTH = 2;
constexpr int LRU_W = 512, DIN = 2560, DFF = 3072, NEXP = 8, NMOD = 6 * DM;
constexpr int ZC_XR = 0, ZC_YR = 512, ZC_Q = 1024, ZC_K = 1536, ZC_V = 2048;
constexpr int ZP = 1536;
constexpr float EPS = 1e-6f;
constexpr int NWAVES = 8;
constexpr int GEMM_LDS = 131072;

constexpr size_t MiB = 1u << 20;
constexpr size_t WS_CTL = 0;
constexpr size_t WS_WIN = 2 * MiB;
constexpr size_t WS_WOUT = 12 * MiB;
constexpr size_t WS_WGU = 16 * MiB;
constexpr size_t WS_WD = 28 * MiB;
constexpr size_t WS_MGU = 34 * MiB;
constexpr size_t WS_MD = 130 * MiB;
constexpr size_t WS_MOD = 178 * MiB;
constexpr size_t WS_ROPE = 180 * MiB;
constexpr size_t WS_AGG = 188 * MiB;
constexpr size_t WS_RP = 190 * MiB;
constexpr size_t WS_GF = 191 * MiB;
constexpr size_t WS_BIAS = WS_MOD + 512 * 1024;
constexpr size_t WS_MOE = 179 * MiB;
constexpr size_t WS_HG = 181 * MiB;
constexpr size_t WS_HG1 = 453 * MiB;
constexpr size_t WS_ACTM = 249 * MiB;
constexpr size_t WS_HB = 192 * MiB;
constexpr size_t WS_ZB = 256 * MiB;
constexpr size_t WS_KT = 352 * MiB;
constexpr size_t WS_VT = 384 * MiB;
constexpr size_t WS_MIX = 416 * MiB;
constexpr size_t WS_ACT = 256 * MiB;
constexpr size_t WS_O0S = 480 * MiB;
constexpr size_t WS_END = 521 * MiB;
static_assert(WS_ACTM + (size_t)34816 * 3072 * 2 <= WS_HG1 && WS_HG1 + (size_t)34816 * 1024 * 2 <= WS_END && WS_HG + (size_t)34816 * 1024 * 2 <= WS_ACTM && WS_MOE + 0x110000 + 16384 + 65536 <= WS_HG && WS_MOD + 2 * 4 * 6144 * 4 <= WS_MOE, "MoE workspace map");

__device__ __forceinline__ float bf2f(bf16 v) { return __uint_as_float((unsigned)v << 16); }
__device__ __forceinline__ bf16 f2bf(float f) { return (bf16)(pg8::cvt_pk_bf16(f, 0.f) & 0xffffu); }
__device__ __forceinline__ float shx(float v, int o, int lane) { return __builtin_bit_cast(float, __builtin_amdgcn_ds_bpermute((lane ^ o) << 2, __builtin_bit_cast(int, v))); }
__device__ __forceinline__ float wave_sum(float v, int lane) {
#pragma unroll
    for (int o = 1; o < 64; o <<= 1) v += shx(v, o, lane);
    return v;
}
__device__ __forceinline__ float gelu_tanh(float y) { const float u = 0.7978845608028654f * (y + 0.044715f * y * y * y); const float t = 1.0f - 2.0f / (1.0f + __expf(2.0f * u)); return 0.5f * y * (1.0f + t); }

constexpr float W_F8_SCALE = 64.0f;
template <bool F8 = false>
__device__ __forceinline__ void transpose_item(const float* W, int K, int N, bf16* WT, int dest_row0, LAS float* scr, int k0, int n0, int lane) {
    float tv[32];
#pragma unroll
    for (int i = 0; i < 32; ++i) { const int kk = 2 * i + (lane >> 5); tv[i] = __builtin_nontemporal_load(W + (size_t)(k0 + kk) * N + n0 + (lane & 31)); }
#pragma unroll
    for (int i = 0; i < 32; ++i) { const int kk = 2 * i + (lane >> 5); scr[kk * 33 + (lane & 31)] = tv[i]; }
    asm volatile("s_waitcnt lgkmcnt(0)" ::: "memory");
    const int c = lane & 7;
#pragma unroll
    for (int j = 0; j < 4; ++j) { const int n = (lane >> 3) + 8 * j; const LAS float* s = scr + (8 * c) * 33 + n;
        if constexpr (F8) { pg8::u32x2 o; o.x = pg8::cvt4_fp8(s[0 * 33] * W_F8_SCALE, s[1 * 33] * W_F8_SCALE, s[2 * 33] * W_F8_SCALE, s[3 * 33] * W_F8_SCALE); o.y = pg8::cvt4_fp8(s[4 * 33] * W_F8_SCALE, s[5 * 33] * W_F8_SCALE, s[6 * 33] * W_F8_SCALE, s[7 * 33] * W_F8_SCALE);
            *(GAS pg8::u32x2*)((unsigned char*)WT + (size_t)(dest_row0 + n) * K + k0 + 8 * c) = o; }
        else { v4u o; o.x = pg8::cvt_pk_bf16(s[0 * 33], s[1 * 33]); o.y = pg8::cvt_pk_bf16(s[2 * 33], s[3 * 33]); o.z = pg8::cvt_pk_bf16(s[4 * 33], s[5 * 33]); o.w = pg8::cvt_pk_bf16(s[6 * 33], s[7 * 33]);
            *(GAS v4u*)(WT + (size_t)(dest_row0 + n) * K + k0 + 8 * c) = o; } }
    asm volatile("s_waitcnt lgkmcnt(0)" ::: "memory");
}
__constant__ float c_inv[32] = {1.000000000e+00f, 7.498942018e-01f, 5.623413324e-01f, 4.216965139e-01f, 3.162277639e-01f, 2.371373773e-01f, 1.778279394e-01f, 1.333521456e-01f, 1.000000015e-01f, 7.498942316e-02f, 5.623413250e-02f, 4.216964915e-02f, 3.162277490e-02f, 2.371373773e-02f, 1.778279431e-02f, 1.333521400e-02f, 9.999999776e-03f, 7.498942316e-03f, 5.623413250e-03f, 4.216964822e-03f, 3.162277630e-03f, 2.371373819e-03f, 1.778279431e-03f, 1.333521446e-03f, 1.000000047e-03f, 7.498941850e-04f, 5.623413017e-04f, 4.216965172e-04f, 3.162277571e-04f, 2.371373703e-04f, 1.778279402e-04f, 1.333521504e-04f};
__device__ __forceinline__ void sincos_acc(float angf, float& cs, float& sn) {
    const double x = (double)angf;
    const double k = rint(x * 0.63661977236758134308);
    const double r = fma(-k, 6.123233995736766036e-17, fma(-k, 1.57079632679489655800, x));
    const double r2 = r * r;
    double s = -7.6471637318198164759e-13; s = fma(s, r2, 1.6059043836821614599e-10); s = fma(s, r2, -2.5052108385441718775e-08); s = fma(s, r2, 2.7557319223985890653e-06);
    s = fma(s, r2, -1.9841269841269841270e-04); s = fma(s, r2, 8.3333333333333333333e-03); s = fma(s, r2, -1.6666666666666666667e-01); s = fma(s * r2, r, r);
    double c = 4.7794773323873852974e-14; c = fma(c, r2, -1.1470745597729724714e-11); c = fma(c, r2, 2.0876756987868098979e-09); c = fma(c, r2, -2.7557319223985890653e-07);
    c = fma(c, r2, 2.4801587301587301587e-05); c = fma(c, r2, -1.3888888888888888889e-03); c = fma(c, r2, 4.1666666666666666667e-02); c = fma(c, r2, -0.5); c = fma(c, r2, 1.0);
    const int q = ((int)(long long)k) & 3;
    const double sv = (q == 0) ? s : (q == 1) ? c : (q == 2) ? -s : -c;
    const double cv = (q == 0) ? c : (q == 1) ? -s : (q == 2) ? -c : s;
    cs = (float)cv; sn = (float)sv;
}
namespace att {
typedef short bf16x8 __attribute__((ext_vector_type(8)));
typedef short s16x4 __attribute__((ext_vector_type(4)));
typedef float f32x16 __attribute__((ext_vector_type(16)));
typedef LAS const unsigned char* lds_cptr;
constexpr int KSLOT = 8192, VSLOT = 16384, NSLOT = 3;
constexpr int L_K = 0, L_V = 4 * KSLOT, L_WS = L_V + 3 * VSLOT, L_Q = L_WS + NWAVES * 256, L_END = L_Q + NWAVES * 4096;
constexpr float C2 = 0.125f * 1.4426950408889634f;
constexpr float THR = 8.0f;
__device__ __forceinline__ int crow(int r, int hi) { return (r & 3) + 8 * (r >> 2) + 4 * hi; }
__device__ __forceinline__ void glds16(const void* gsrc, unsigned lds_dst) { unsigned keep;
    asm volatile("s_mov_b32 %0, m0\n\ts_mov_b32 m0, %2\n\ts_nop 0\n\tglobal_load_lds_dwordx4 %1, off\n\ts_mov_b32 m0, %0" : "=&s"(keep) : "v"(gsrc), "s"(lds_dst) : "memory"); }
#define ATT_WAIT_BAR(N) asm volatile("s_waitcnt vmcnt(" #N ")\n\ts_barrier" ::: "memory")
__device__ __forceinline__ float max3f(float a, float b, float c) { float r; asm("v_max3_f32 %0, %1, %2, %3" : "=v"(r) : "v"(a), "v"(b), "v"(c)); return r; }
__device__ __forceinline__ float merge_max32(float m) { auto rr = __builtin_amdgcn_permlane32_swap(__float_as_uint(m), __float_as_uint(m), false, false); return fmaxf(__uint_as_float(rr[0]), __uint_as_float(rr[1])); }
__device__ __forceinline__ float merge_sum32(float m) { auto rr = __builtin_amdgcn_permlane32_swap(__float_as_uint(m), __float_as_uint(m), false, false); return __uint_as_float(rr[0]) + __uint_as_float(rr[1]); }
__device__ __forceinline__ s16x4 vtr(lds_cptr p) { typedef short v4i16_t __attribute__((ext_vector_type(4))); return __builtin_bit_cast(s16x4, __builtin_amdgcn_ds_read_tr16_b64_v4i16((LAS v4i16_t*)p)); }

#define SBAR() __builtin_amdgcn_sched_barrier(0)
#define ATT_WB(N) asm volatile("s_waitcnt vmcnt(" #N ") lgkmcnt(0)\n\ts_barrier" ::: "memory")
__device__ __forceinline__ void attn_pass(f32x16 (&o)[4], const bf16* Qblk  , const bf16* Kh, const bf16* Vh, LAS unsigned char* shm, int NT, int tmax, int wid, int lane_in) {
    int lane = lane_in; asm volatile("" : "+v"(lane));
    const int r32 = lane & 31, hi = lane >> 5;
    const bf16* Qw = Qblk + (size_t)r32 * ZP;
    const unsigned lds0 = (unsigned)(size_t)shm;
    LAS float* wsf = (LAS float*)(shm + L_WS) + wid * 64;
    const char* ksb = pg8::uni_ptr((const char*)Kh); const char* vsb = pg8::uni_ptr((const char*)Vh);
    const unsigned dmao = (unsigned)(wid * 1024 + lane * 16);
    const unsigned dmav = (unsigned)(wid * 2048 + lane * 16);
    const unsigned kdst = (unsigned)__builtin_amdgcn_readfirstlane((int)(lds0 + L_K + wid * 1024)), vdst = (unsigned)__builtin_amdgcn_readfirstlane((int)(lds0 + L_V + wid * 2048));
#define GLDS_S(sbase, ldsa) asm volatile("s_mov_b32 m0, %2\n\ts_nop 0\n\tglobal_load_lds_dwordx4 %0, %1" :: "v"(dmao), "s"(sbase), "s"(ldsa) : "memory")
#define DMA_K(t) GLDS_S(ksb + (size_t)(t) * 8192, kdst + (unsigned)(((t) & 3) * KSLOT))
#define DMA_V(t, slot) asm volatile("s_mov_b32 m0, %2\n\ts_nop 0\n\tglobal_load_lds_dwordx4 %0, %1\n\tglobal_load_lds_dwordx4 %0, %1 offset:1024" :: "v"(dmav), "s"(vsb + (size_t)(t) * 16384), "s"(vdst + (unsigned)((slot) * VSLOT)) : "memory")
    bf16x8 kf[8];
    const lds_cptr kp0 = (lds_cptr)shm + L_K + hi * 1024 + r32 * 16;
    const lds_cptr vp0 = (lds_cptr)shm + L_V + ((lane >> 4) & 1) * 32 + (lane & 3) * 8 + (4 * hi + ((lane & 15) >> 2)) * 64;
#define KFRAG(t, j) (*(const LAS bf16x8*)(kp0 + ((t) & 3) * KSLOT + ((j) >> 1) * 2048 + ((j) & 1) * 512))
    DMA_K(0); DMA_V(0, 0); DMA_K(1);
    const lds_cptr qp0 = (lds_cptr)shm + L_Q + wid * 4096 + hi * 512 + r32 * 16;
    { bf16x8 qt[4];
#pragma unroll
      for (int d0 = 0; d0 < 4; ++d0) qt[d0] = *(const bf16x8*)(Qw + d0 * 16 + hi * 8);
#pragma unroll
      for (int d0 = 0; d0 < 4; ++d0) *(LAS bf16x8*)((LAS unsigned char*)shm + L_Q + wid * 4096 + hi * 512 + r32 * 16 + d0 * 1024) = qt[d0]; }
#define QFRAG(d0) (*(const LAS bf16x8*)(qp0 + (d0) * 1024))
    bf16x8 qr[4];
    float mhat = 0.f, l_reg = 0.f;
#pragma unroll
    for (int db = 0; db < 4; ++db) o[db] = f32x16{};
    f32x16 negm = f32x16{}; asm volatile("" : "+v"(negm));
    s16x4 vlo[8], vhi[8]; u32x4_t pwa0, pwa1, pwa2, pwa3, pwb0, pwb1, pwb2, pwb3;
    f32x16 c0, c1;
    int sv_prev = 0, sv_cur = 0, sv_next = 1;
#define ROT() do { sv_prev = sv_cur; sv_cur = sv_next; sv_next = (sv_next == 2) ? 0 : sv_next + 1; } while (0)
#define PIN(x) asm volatile("" : "+v"(x))
#define MX3(a, b, c) __builtin_fmaxf(__builtin_fmaxf((a), (b)), (c))
#define EX(v) __builtin_amdgcn_exp2f(v)
#define VFR(i) (bf16x8){vlo[i][0], vlo[i][1], vlo[i][2], vlo[i][3], vhi[i][0], vhi[i][1], vhi[i][2], vhi[i][3]}
#define VRD(i, f) do { vlo[i] = vtr(vp_ + (((f) >> 2) * 4096 + ((f) & 3) * 1024)); vhi[i] = vtr(vp_ + (((f) >> 2) * 4096 + ((f) & 3) * 1024 + 512)); } while (0)
    DMA_K(2);
    ATT_WB(4);
    { asm volatile("s_waitcnt lgkmcnt(0)" ::: "memory");
#pragma unroll
      for (int d0 = 0; d0 < 4; ++d0) qr[d0] = QFRAG(d0);
      c0 = negm; c1 = negm;
#pragma unroll
      for (int d0 = 0; d0 < 4; ++d0) { c0 = __builtin_amdgcn_mfma_f32_32x32x16_bf16(KFRAG(0, 2 * d0), qr[d0], c0, 0, 0, 0); c1 = __builtin_amdgcn_mfma_f32_32x32x16_bf16(KFRAG(0, 2 * d0 + 1), qr[d0], c1, 0, 0, 0); }
      float a = MX3(c0[0], c0[1], c1[0]), b = MX3(c0[2], c0[3], c1[1]); a = MX3(a, c1[2], c1[3]);
#pragma unroll
      for (int r = 4; r < 16; r += 4) { a = MX3(a, c0[r], c0[r + 1]); b = MX3(b, c0[r + 2], c0[r + 3]); a = MX3(a, c1[r], c1[r + 1]); b = MX3(b, c1[r + 2], c1[r + 3]); }
      mhat = merge_max32(__builtin_fmaxf(a, b));
      float sacc = 0.f;
#pragma unroll
      for (int r = 0; r < 16; ++r) { c0[r] = EX(c0[r] - mhat); c1[r] = EX(c1[r] - mhat); sacc += c0[r] + c1[r]; }
      l_reg = sacc;
#pragma unroll
      for (int r = 0; r < 16; ++r) negm[r] = -mhat;
      asm volatile("" : "+v"(negm));
      pwa0 = (u32x4_t){pg8::cvt_pk_bf16(c0[0], c0[1]), pg8::cvt_pk_bf16(c0[2], c0[3]), pg8::cvt_pk_bf16(c0[4], c0[5]), pg8::cvt_pk_bf16(c0[6], c0[7])};
      pwa1 = (u32x4_t){pg8::cvt_pk_bf16(c0[8], c0[9]), pg8::cvt_pk_bf16(c0[10], c0[11]), pg8::cvt_pk_bf16(c0[12], c0[13]), pg8::cvt_pk_bf16(c0[14], c0[15])};
      pwa2 = (u32x4_t){pg8::cvt_pk_bf16(c1[0], c1[1]), pg8::cvt_pk_bf16(c1[2], c1[3]), pg8::cvt_pk_bf16(c1[4], c1[5]), pg8::cvt_pk_bf16(c1[6], c1[7])};
      pwa3 = (u32x4_t){pg8::cvt_pk_bf16(c1[8], c1[9]), pg8::cvt_pk_bf16(c1[10], c1[11]), pg8::cvt_pk_bf16(c1[12], c1[13]), pg8::cvt_pk_bf16(c1[14], c1[15])}; }
    ATT_WB(0);
    DMA_K(3); DMA_V(1, 1);
    ROT();
    kf[0] = KFRAG(1, 0); kf[1] = KFRAG(1, 1); kf[2] = KFRAG(1, 2); kf[3] = KFRAG(1, 3); qr[0] = QFRAG(0);
    ATT_WB(3);
#define GAPB(MF, X, B, PN, W) do { MF; X[B] = EX(X[B]); X[B + 1] = EX(X[B + 1]); sacc += X[B]; sacc += X[B + 1]; PN[W] = pg8::cvt_pk_bf16(X[B], X[B + 1]); PIN(PN); PIN(sacc); SBAR(); } while (0)
#define PVM(db, PWk, i) o[db] = __builtin_amdgcn_mfma_f32_32x32x16_bf16(__builtin_bit_cast(bf16x8, PWk), VFR(i), o[db], 0, 0, 0)
#define STEP(PW0, PW1, PW2, PW3, PN0, PN1, PN2, PN3, t, GK, GV, GL) do { SBAR(); \
    const lds_cptr vp_ = vp0 + sv_prev * VSLOT; \
    qr[1] = QFRAG(1); kf[4] = KFRAG(t, 4); kf[5] = KFRAG(t, 5); qr[2] = QFRAG(2); kf[6] = KFRAG(t, 6); kf[7] = KFRAG(t, 7); qr[3] = QFRAG(3); \
    VRD(0, 0); SBAR(); \
    c0 = __builtin_amdgcn_mfma_f32_32x32x16_bf16(kf[0], qr[0], negm, 0, 0, 0); VRD(1, 1); SBAR(); \
    c1 = __builtin_amdgcn_mfma_f32_32x32x16_bf16(kf[1], qr[0], negm, 0, 0, 0); VRD(2, 2); SBAR(); \
    c0 = __builtin_amdgcn_mfma_f32_32x32x16_bf16(kf[2], qr[1], c0, 0, 0, 0);     VRD(3, 3); SBAR(); \
    c1 = __builtin_amdgcn_mfma_f32_32x32x16_bf16(kf[3], qr[1], c1, 0, 0, 0);     VRD(4, 4); SBAR(); \
    c0 = __builtin_amdgcn_mfma_f32_32x32x16_bf16(kf[4], qr[2], c0, 0, 0, 0);     VRD(5, 5); SBAR(); \
    c1 = __builtin_amdgcn_mfma_f32_32x32x16_bf16(kf[5], qr[2], c1, 0, 0, 0);     VRD(6, 6); SBAR(); \
    c0 = __builtin_amdgcn_mfma_f32_32x32x16_bf16(kf[6], qr[3], c0, 0, 0, 0);     VRD(7, 7); SBAR(); \
    c1 = __builtin_amdgcn_mfma_f32_32x32x16_bf16(kf[7], qr[3], c1, 0, 0, 0); SBAR(); \
    if (GK) { DMA_K((t) + 3); } if (GV) { DMA_V((t) + 1, sv_next); } \
    if (__builtin_expect((t) > tmax, 0)) { asm volatile("; masked tile" ::: "memory"); _Pragma("unroll") for (int r = 0; r < 16; ++r) { c0[r] = -INFINITY; c1[r] = -INFINITY; } asm volatile("" : "+v"(c0), "+v"(c1)); } \
    SBAR(); \
    float sacc = 0.f; \
    GAPB(PVM(0, PW0, 0), c0, 0,  PN0, 0); VRD(0, 8);  SBAR(); \
    GAPB(PVM(0, PW1, 1), c0, 2,  PN0, 1); VRD(1, 9);  SBAR(); \
    GAPB(PVM(0, PW2, 2), c0, 4,  PN0, 2); VRD(2, 10); SBAR(); \
    GAPB(PVM(0, PW3, 3), c0, 6,  PN0, 3); VRD(3, 11); SBAR(); \
    GAPB(PVM(1, PW0, 4), c0, 8,  PN1, 0); VRD(4, 12); SBAR(); \
    GAPB(PVM(1, PW1, 5), c0, 10, PN1, 1); VRD(5, 13); SBAR(); \
    GAPB(PVM(1, PW2, 6), c0, 12, PN1, 2); VRD(6, 14); SBAR(); \
    GAPB(PVM(1, PW3, 7), c0, 14, PN1, 3); VRD(7, 15); SBAR(); \
    if (GL) { kf[0] = KFRAG((t) + 1, 0); SBAR(); } GAPB(PVM(2, PW0, 0), c1, 0,  PN2, 0); \
    if (GL) { kf[1] = KFRAG((t) + 1, 1); SBAR(); } GAPB(PVM(2, PW1, 1), c1, 2,  PN2, 1); \
    if (GL) { kf[2] = KFRAG((t) + 1, 2); SBAR(); } GAPB(PVM(2, PW2, 2), c1, 4,  PN2, 2); \
    if (GL) { kf[3] = KFRAG((t) + 1, 3); qr[0] = QFRAG(0); SBAR(); } GAPB(PVM(2, PW3, 3), c1, 6,  PN2, 3); \
    GAPB(PVM(3, PW0, 4), c1, 8,  PN3, 0); \
    GAPB(PVM(3, PW1, 5), c1, 10, PN3, 1); \
    GAPB(PVM(3, PW2, 6), c1, 12, PN3, 2); \
    GAPB(PVM(3, PW3, 7), c1, 14, PN3, 3); \
    l_reg += sacc; \
    } while (0)
#define STEP_AB(t, GK, GV, GL) STEP(pwa0, pwa1, pwa2, pwa3, pwb0, pwb1, pwb2, pwb3, t, GK, GV, GL)
#define STEP_BA(t, GK, GV, GL) STEP(pwb0, pwb1, pwb2, pwb3, pwa0, pwa1, pwa2, pwa3, t, GK, GV, GL)
    int t = 1;
    for (; t + 5 < NT; t += 2) {
        STEP_AB(t, true, true, true);       ATT_WB(3); ROT();
        STEP_BA(t + 1, true, true, true);   ATT_WB(3); ROT();
    }
#define ENDW(tt) do { if ((tt) + 3 < NT) { ATT_WB(3); } else if ((tt) + 2 < NT) { ATT_WB(2); } else { ATT_WB(0); } } while (0)
    for (; t + 1 < NT; t += 2) {
        STEP_AB(t, (t + 3 < NT), (t + 1 < NT), (t + 1 < NT));         ENDW(t);     ROT();
        STEP_BA(t + 1, (t + 4 < NT), (t + 2 < NT), (t + 2 < NT));     ENDW(t + 1); ROT();
    }
    STEP_AB(NT - 1, false, false, false);
    { SBAR();
      const lds_cptr vp_ = vp0 + sv_cur * VSLOT;
#pragma unroll
      for (int db = 0; db < 4; ++db) { VRD(0, db * 4 + 0); VRD(1, db * 4 + 1); VRD(2, db * 4 + 2); VRD(3, db * 4 + 3);
          PVM(db, pwb0, 0); PVM(db, pwb1, 1); PVM(db, pwb2, 2); PVM(db, pwb3, 3); } }
    ATT_WB(0);
    l_reg = merge_sum32(l_reg);
    if (hi == 0) wsf[32 + r32] = 1.0f / l_reg;
    asm volatile("s_waitcnt lgkmcnt(0)" ::: "memory");
#pragma unroll
    for (int g = 0; g < 4; ++g) { const f32x4 fv = *(const LAS f32x4*)(wsf + 32 + 8 * g + 4 * hi);
#pragma unroll
        for (int i = 0; i < 4; ++i)
#pragma unroll
            for (int db = 0; db < 4; ++db) o[db][4 * g + i] *= fv[i]; }
    asm volatile("s_waitcnt lgkmcnt(0)" ::: "memory");
#undef DMA_K
#undef DMA_V
#undef GLDS_S
#undef KFRAG
#undef QFRAG
#undef ROT
#undef PIN
#undef MX3
#undef EX
#undef VFR
#undef VRD
#undef GAPB
#undef PVM
#undef STEP
#undef STEP_AB
#undef STEP_BA
#undef ENDW
}
#undef SBAR
#undef ATT_WB

__device__ __forceinline__ void attn_unit(int b, int h, int qb, const bf16* Z, const bf16* KT, const bf16* VT, bf16* MIX, unsigned* O0S, LAS unsigned char* shm, float lam, float out_scale, const float* subg) {
    const int tid = otid(); const int wid = __builtin_amdgcn_readfirstlane(tid >> 6);
    const size_t rowbase = (size_t)b * SEQ; const int q0 = qb * 256;
    const int NT = 4 * qb + 4, tmax = 4 * qb + (wid >> 1);
    const bf16* Qblk = Z + (rowbase + q0 + wid * 32) * ZP + ZC_Q + h * 128;
    const bf16* Kh = KT + (size_t)((b * 4 + h) * 2) * SEQ * 64;
    const bf16* Vh = VT + (size_t)(b * 4 + h) * SEQ * 128;
    unsigned* svw = O0S + (size_t)wid * 2048;
    f32x16 o[4];
    attn_pass(o, Qblk, Kh, Vh, shm, NT, tmax, wid, tid & 63);
    { int lane = tid & 63; asm volatile("" : "+v"(lane)); unsigned* sv = svw + lane;
#pragma unroll
      for (int db = 0; db < 4; ++db)
#pragma unroll
          for (int r2 = 0; r2 < 8; ++r2) sv[(db * 8 + r2) * 64] = pg8::cvt_pk_bf16(o[db][2 * r2], o[db][2 * r2 + 1]); }
    attn_pass(o, Qblk + 64, Kh + (size_t)SEQ * 64, Vh, shm, NT, tmax, wid, tid & 63);
    int lane = tid & 63; asm volatile("" : "+v"(lane));
    const int r32 = lane & 31, hi = lane >> 5;
    const unsigned* sv = svw + lane;
    float ssq[16];
#pragma unroll
    for (int r = 0; r < 16; ++r) ssq[r] = 0.f;
#pragma unroll
    for (int db = 0; db < 4; ++db)
#pragma unroll
        for (int r2 = 0; r2 < 8; ++r2) { const unsigned w = sv[(db * 8 + r2) * 64];
            const float a0 = __uint_as_float(w << 16), a1 = __uint_as_float(w & 0xffff0000u);
            const float v0 = a0 - lam * o[db][2 * r2], v1 = a1 - lam * o[db][2 * r2 + 1];
            o[db][2 * r2] = v0; o[db][2 * r2 + 1] = v1; ssq[2 * r2] += v0 * v0; ssq[2 * r2 + 1] += v1 * v1; }
#pragma unroll
    for (int r = 0; r < 16; ++r) {
#pragma unroll
        for (int off = 1; off < 32; off <<= 1) ssq[r] += shx(ssq[r], off, lane);
        ssq[r] = rsqrtf(ssq[r] * (1.0f / 128.0f) + EPS) * out_scale; }
    bf16* Ow = MIX + (rowbase + q0 + wid * 32) * DM + 512 + h * 128 + r32;
#pragma unroll
    for (int db = 0; db < 4; ++db) { const float gsc = subg[32 * db + r32];
#pragma unroll
        for (int r = 0; r < 16; ++r) Ow[(size_t)crow(r, hi) * DM + 32 * db] = f2bf(o[db][r] * ssq[r] * gsc); }
}
#undef ATT_WAIT_BAR
}

namespace lru {
typedef short bf16x8 __attribute__((ext_vector_type(8)));
typedef float f32x16 __attribute__((ext_vector_type(16)));
constexpr int NCH = SEQ / 64;
constexpr int WLDS = 2 * 32 * 144;
constexpr float LOG2E = 1.4426950408889634f;
__device__ __forceinline__ float sigm(float x) { return __builtin_amdgcn_rcpf(1.0f + __builtin_amdgcn_exp2f(-LOG2E * x)); }
typedef float f32x2_t __attribute__((ext_vector_type(2)));
__device__ __forceinline__ f32x2_t ex2(f32x2_t v) { return (f32x2_t){__builtin_amdgcn_exp2f(v.x), __builtin_amdgcn_exp2f(v.y)}; }
__device__ __forceinline__ f32x2_t rc2(f32x2_t v) { return (f32x2_t){__builtin_amdgcn_rcpf(v.x), __builtin_amdgcn_rcpf(v.y)}; }
__device__ __forceinline__ f32x2_t sq2(f32x2_t v) { return (f32x2_t){__builtin_amdgcn_sqrtf(v.x), __builtin_amdgcn_sqrtf(v.y)}; }
constexpr float NL2E = -1.4426950408889634f;
__device__ __forceinline__ float gelu_fast(float y) {
    const float u2 = (2.0f * 0.7978845608028654f * LOG2E) * y * __builtin_fmaf(0.044715f * y, y, 1.0f);
    return y * __builtin_amdgcn_rcpf(1.0f + __builtin_amdgcn_exp2f(-u2)); }
__device__ __forceinline__ float one_minus_exp(float x) {
    if (x > -0.25f) { float p = 1.0f + x * (1.0f / 7.0f); p = 1.0f + x * (1.0f / 6.0f) * p; p = 1.0f + x * 0.2f * p; p = 1.0f + x * 0.25f * p; p = 1.0f + x * (1.0f / 3.0f) * p; p = 1.0f + x * 0.5f * p; return -x * p; }
    return 1.0f - __builtin_amdgcn_exp2f(LOG2E * x);
}
struct Par { const float* cw; const float* cb; const bf16* wa_img; const float* ba; const bf16* wx_img; const float* bx; const float* lam; };
__device__ __forceinline__ void load_gate_frags(bf16x8 (&wf)[8], const float* W  , int lane) {
    const int r32 = lane & 31, hi = lane >> 5;
#pragma unroll
    for (int ks = 0; ks < 4; ++ks)
#pragma unroll
        for (int nb = 0; nb < 2; ++nb) { const float* p = W + (size_t)(16 * ks + 8 * hi) * 64 + 32 * nb + r32; u32x4_t w;
            w.x = pg8::cvt_pk_bf16(p[0 * 64], p[1 * 64]); w.y = pg8::cvt_pk_bf16(p[2 * 64], p[3 * 64]); w.z = pg8::cvt_pk_bf16(p[4 * 64], p[5 * 64]); w.w = pg8::cvt_pk_bf16(p[6 * 64], p[7 * 64]);
            wf[ks * 2 + nb] = __builtin_bit_cast(bf16x8, w); }
}
struct CvJob { const float* W; unsigned char* WT; int K, N, k0, n0, d0; };
constexpr int CV_SLOTS = 16;
constexpr int CV_ITEMS = CV_SLOTS * 256 * NWAVES;
constexpr int CV_I_FF = (DM / 64) * (DFF / 32);
__device__ __forceinline__ CvJob cv_job(int m, const float* wg, const float* wu, const float* wd, unsigned char* Mgu, unsigned char* Md) {
    CvJob j; const int seg = m / CV_I_FF, r = m - seg * CV_I_FF, e = seg / 3, kind = seg - 3 * e;
    j.W = ((kind == 0) ? wg : (kind == 1) ? wu : wd) + (size_t)e * DM * DFF;
    j.WT = (kind < 2) ? Mgu + (size_t)e * 2 * DFF * DM : Md + (size_t)e * DM * DFF;
    if (kind < 2) { j.K = DM; j.N = DFF; } else { j.K = DFF; j.N = DM; }
    const int nblk = j.N / 32, kb = r / nblk, nb = r - kb * nblk; j.k0 = 64 * kb; j.n0 = 32 * nb;
    j.d0 = (kind == 0) ? 256 * (j.n0 / 128) + (j.n0 % 128) : (kind == 1) ? 256 * (j.n0 / 128) + 128 + (j.n0 % 128) : j.n0;
    return j;
}
__device__ __forceinline__ void cv_issue(const CvJob& j, LAS unsigned char* slot, int lane) {
    const float* src = j.W + (size_t)(j.k0 + (lane >> 3)) * j.N + j.n0 + 4 * (lane & 7);
#pragma unroll
    for (int q = 0; q < 8; ++q) __builtin_amdgcn_global_load_lds((const unsigned*)(src + (size_t)(8 * q) * j.N), (LAS unsigned*)(slot + q * 1024), 16, 0, 2);
}
template <int NYOUNG>
__device__ __forceinline__ void cv_finish(const CvJob& j, LAS unsigned char* slot, int lane) {
    if constexpr (NYOUNG == 4) asm volatile("s_waitcnt vmcnt(4)" ::: "memory"); else asm volatile("s_waitcnt vmcnt(0)" ::: "memory");
    const int c = lane & 7; const LAS float* t = (const LAS float*)slot;
#pragma unroll
    for (int jj = 0; jj < 4; ++jj) { const int n = (lane >> 3) + 8 * jj; const LAS float* p = t + (8 * c) * 32 + n;
        pg8::u32x2 o; o.x = pg8::cvt4_fp8(p[0 * 32] * W_F8_SCALE, p[1 * 32] * W_F8_SCALE, p[2 * 32] * W_F8_SCALE, p[3 * 32] * W_F8_SCALE); o.y = pg8::cvt4_fp8(p[4 * 32] * W_F8_SCALE, p[5 * 32] * W_F8_SCALE, p[6 * 32] * W_F8_SCALE, p[7 * 32] * W_F8_SCALE);
        __builtin_nontemporal_store(o, (GAS pg8::u32x2*)(j.WT + (size_t)(j.d0 + n) * j.K + j.k0 + 8 * c)); }
    asm volatile("s_waitcnt lgkmcnt(0)" ::: "memory");
}
struct CvCtx { const float* wg; const float* wu; const float* wd; unsigned char* Mgu; unsigned char* Md; int slot0; int gw; };
template <int PASS>
__device__ __forceinline__ void item(int b, int ch, int n, const bf16* Z, const Par& P, const bf16x8 (&wfa)[8], const bf16x8 (&wfx)[8], float2* AGG, bf16* MIX, LAS unsigned char* wl, int lane, const CvCtx& cv, int cvslot, LAS unsigned char* cvl) {
    const int r32 = lane & 31, hi = lane >> 5, c = n * 64 + lane;
    const int lr = lane >> 3, lc = lane & 7;
    const size_t row0 = (size_t)b * SEQ + (size_t)ch * 64;
    const float cw0 = P.cw[c], cw1 = P.cw[LRU_W + c], cw2 = P.cw[2 * LRU_W + c], cw3 = P.cw[3 * LRU_W + c], cbv = P.cb[c];
    const float bav2 = NL2E * P.ba[c], bxv2 = NL2E * P.bx[c];
    const float L = P.lam[c]; const float sp = log1pf(__expf(-L));
    const float ka2 = -8.0f * sp * LOG2E;
    const GAS bf16* zc = (const GAS bf16*)Z + row0 * ZP + ZC_XR + c;
    float xm3 = 0.f, xm2 = 0.f, xm1 = 0.f;
    if (ch > 0) { xm3 = bf2f(zc[-3 * ZP]); xm2 = bf2f(zc[-2 * ZP]); xm1 = bf2f(zc[-1 * ZP]); }
    float carry = 0.f;
    if (PASS == 2) {
        const float2* ag = AGG + ((size_t)b * NCH) * LRU_W + c;
        for (int cc = 0; cc < ch; cc += 64) { float2 v[64];
#pragma unroll
            for (int j = 0; j < 64; ++j) { const int ci = (cc + j < ch) ? cc + j : ch - 1; v[j] = ag[(size_t)ci * LRU_W]; }
#pragma unroll
            for (int j = 0; j < 64; ++j) { const bool ok = cc + j < ch; carry = ok ? v[j].x * carry + v[j].y : carry; } }
    }
    float h = carry, aprod = 1.0f;
    const GAS v4u* xg = (const GAS v4u*)((const GAS bf16*)Z + (row0 + lr) * ZP + ZC_XR + n * 64 + lc * 8);
    const GAS v4u* yg = (const GAS v4u*)((const GAS bf16*)Z + (row0 + lr) * ZP + ZC_YR + n * 64 + lc * 8);
    GAS v4u* og = (GAS v4u*)((GAS bf16*)MIX + (row0 + lr) * DM + n * 64 + lc * 8);
    LAS unsigned char* xt = wl; LAS unsigned char* yt = wl + 32 * 144;
    LAS bf16* xcol = (LAS bf16*)xt + lane; LAS bf16* ycol = (LAS bf16*)yt + lane;
    LAS v4u* xw = (LAS v4u*)(xt + lr * 144 + lc * 16); LAS v4u* yw = (LAS v4u*)(yt + lr * 144 + lc * 16);
#pragma unroll 1
    for (int th = 0; th < 2; ++th) {
        const int cm = (cvslot + th) * (256 * NWAVES) + cv.gw; const bool cvon = (cvslot + th) < CV_SLOTS && cv.wg != nullptr;
        CvJob cj; cj.W = nullptr;
        if (cvon) { cj = cv_job(cm, cv.wg, cv.wu, cv.wd, cv.Mgu, cv.Md); cv_issue(cj, cvl, lane); }
        v4u xq[4], yq[4];
#pragma unroll
        for (int q = 0; q < 4; ++q) { xq[q] = xg[(size_t)(th * 32 + q * 8) * (ZP / 8)]; if (PASS == 2) yq[q] = yg[(size_t)(th * 32 + q * 8) * (ZP / 8)]; }
#pragma unroll
        for (int q = 0; q < 4; ++q) { xw[q * 8 * 9] = xq[q]; if (PASS == 2) yw[q * 8 * 9] = yq[q]; }
        asm volatile("s_waitcnt lgkmcnt(0)" ::: "memory");
        float xc[32];
#pragma unroll
        for (int t = 0; t < 32; ++t) { const float xv = bf2f(xcol[t * 72]); xc[t] = cbv + cw0 * xm3 + cw1 * xm2 + cw2 * xm1 + cw3 * xv; xm3 = xm2; xm2 = xm1; xm1 = xv; }
#pragma unroll
        for (int t = 0; t < 32; ++t) xcol[t * 72] = f2bf(xc[t]);
        asm volatile("s_waitcnt lgkmcnt(0)" ::: "memory");
        f32x16 ga[2], gx[2];
        ga[0] = f32x16{}; ga[1] = f32x16{}; gx[0] = f32x16{}; gx[1] = f32x16{};
#pragma unroll
        for (int ks = 0; ks < 4; ++ks) { const bf16x8 af = *(const LAS bf16x8*)(xt + r32 * 144 + (ks * 16 + hi * 8) * 2);
#pragma unroll
            for (int nb = 0; nb < 2; ++nb) { ga[nb] = __builtin_amdgcn_mfma_f32_32x32x16_bf16(af, wfa[ks * 2 + nb], ga[nb], 0, 0, 0); gx[nb] = __builtin_amdgcn_mfma_f32_32x32x16_bf16(af, wfx[ks * 2 + nb], gx[nb], 0, 0, 0); } }
#pragma unroll
        for (int r = 0; r < 16; ++r) {
            auto s1 = __builtin_amdgcn_permlane32_swap(__float_as_uint(ga[0][r]), __float_as_uint(ga[1][r]), false, false); ga[0][r] = __uint_as_float(s1[0]); ga[1][r] = __uint_as_float(s1[1]);
            auto s2 = __builtin_amdgcn_permlane32_swap(__float_as_uint(gx[0][r]), __float_as_uint(gx[1][r]), false, false); gx[0][r] = __uint_as_float(s2[0]); gx[1][r] = __uint_as_float(s2[1]); }
#pragma unroll
        for (int g = 0; g < 4; ++g)
#pragma unroll
            for (int hf = 0; hf < 2; ++hf)
#pragma unroll
                for (int ip = 0; ip < 2; ++ip) { const int i = 2 * ip, tl = 8 * g + 4 * hf + i;
                    const f32x2_t gr = {ga[hf][4 * g + i], ga[hf][4 * g + i + 1]}, gi = {gx[hf][4 * g + i], gx[hf][4 * g + i + 1]};
                    const f32x2_t r = rc2(ex2(gr * NL2E + bav2) + 1.0f), ig = rc2(ex2(gi * NL2E + bxv2) + 1.0f);
                    const f32x2_t a = ex2(r * ka2);
                    const f32x2_t mult = sq2(1.0f - a * a);
                    const f32x2_t xv2 = {xc[tl], xc[tl + 1]};
                    const f32x2_t bt = mult * (ig * xv2);
                    ga[hf][4 * g + i] = a.x; ga[hf][4 * g + i + 1] = a.y; gx[hf][4 * g + i] = bt.x; gx[hf][4 * g + i + 1] = bt.y; }
#pragma unroll
        for (int g = 0; g < 4; ++g)
#pragma unroll
            for (int hf = 0; hf < 2; ++hf)
#pragma unroll
                for (int i = 0; i < 4; ++i) { h = ga[hf][4 * g + i] * h + gx[hf][4 * g + i]; gx[hf][4 * g + i] = h; if (PASS == 1) aprod *= ga[hf][4 * g + i]; }
        if (PASS == 2) {
#pragma unroll
            for (int g = 0; g < 4; ++g)
#pragma unroll
                for (int hf = 0; hf < 2; ++hf)
#pragma unroll
                    for (int ip = 0; ip < 2; ++ip) { const int i = 2 * ip, tl = 8 * g + 4 * hf + i;
                        const f32x2_t hh = {gx[hf][4 * g + i], gx[hf][4 * g + i + 1]};
                        const f32x2_t y2 = {bf2f(ycol[tl * 72]), bf2f(ycol[(tl + 1) * 72])};
                        const f32x2_t u2 = (y2 * (2.0f * 0.7978845608028654f * LOG2E)) * (y2 * y2 * 0.044715f + 1.0f);
                        const f32x2_t ov = hh * y2 * rc2(ex2(-u2) + 1.0f);
                        const unsigned pk = pg8::cvt_pk_bf16(ov.x, ov.y);
                        ycol[tl * 72] = (bf16)(pk & 0xffffu); ycol[(tl + 1) * 72] = (bf16)(pk >> 16); }
        }
        if (PASS == 2) {
            asm volatile("s_waitcnt lgkmcnt(0)" ::: "memory");
#pragma unroll
            for (int q = 0; q < 4; ++q) __builtin_nontemporal_store((v4u)yw[q * 8 * 9], og + (size_t)(th * 32 + q * 8) * (DM / 8));
        }
        asm volatile("s_waitcnt lgkmcnt(0)" ::: "memory");
        if (cvon) cv_finish<(PASS == 2) ? 4 : 0>(cj, cvl, lane);
    }
    if (PASS == 1) AGG[((size_t)b * NCH + ch) * LRU_W + c] = make_float2(aprod, h);
}
template <int PASS>
__device__ __forceinline__ void phase(const bf16* Z, const Par& P, float2* AGG, bf16* MIX, LAS unsigned char* lds, int vcu, int G, CvCtx cv) {
    const int tid = otid(); const int lane = tid & 63; const int wid = __builtin_amdgcn_readfirstlane(tid >> 6);
    bf16x8 wfa[8], wfx[8];
#pragma unroll
    for (int f = 0; f < 8; ++f) { wfa[f] = *(const bf16x8*)(P.wa_img + ((size_t)(wid * 8 + f) * 64 + lane) * 8); wfx[f] = *(const bf16x8*)(P.wx_img + ((size_t)(wid * 8 + f) * 64 + lane) * 8); }
    cv.gw = vcu * NWAVES + wid; if (G != 256) cv.wg = nullptr;
    int it = 0;
    for (int bc = vcu; bc < NB * NCH; bc += G, ++it) item<PASS>(bc / NCH, bc % NCH, wid, Z, P, wfa, wfx, AGG, MIX, lds + wid * WLDS, lane, cv, cv.slot0 + 2 * it, lds + NWAVES * WLDS + wid * 8192);
}
}
namespace moe {
constexpr int MAXP = 136;
constexpr int SLOTS = MAXP * 256;
constexpr int PINFO = 160;
struct Ws { int* cnt; uint4* topk; int* slot_tok; float* slot_w; int* pinfo; unsigned char* HG; int* cnt_pre; int* cntp; unsigned char* HG1; };
constexpr int NRB = 4;
struct ModVec { f32x4 gm[4], sh[4]; };
__device__ __forceinline__ void load_modvec(ModVec& mv, const float* lng, const float* mb, int sh_off, int sc_off, int lane) {
#pragma unroll
    for (int j = 0; j < 4; ++j) { const int c0 = 4 * lane + 256 * j;
        const f32x4 g = *(const f32x4*)(lng + c0), sc = *(const f32x4*)(mb + sc_off + c0); mv.sh[j] = *(const f32x4*)(mb + sh_off + c0); mv.gm[j] = g * (1.0f + sc); }
}
__device__ __forceinline__ void load_rows(f32x4 (&v)[NRB][4], const float* x, int row0, int lane) {
#pragma unroll
    for (int r = 0; r < NRB; ++r)
#pragma unroll
        for (int j = 0; j < 4; ++j) v[r][j] = __builtin_nontemporal_load((const f32x4*)(x + (size_t)(row0 + r) * DM) + lane + 64 * j);
}
__device__ __forceinline__ void norm_rows(f32x4 (&v)[NRB][4], const ModVec& mv, int lane) {
    float s[NRB];
#pragma unroll
    for (int r = 0; r < NRB; ++r) { s[r] = 0.f;
#pragma unroll
        for (int j = 0; j < 4; ++j) s[r] += (v[r][j].x * v[r][j].x + v[r][j].y * v[r][j].y) + (v[r][j].z * v[r][j].z + v[r][j].w * v[r][j].w); }
#pragma unroll
    for (int o = 1; o < 64; o <<= 1)
#pragma unroll
        for (int r = 0; r < NRB; ++r) s[r] += shx(s[r], o, lane);
#pragma unroll
    for (int r = 0; r < NRB; ++r) { const float rstd = rsqrtf(s[r] * (1.0f / DM) + EPS);
#pragma unroll
        for (int j = 0; j < 4; ++j) v[r][j] = v[r][j] * rstd * mv.gm[j] + mv.sh[j]; }
}
__device__ __forceinline__ void store_row_bf16(const f32x4 (&h)[4], bf16* dst, int lane) {
#pragma unroll
    for (int j = 0; j < 4; ++j) { uint2 o; o.x = pg8::cvt_pk_bf16(h[j].x, h[j].y); o.y = pg8::cvt_pk_bf16(h[j].z, h[j].w); *(uint2*)(dst + 4 * lane + 256 * j) = o; }
}
__device__ __forceinline__ void store_row_fp8(const f32x4 (&h)[4], unsigned char* dst, int lane) {
#pragma unroll
    for (int j = 0; j < 4; ++j) *(unsigned*)(dst + 4 * lane + 256 * j) = pg8::cvt4_fp8(h[j].x, h[j].y, h[j].z, h[j].w);
}
__device__ __forceinline__ void route_phase(const float* x, const float* lng, const float* modl, const float* router, const Ws& W, unsigned char* H8  , LAS unsigned char* lds, int vcu, int G) {
    const int tid = otid(), lane = tid & 63; const int wid = __builtin_amdgcn_readfirstlane(tid >> 6);
    LAS int* lcnt = (LAS int*)lds;
    if (tid < 80) lcnt[tid] = 0;
    __syncthreads();
    const int rpw = MROWS / G / NWAVES;
    const int rbase = vcu * (MROWS / G) + wid * rpw;
    ModVec mv; load_modvec(mv, lng, modl + (size_t)(rbase / SEQ) * NMOD, 3 * DM, 4 * DM, lane);
    for (int i = 0; i < rpw; i += NRB) {
        f32x4 v[NRB][4]; load_rows(v, x, rbase + i, lane); norm_rows(v, mv, lane);
#pragma unroll
        for (int r = 0; r < NRB; ++r) store_row_fp8(v[r], H8 + (size_t)(rbase + i + r) * DM, lane);
        float lg[NRB][8];
#pragma unroll
        for (int r = 0; r < NRB; ++r)
#pragma unroll
            for (int e = 0; e < 8; ++e) lg[r][e] = 0.f;
#pragma unroll
        for (int j = 0; j < 4; ++j)
#pragma unroll
            for (int q = 0; q < 4; ++q) { const int c = 4 * lane + 256 * j + q; const f32x4 r0 = *(const f32x4*)(router + (size_t)c * 8), r1 = *(const f32x4*)(router + (size_t)c * 8 + 4);
#pragma unroll
                for (int r = 0; r < NRB; ++r) { const float hv = v[r][j][q];
                    lg[r][0] += hv * r0.x; lg[r][1] += hv * r0.y; lg[r][2] += hv * r0.z; lg[r][3] += hv * r0.w; lg[r][4] += hv * r1.x; lg[r][5] += hv * r1.y; lg[r][6] += hv * r1.z; lg[r][7] += hv * r1.w; } }
#pragma unroll
        for (int o = 1; o < 64; o <<= 1)
#pragma unroll
            for (int r = 0; r < NRB; ++r)
#pragma unroll
                for (int e = 0; e < 8; ++e) lg[r][e] += shx(lg[r][e], o, lane);
#pragma unroll
        for (int r = 0; r < NRB; ++r) { const int row = rbase + i + r;
            int i0 = 0; float v0 = lg[r][0];
#pragma unroll
            for (int e = 1; e < 8; ++e) if (lg[r][e] > v0) { v0 = lg[r][e]; i0 = e; }
            int i1 = -1; float v1 = -INFINITY;
#pragma unroll
            for (int e = 0; e < 8; ++e) if (e != i0 && lg[r][e] > v1) { v1 = lg[r][e]; i1 = e; }
            const float e1 = expf(v1 - v0), w0 = 1.0f / (1.0f + e1), w1 = e1 / (1.0f + e1);
            if (lane == 0) { W.topk[row] = make_uint4((unsigned)i0, (unsigned)i1, __float_as_uint(w0), __float_as_uint(w1)); __hip_atomic_fetch_add(&lcnt[i0], 1, __ATOMIC_RELAXED, __HIP_MEMORY_SCOPE_WORKGROUP); __hip_atomic_fetch_add(&lcnt[8 + i1], 1, __ATOMIC_RELAXED, __HIP_MEMORY_SCOPE_WORKGROUP); __hip_atomic_fetch_add(&lcnt[16 + i0 * 8 + i1], 1, __ATOMIC_RELAXED, __HIP_MEMORY_SCOPE_WORKGROUP); } }
    }
    __syncthreads();
    if (tid < 16) W.cnt_pre[vcu * 16 + tid] = lcnt[tid];
    if (tid < 64) W.cntp[vcu * 64 + tid] = lcnt[16 + tid];
    __syncthreads();
}
__device__ __forceinline__ void flip_phase(const Ws& W, LAS unsigned char* lds, int vcu, int G) {
    const int tid = otid(), lane = tid & 63; const int wid = __builtin_amdgcn_readfirstlane(tid >> 6);
    LAS int* s_N = (LAS int*)lds; LAS int* s_P = s_N + 64; LAS int* s_f = s_P + 64; LAS int* s_run = s_f + 64; LAS int* s_c1 = s_run + 64; LAS int* s_d = s_c1 + 8; LAS int* s_up = s_d + 8; LAS int* lcnt = s_up + 8;
    const int rpg = MROWS / G;
    if (tid < 64) { s_f[tid] = 0; s_run[tid] = 0; } if (tid < 16) lcnt[tid] = 0;
    {
        int tn[8], tp[8], c1 = 0;
#pragma unroll
        for (int b = 0; b < 8; ++b) { tn[b] = 0; tp[b] = 0; }
        for (int g = lane; g < G; g += 64) { const int4 q0 = *(const int4*)(W.cntp + g * 64 + wid * 8), q1 = *(const int4*)(W.cntp + g * 64 + wid * 8 + 4); const bool pre = g < vcu;
            const int qv[8] = {q0.x, q0.y, q0.z, q0.w, q1.x, q1.y, q1.z, q1.w};
#pragma unroll
            for (int b = 0; b < 8; ++b) { tn[b] += qv[b]; tp[b] += pre ? qv[b] : 0; }
            c1 += W.cnt_pre[g * 16 + 8 + wid]; }
#pragma unroll
        for (int b = 0; b < 8; ++b) { tn[b] = (int)wave_sum((float)tn[b], lane); tp[b] = (int)wave_sum((float)tp[b], lane); }
        c1 = (int)wave_sum((float)c1, lane);
        if (lane == 0) {
#pragma unroll
            for (int b = 0; b < 8; ++b) { s_N[wid * 8 + b] = tn[b]; s_P[wid * 8 + b] = tp[b]; }
            s_c1[wid] = c1; }
    }
    __syncthreads();
    if (tid == 0) {
        int S = 0;
        for (int e = 0; e < 8; ++e) { s_d[e] = s_c1[e] & 255; s_up[e] = 0; S += s_d[e]; }
        const int j = S >> 8;
        for (int n = 0; n < j; ++n) { int best = -1, br = 0; for (int e = 0; e < 8; ++e) if (!s_up[e] && s_d[e] > br) { br = s_d[e]; best = e; } if (best >= 0) s_up[best] = 1; }
        for (int e = 0; e < 8; ++e) s_d[e] = s_up[e] ? 256 - s_d[e] : -s_d[e];
        for (int a = 0; a < 8; ++a) for (int b = 0; b < 8; ++b) { if (a == b) continue; const int need = s_d[a], give = -s_d[b];
            if (need > 0 && give > 0) { int amt = need < give ? need : give; const int av = s_N[a * 8 + b]; amt = amt < av ? amt : av; s_f[a * 8 + b] = amt; s_d[a] -= amt; s_d[b] += amt; } }
    }
    __syncthreads();
    if (wid == 0) {
        for (int r0 = 0; r0 < rpg; r0 += 64) { const int row = vcu * rpg + r0 + lane; uint4 tk = W.topk[row]; const int pr = (int)tk.x * 8 + (int)tk.y; bool flip = false;
            for (int p = 0; p < 64; ++p) { const int f = __builtin_amdgcn_readfirstlane(s_f[p]); if (f <= 0) continue;
                const unsigned long long m = __ballot(pr == p); const int base = __builtin_amdgcn_readfirstlane(s_P[p] + s_run[p]);
                if (pr == p && base + __popcll(m & ((1ull << lane) - 1ull)) < f) flip = true;
                if (lane == 0) s_run[p] = base - s_P[p] + __popcll(m); }
            if (flip) { tk = make_uint4(tk.y, tk.x, tk.w, tk.z); W.topk[row] = tk; }
            __hip_atomic_fetch_add(&lcnt[tk.x], 1, __ATOMIC_RELAXED, __HIP_MEMORY_SCOPE_WORKGROUP); __hip_atomic_fetch_add(&lcnt[8 + tk.y], 1, __ATOMIC_RELAXED, __HIP_MEMORY_SCOPE_WORKGROUP); }
    }
    __syncthreads();
    if (tid < 16) W.cnt[vcu * 16 + tid] = lcnt[tid];
    __syncthreads();
}
__device__ __forceinline__ void flipgather_phase(const unsigned char* H8, const Ws& W, LAS unsigned char* lds, int vcu, int G) {
    const int tid = otid(), lane = tid & 63; const int wid = __builtin_amdgcn_readfirstlane(tid >> 6);
    LAS int* s_N = (LAS int*)lds; LAS int* s_P = s_N + 64; LAS int* s_f = s_P + 64; LAS int* s_run = s_f + 64; LAS int* s_d = s_run + 64; LAS int* s_up = s_d + 8;
    LAS int* s_tot = s_up + 8; LAS int* s_off = s_tot + 16; LAS int* s_slot = s_off + 16;
    const int rpg = MROWS / G, rpw = rpg / NWAVES;
    LAS v4u* s_tk = (LAS v4u*)(s_slot + 2 * rpg);
    if (tid < 64) { s_f[tid] = 0; s_run[tid] = 0; }
    {
        int tn[8], tp[8];
#pragma unroll
        for (int b = 0; b < 8; ++b) { tn[b] = 0; tp[b] = 0; }
        for (int g = lane; g < G; g += 64) { const int4 q0 = *(const int4*)(W.cntp + g * 64 + wid * 8), q1 = *(const int4*)(W.cntp + g * 64 + wid * 8 + 4); const bool pre = g < vcu;
            const int qv[8] = {q0.x, q0.y, q0.z, q0.w, q1.x, q1.y, q1.z, q1.w};
#pragma unroll
            for (int b = 0; b < 8; ++b) { tn[b] += qv[b]; tp[b] += pre ? qv[b] : 0; } }
#pragma unroll
        for (int b = 0; b < 8; ++b) { tn[b] = (int)wave_sum((float)tn[b], lane); tp[b] = (int)wave_sum((float)tp[b], lane); }
        if (lane == 0) {
#pragma unroll
            for (int b = 0; b < 8; ++b) { s_N[wid * 8 + b] = tn[b]; s_P[wid * 8 + b] = tp[b]; } }
    }
    __syncthreads();
    if (tid == 0) {
        int S = 0;
        for (int e = 0; e < 8; ++e) { int c1 = 0; for (int a = 0; a < 8; ++a) c1 += s_N[a * 8 + e]; s_d[e] = c1 & 255; s_up[e] = 0; S += s_d[e]; }
        const int j = S >> 8;
        for (int n = 0; n < j; ++n) { int best = -1, br = 0; for (int e = 0; e < 8; ++e) if (!s_up[e] && s_d[e] > br) { br = s_d[e]; best = e; } if (best >= 0) s_up[best] = 1; }
        for (int e = 0; e < 8; ++e) s_d[e] = s_up[e] ? 256 - s_d[e] : -s_d[e];
        for (int a = 0; a < 8; ++a) for (int b = 0; b < 8; ++b) { if (a == b) continue; const int need = s_d[a], give = -s_d[b];
            if (need > 0 && give > 0) { int amt = need < give ? need : give; const int av = s_N[a * 8 + b]; amt = amt < av ? amt : av; s_f[a * 8 + b] = amt; s_d[a] -= amt; s_d[b] += amt; } }
    }
    __syncthreads();
    if (tid < 16) { const int k = tid >> 3, e = tid & 7; int t = 0, o = 0;
        for (int q = 0; q < 8; ++q) { const int pr = e * 8 + q, pc = q * 8 + e;
            const int fr_ = s_f[pr], fc_ = s_f[pc], Fr = fr_ < s_P[pr] ? fr_ : s_P[pr], Fc = fc_ < s_P[pc] ? fc_ : s_P[pc];
            if (k == 0) { t += s_N[pr] - fr_ + fc_; o += s_P[pr] - Fr + Fc; } else { t += s_N[pc] + fr_ - fc_; o += s_P[pc] + Fr - Fc; } }
        s_tot[tid] = t; s_off[tid] = o; }
    if (wid == 0) {
        for (int r0 = 0; r0 < rpg; r0 += 64) { const int row = vcu * rpg + r0 + lane; uint4 tk = W.topk[row]; const int pr = (int)tk.x * 8 + (int)tk.y; bool flip = false;
            for (int p = 0; p < 64; ++p) { const int f = __builtin_amdgcn_readfirstlane(s_f[p]); if (f <= 0) continue;
                const unsigned long long m = __ballot(pr == p); const int base = __builtin_amdgcn_readfirstlane(s_P[p] + s_run[p]);
                if (pr == p && base + __popcll(m & ((1ull << lane) - 1ull)) < f) flip = true;
                if (lane == 0) s_run[p] = base - s_P[p] + __popcll(m); }
            if (flip) tk = make_uint4(tk.y, tk.x, tk.w, tk.z);
            s_tk[r0 + lane] = (v4u){tk.x, tk.y, tk.z, tk.w}; }
    }
    __syncthreads();
    if (wid < 2) { const int k = wid;
        int base[8], run[8]; { int bsum = 0;
#pragma unroll
            for (int e = 0; e < 8; ++e) { base[e] = bsum + s_off[k * 8 + e]; bsum += (s_tot[k * 8 + e] + 255) & ~255; run[e] = 0; } }
        for (int r0 = 0; r0 < rpg; r0 += 64) { const int row = vcu * rpg + r0 + lane; const v4u tk = s_tk[r0 + lane]; const int ek = (k == 0) ? (int)tk.x : (int)tk.y; int slot = 0;
#pragma unroll
            for (int e = 0; e < 8; ++e) { const unsigned long long m = __ballot(ek == e); const int below = __popcll(m & ((1ull << lane) - 1ull));
                if (ek == e) slot = base[e] + run[e] + below; run[e] += __popcll(m); }
            s_slot[k * rpg + r0 + lane] = slot;
            W.slot_tok[k * SLOTS + slot] = row; W.slot_w[k * SLOTS + slot] = __uint_as_float(k == 0 ? tk.z : tk.w); }
    }
    if (vcu == 0 && tid < 2 * MAXP) { const int k = tid / MAXP, pi = tid % MAXP; int np = 0, mine = -1;
#pragma unroll
        for (int e = 0; e < 8; ++e) { const int n = (s_tot[k * 8 + e] + 255) >> 8; if (pi >= np && pi < np + n) mine = e; np += n; }
        if (mine >= 0) W.pinfo[k * PINFO + 1 + pi] = mine;
        if (pi == 0) W.pinfo[k * PINFO] = np; }
    if (vcu < 16) { const int k = vcu >> 3, e = vcu & 7; int te = 0, be = 0, bsum = 0;
#pragma unroll
        for (int q = 0; q < 8; ++q) { const int tq = s_tot[k * 8 + q]; if (q == e) { te = tq; be = bsum; } bsum += (tq + 255) & ~255; }
        const int pe = (te + 255) & ~255;
        for (int sidx = te + tid; sidx < pe; sidx += NWAVES * 64) W.slot_tok[k * SLOTS + be + sidx] = -1; }
    __syncthreads();
    { const int rbase = vcu * rpg + wid * rpw;
      for (int i = 0; i < rpw; i += 8) { v4u v[8];
#pragma unroll
          for (int r = 0; r < 8; ++r) v[r] = __builtin_nontemporal_load((const GAS v4u*)(H8 + (size_t)(rbase + i + r) * DM + 16 * lane));
#pragma unroll
          for (int r = 0; r < 8; ++r) { const int lr = wid * rpw + i + r;
              *(GAS v4u*)(W.HG + (size_t)s_slot[lr] * DM + 16 * lane) = v[r]; __builtin_nontemporal_store(v[r], (GAS v4u*)(W.HG1 + (size_t)s_slot[rpg + lr] * DM + 16 * lane)); }
      } }
    __syncthreads();
}
__device__ __forceinline__ void gather_phase(const unsigned char* H8, const Ws& W, LAS unsigned char* lds, int vcu, int G) {
    const int tid = otid(), lane = tid & 63; const int wid = __builtin_amdgcn_readfirstlane(tid >> 6);
    LAS int* s_tot = (LAS int*)lds; LAS int* s_off = s_tot + 16; LAS int* s_slot = s_tot + 32;
    const int rpg = MROWS / G, rpw = rpg / NWAVES;
    {
#pragma unroll
        for (int k = 0; k < 2; ++k) { int t = 0, o = 0;
            for (int g = lane; g < G; g += 64) { const int c = W.cnt[g * 16 + k * 8 + wid]; t += c; o += (g < vcu) ? c : 0; }
            t = (int)wave_sum((float)t, lane); o = (int)wave_sum((float)o, lane);
            if (lane == 0) { s_tot[k * 8 + wid] = t; s_off[k * 8 + wid] = o; } }
    }
    __syncthreads();
    if (wid < 2) { const int k = wid;
        int base[8], run[8]; { int bsum = 0;
#pragma unroll
            for (int e = 0; e < 8; ++e) { base[e] = bsum + s_off[k * 8 + e]; bsum += (s_tot[k * 8 + e] + 255) & ~255; run[e] = 0; } }
        for (int r0 = 0; r0 < rpg; r0 += 64) { const int row = vcu * rpg + r0 + lane; const uint4 tk = W.topk[row]; const int ek = (k == 0) ? (int)tk.x : (int)tk.y; int slot = 0;
#pragma unroll
            for (int e = 0; e < 8; ++e) { const unsigned long long m = __ballot(ek == e); const int below = __popcll(m & ((1ull << lane) - 1ull));
                if (ek == e) slot = base[e] + run[e] + below; run[e] += __popcll(m); }
            s_slot[k * rpg + r0 + lane] = slot;
            W.slot_tok[k * SLOTS + slot] = row; W.slot_w[k * SLOTS + slot] = __uint_as_float(k == 0 ? tk.z : tk.w); }
    }
    if (vcu == 0 && tid < 2 * MAXP) { const int k = tid / MAXP, pi = tid % MAXP; int np = 0, mine = -1;
#pragma unroll
        for (int e = 0; e < 8; ++e) { const int n = (s_tot[k * 8 + e] + 255) >> 8; if (pi >= np && pi < np + n) mine = e; np += n; }
        if (mine >= 0) W.pinfo[k * PINFO + 1 + pi] = mine;
        if (pi == 0) W.pinfo[k * PINFO] = np; }
    if (vcu < 16) { const int k = vcu >> 3, e = vcu & 7; int te = 0, be = 0, bsum = 0;
#pragma unroll
        for (int q = 0; q < 8; ++q) { const int tq = s_tot[k * 8 + q]; if (q == e) { te = tq; be = bsum; } bsum += (tq + 255) & ~255; }
        const int pe = (te + 255) & ~255;
        for (int sidx = te + tid; sidx < pe; sidx += NWAVES * 64) W.slot_tok[k * SLOTS + be + sidx] = -1; }
    __syncthreads();
    { const int rbase = vcu * rpg + wid * rpw;
      for (int i = 0; i < rpw; i += 8) { v4u v[8];
#pragma unroll
          for (int r = 0; r < 8; ++r) v[r] = __builtin_nontemporal_load((const GAS v4u*)(H8 + (size_t)(rbase + i + r) * DM + 16 * lane));
#pragma unroll
          for (int r = 0; r < 8; ++r) { const int lr = wid * rpw + i + r;
              *(GAS v4u*)(W.HG + (size_t)s_slot[lr] * DM + 16 * lane) = v[r]; *(GAS v4u*)(W.HG1 + (size_t)s_slot[rpg + lr] * DM + 16 * lane) = v[r]; }
      } }
    __syncthreads();
}
}

constexpr int LDS_BYTES = 147456;
constexpr int MISC_OFF = LDS_BYTES - 256;
static_assert(att::L_END <= MISC_OFF && GEMM_LDS <= MISC_OFF, "LDS map");
#define RLX_AGENT __ATOMIC_RELAXED, __HIP_MEMORY_SCOPE_AGENT
#define XB_TMO      128
#define XB_XCNT(j)  (256  + 64 * (j))
#define XB_XSUB(j)  (1280 + 64 * (j))
#define XB_XGEN(j)  (2304 + 64 * (j))
#define XB_TOP      3328
#define XB_TOPGEN   3392
#define XCD_BAR_WORDS 3456
#define XB_SPIN_CAP (1u << 18)
__device__ __forceinline__ unsigned xb_ld(unsigned* p)              { return __hip_atomic_load((GAS unsigned*)p, __ATOMIC_RELAXED, __HIP_MEMORY_SCOPE_AGENT); }
__device__ __forceinline__ unsigned xb_add(unsigned* p, unsigned v) { return __hip_atomic_fetch_add((GAS unsigned*)p, v, __ATOMIC_RELAXED, __HIP_MEMORY_SCOPE_AGENT); }
__device__ __forceinline__ unsigned xb_xcc_id() { return (unsigned)__builtin_amdgcn_s_getreg((3 << 11) | 20) & 0xFu; }
#define XB_SPIN(cond, bar) do { unsigned _sp = 0; while (cond) { __builtin_amdgcn_s_sleep(1); \
    if ((++_sp & 255u) == 0u) { if (xb_ld(&(bar)[XB_TMO])) break; if (_sp > XB_SPIN_CAP) { atomicAdd(&(bar)[XB_TMO], 1u); break; } } } } while (0)
struct XcdBarrier { unsigned* bar; unsigned x; volatile LAS unsigned* st; };
__device__ __forceinline__ XcdBarrier xcd_barrier_post(unsigned* bar, volatile LAS unsigned* st) {
    XcdBarrier b; b.bar = bar; b.x = xb_xcc_id(); b.st = st;
    if (threadIdx.x == 0) (void)xb_add(&bar[XB_XCNT(b.x)], 1u);
    return b;
}
__device__ __forceinline__ void xcd_barrier_complete(unsigned* bar, unsigned x, unsigned& nloc, unsigned& nx) {
    const unsigned G = gridDim.x * gridDim.y * gridDim.z;
    unsigned sum, cnt, mine, sp = 0u;
    for (;;) {
        sum = 0u; cnt = 0u; mine = 0u;
#pragma unroll
        for (unsigned j = 0; j < 16; ++j) { const unsigned c = xb_ld(&bar[XB_XCNT(j)]); sum += c; cnt += (c > 0u) ? 1u : 0u; mine = (j == x) ? c : mine; }
        if (sum == G) break;
        __builtin_amdgcn_s_sleep(1);
        if ((++sp & 255u) == 0u) { if (xb_ld(&bar[XB_TMO])) break; if (sp > XB_SPIN_CAP) { atomicAdd(&bar[XB_TMO], 1u); break; } }
    }
    nloc = mine > 0u ? mine : 1u; nx = cnt > 0u ? cnt : 1u;
}
__device__ __forceinline__ void xcd_barrier(const XcdBarrier& b) {
    asm volatile("s_waitcnt vmcnt(0)" ::: "memory");
    __syncthreads();
    if (threadIdx.x == 0) {
        unsigned* bar = b.bar; unsigned bx_ = b.x;
        asm volatile("" : "+s"(bar), "+s"(bx_));
        __builtin_amdgcn_s_waitcnt(0);
        unsigned nloc = b.st[0], nx = b.st[1];
        if (nloc == 0u) { xcd_barrier_complete(bar, bx_, nloc, nx); b.st[0] = nloc; b.st[1] = nx; }
        const unsigned old = xb_add(&bar[XB_XSUB(bx_)], 1u);
        const unsigned gen = old / nloc;
        if (old + 1u == (gen + 1u) * nloc) {
            __builtin_amdgcn_fence(__ATOMIC_RELEASE, "agent");
            asm volatile("s_waitcnt vmcnt(0)" ::: "memory");
            const unsigned og = xb_add(&bar[XB_TOP], 1u);
            const unsigned tg = og / nx;
            if (og + 1u == (tg + 1u) * nx) xb_add(&bar[XB_TOPGEN], 1u);
            else XB_SPIN(xb_ld(&bar[XB_TOPGEN]) == tg, bar);
            __builtin_amdgcn_fence(__ATOMIC_ACQUIRE, "agent");
            xb_add(&bar[XB_XGEN(bx_)], 1u);
            asm volatile("s_waitcnt vmcnt(0)" ::: "memory");
        } else {
            XB_SPIN(xb_ld(&bar[XB_XGEN(bx_)]) == gen, bar);
            __builtin_amdgcn_fence(__ATOMIC_ACQUIRE, "agent");
            asm volatile("s_waitcnt vmcnt(0)" ::: "memory");
        }
    }
    __syncthreads();
}

struct Params {
    const float* x_in; const float* c_in; const int* pos; const float* ada_w; const float* ada_b; const float* ln1_g; const float* ln2_g; const float* w_in; const float* conv_w; const float* conv_b;
    const float* gate_a_w; const float* gate_a_b; const float* gate_x_w; const float* gate_x_b; const float* lru_lambda; const float* lam_q1; const float* lam_k1; const float* lam_q2; const float* lam_k2;
    const float* subln_g; const float* w_out; const float* ffn_wg; const float* ffn_wu; const float* ffn_wd; const float* moe_router; const float* moe_wg; const float* moe_wu; const float* moe_wd; const float* final_g;
    float* xr; unsigned char* ws; int ph_lo, ph_hi;
};
__device__ __forceinline__ void prologue_phase(const Params& p, LAS unsigned char* lds, int vcu, int G) {
    const int tid = otid(), lane = tid & 63; const int wid = __builtin_amdgcn_readfirstlane(tid >> 6);
    unsigned char* ws = p.ws;
    if (vcu < DEPTH * NMOD / 64) {
        LAS float* sc = (LAS float*)lds; LAS float* red = sc + NB * DM;
        for (int i = tid; i < NB * DM; i += NWAVES * 64) { const float v = p.c_in[i]; sc[i] = v / (1.0f + __expf(-v)); }
        __syncthreads();
        const int l = vcu / (NMOD / 64), n0 = (vcu % (NMOD / 64)) * 64;
        const float* w = p.ada_w + (size_t)l * DM * NMOD + (size_t)(wid * 128) * NMOD + n0 + lane;
        float a0 = 0.f, a1 = 0.f, a2 = 0.f, a3 = 0.f;
#pragma unroll 8
        for (int k = 0; k < 128; ++k) { const float wv = w[(size_t)k * NMOD]; const int kk = wid * 128 + k; a0 += sc[kk] * wv; a1 += sc[DM + kk] * wv; a2 += sc[2 * DM + kk] * wv; a3 += sc[3 * DM + kk] * wv; }
        red[(wid * 4 + 0) * 64 + lane] = a0; red[(wid * 4 + 1) * 64 + lane] = a1; red[(wid * 4 + 2) * 64 + lane] = a2; red[(wid * 4 + 3) * 64 + lane] = a3;
        __syncthreads();
        if (tid < 256) { const int b = tid >> 6; float sum = p.ada_b[l * NMOD + n0 + lane];
#pragma unroll
            for (int w8 = 0; w8 < 8; ++w8) sum += red[(w8 * 4 + b) * 64 + lane];
            ((float*)(ws + WS_MOD))[((size_t)l * NB + b) * NMOD + n0 + lane] = sum; }
        __syncthreads();
    }
    { float2* tbl = (float2*)(ws + WS_ROPE);
      for (int gid = vcu * (NWAVES * 64) + tid; gid < MROWS * 32; gid += G * NWAVES * 64) { const int row = gid >> 5, i = gid & 31;
          const float ang = __fmul_rn((float)p.pos[row], c_inv[i]); float cs, sn; sincos_acc(ang, cs, sn); tbl[gid] = make_float2(cs, sn); } }
    { const int gwf = vcu * NWAVES + wid;
      if (gwf < DEPTH * 2 * 8 * 8) { const int f = gwf & 7, n = (gwf >> 3) & 7, mat = (gwf >> 6) & 1, l = gwf >> 7; const int ks = f >> 1, nb = f & 1, r32 = lane & 31, hi = lane >> 5;
          const float* W = ((mat == 0) ? p.gate_a_w : p.gate_x_w) + ((size_t)l * 8 + n) * 64 * 64; const float* pw = W + (size_t)(16 * ks + 8 * hi) * 64 + 32 * nb + r32;
          v4u w; w.x = pg8::cvt_pk_bf16(pw[0 * 64], pw[1 * 64]); w.y = pg8::cvt_pk_bf16(pw[2 * 64], pw[3 * 64]); w.z = pg8::cvt_pk_bf16(pw[4 * 64], pw[5 * 64]); w.w = pg8::cvt_pk_bf16(pw[6 * 64], pw[7 * 64]);
          *(v4u*)(ws + WS_GF + ((size_t)gwf * 64 + lane) * 16) = w; } }
    { LAS float* scr = (LAS float*)(lds + wid * (64 * 33 * 4));
      constexpr int I_IN = (DM / 64) * (DIN / 32), I_OUT = (DM / 64) * (DM / 32), I_FF = (DM / 64) * (DFF / 32);
      constexpr int NITEMS = 2 * I_IN + 2 * I_OUT + 27 * I_FF;
      const int gw = vcu * NWAVES + wid, NGW = G * NWAVES;
      for (int it = gw; it < NITEMS; it += NGW) {
          const float* W; bf16* WT; int K, N, mode, r = it; bool f8 = false;
          if (r < 2 * I_IN) { const int l = r / I_IN; r -= l * I_IN; W = p.w_in + (size_t)l * DM * DIN; WT = (bf16*)(ws + WS_WIN) + (size_t)l * DIN * DM; K = DM; N = DIN; mode = 3; }
          else if ((r -= 2 * I_IN) < 2 * I_OUT) { const int l = r / I_OUT; r -= l * I_OUT; W = p.w_out + (size_t)l * DM * DM; WT = (bf16*)(ws + WS_WOUT) + (size_t)l * DM * DM; K = DM; N = DM; mode = 0; }
          else { r -= 2 * I_OUT; if (G == 256 && r >= 3 * I_FF && r - 3 * I_FF < lru::CV_ITEMS) continue;
              const int seg = r / I_FF; r -= seg * I_FF; const int e = (seg - 3) / 3, kind = (seg < 3) ? seg : (seg - 3) % 3;
              if (seg < 3) { W = (kind == 0) ? p.ffn_wg : (kind == 1) ? p.ffn_wu : p.ffn_wd; WT = (kind < 2) ? (bf16*)(ws + WS_WGU) : (bf16*)(ws + WS_WD); f8 = !FFN0_BF16; }
              else { W = ((kind == 0) ? p.moe_wg : (kind == 1) ? p.moe_wu : p.moe_wd) + (size_t)e * DM * DFF; f8 = true;
                     WT = (bf16*)((kind < 2) ? (ws + WS_MGU) + (size_t)e * 2 * DFF * DM : (ws + WS_MD) + (size_t)e * DM * DFF); }
              if (kind < 2) { K = DM; N = DFF; mode = 1 + kind; } else { K = DFF; N = DM; mode = 0; } }
          const int nblk = N / 32, kb = r / nblk, nb = r % nblk, k0 = 64 * kb, n0 = 32 * nb;
          int d0 = n0;
          if (mode == 1) d0 = 256 * (n0 / 128) + (n0 % 128); else if (mode == 2) d0 = 256 * (n0 / 128) + 128 + (n0 % 128);
          else if (mode == 3 && n0 >= ZC_Q && n0 < ZC_V) { const int u = n0 & 255; d0 = (n0 & ~255) + 128 * ((u >> 5) & 1) + 32 * (u >> 6); }
          if (f8) transpose_item<true>(W, K, N, WT, d0, scr, k0, n0, lane); else transpose_item<false>(W, K, N, WT, d0, scr, k0, n0, lane);
      } }
}
__device__ __forceinline__ void bias_job(const unsigned char* Wgu8, const bf16* Win1, const float* sh3  , const float* sh1, float* bias, int vcu, int G) {
    const int tid = otid(), lane = tid & 63; const int wid = __builtin_amdgcn_readfirstlane(tid >> 6);
    const int gw = vcu * NWAVES + wid, NGW = G * NWAVES;
#if FFN0_BF16
    { f32x4 sh[4][4]; const bf16* Wg16 = (const bf16*)Wgu8;
#pragma unroll
      for (int b = 0; b < 4; ++b)
#pragma unroll
          for (int j = 0; j < 4; ++j) sh[b][j] = *(const f32x4*)(sh3 + (size_t)b * NMOD + 16 * lane + 4 * j);
      for (int r0 = gw * 2; r0 < 2 * DFF; r0 += NGW * 2) { v4u w[2][2]; float a[2][4];
#pragma unroll
          for (int q = 0; q < 2; ++q) { w[q][0] = *(const v4u*)(Wg16 + (size_t)(r0 + q) * DM + 16 * lane); w[q][1] = *(const v4u*)(Wg16 + (size_t)(r0 + q) * DM + 16 * lane + 8); }
#pragma unroll
          for (int q = 0; q < 2; ++q) {
#pragma unroll
              for (int b = 0; b < 4; ++b) a[q][b] = 0.f;
#pragma unroll
              for (int j = 0; j < 4; ++j) { const unsigned lo = w[q][j >> 1][2 * (j & 1)], hi = w[q][j >> 1][2 * (j & 1) + 1];
                  const f32x4 f = {__uint_as_float(lo << 16), __uint_as_float(lo & 0xffff0000u), __uint_as_float(hi << 16), __uint_as_float(hi & 0xffff0000u)};
#pragma unroll
                  for (int b = 0; b < 4; ++b) a[q][b] += (f[0] * sh[b][j][0] + f[1] * sh[b][j][1]) + (f[2] * sh[b][j][2] + f[3] * sh[b][j][3]); } }
#pragma unroll
          for (int o = 1; o < 64; o <<= 1)
#pragma unroll
              for (int q = 0; q < 2; ++q)
#pragma unroll
                  for (int b = 0; b < 4; ++b) a[q][b] += shx(a[q][b], o, lane);
          if (lane == 0) {
#pragma unroll
              for (int q = 0; q < 2; ++q)
#pragma unroll
                  for (int b = 0; b < 4; ++b) bias[b * (2 * DFF) + r0 + q] = a[q][b]; } } }
#else
    { f32x4 sh[4][4];
#pragma unroll
      for (int b = 0; b < 4; ++b)
#pragma unroll
          for (int j = 0; j < 4; ++j) sh[b][j] = *(const f32x4*)(sh3 + (size_t)b * NMOD + 16 * lane + 4 * j);
      for (int r0 = gw * 4; r0 < 2 * DFF; r0 += NGW * 4) { v4u w[4]; float a[4][4];
#pragma unroll
          for (int q = 0; q < 4; ++q) w[q] = *(const v4u*)(Wgu8 + (size_t)(r0 + q) * DM + 16 * lane);
#pragma unroll
          for (int q = 0; q < 4; ++q) {
#pragma unroll
              for (int b = 0; b < 4; ++b) a[q][b] = 0.f;
#pragma unroll
              for (int j = 0; j < 4; ++j) { const int word = (int)w[q][j]; const f32x4 f = {__builtin_amdgcn_cvt_f32_fp8(word, 0), __builtin_amdgcn_cvt_f32_fp8(word, 1), __builtin_amdgcn_cvt_f32_fp8(word, 2), __builtin_amdgcn_cvt_f32_fp8(word, 3)};
#pragma unroll
                  for (int b = 0; b < 4; ++b) a[q][b] += (f[0] * sh[b][j][0] + f[1] * sh[b][j][1]) + (f[2] * sh[b][j][2] + f[3] * sh[b][j][3]); } }
#pragma unroll
          for (int o = 1; o < 64; o <<= 1)
#pragma unroll
              for (int q = 0; q < 4; ++q)
#pragma unroll
                  for (int b = 0; b < 4; ++b) a[q][b] += shx(a[q][b], o, lane);
          if (lane == 0) {
#pragma unroll
              for (int q = 0; q < 4; ++q)
#pragma unroll
                  for (int b = 0; b < 4; ++b) bias[b * (2 * DFF) + r0 + q] = a[q][b]; } } }
#endif
    { f32x4 sh[4][4];
#pragma unroll
      for (int b = 0; b < 4; ++b)
#pragma unroll
          for (int j = 0; j < 4; ++j) sh[b][j] = *(const f32x4*)(sh1 + (size_t)b * NMOD + 16 * lane + 4 * j);
      for (int r0 = gw * 2; r0 < DIN; r0 += NGW * 2) { v4u w[2][2]; float a[2][4];
#pragma unroll
          for (int q = 0; q < 2; ++q) { w[q][0] = *(const v4u*)(Win1 + (size_t)(r0 + q) * DM + 16 * lane); w[q][1] = *(const v4u*)(Win1 + (size_t)(r0 + q) * DM + 16 * lane + 8); }
#pragma unroll
          for (int q = 0; q < 2; ++q) {
#pragma unroll
              for (int b = 0; b < 4; ++b) a[q][b] = 0.f;
#pragma unroll
              for (int j = 0; j < 4; ++j) { const unsigned lo = w[q][j >> 1][2 * (j & 1)], hi = w[q][j >> 1][2 * (j & 1) + 1];
                  const f32x4 f = {__uint_as_float(lo << 16), __uint_as_float(lo & 0xffff0000u), __uint_as_float(hi << 16), __uint_as_float(hi & 0xffff0000u)};
#pragma unroll
                  for (int b = 0; b < 4; ++b) a[q][b] += (f[0] * sh[b][j][0] + f[1] * sh[b][j][1]) + (f[2] * sh[b][j][2] + f[3] * sh[b][j][3]); } }
#pragma unroll
          for (int o = 1; o < 64; o <<= 1)
#pragma unroll
              for (int q = 0; q < 2; ++q)
#pragma unroll
                  for (int b = 0; b < 4; ++b) a[q][b] += shx(a[q][b], o, lane);
          if (lane == 0) {
#pragma unroll
              for (int q = 0; q < 2; ++q)
#pragma unroll
                  for (int b = 0; b < 4; ++b) bias[4 * (2 * DFF) + b * DIN + r0 + q] = a[q][b]; } } }
}
template <bool F8 = false>
__device__ __forceinline__ void norm_phase(const float* x, const float* lng, const float* modl, int sh_off, int sc_off, bf16* H, int vcu, int G) {
    const int tid = otid(); const int lane = tid & 63; const int wid = __builtin_amdgcn_readfirstlane(tid >> 6);
    const int rpw = MROWS / (G * NWAVES), rbase = (vcu * NWAVES + wid) * rpw;
    moe::ModVec mv; moe::load_modvec(mv, lng, modl + (size_t)(rbase / SEQ) * NMOD, sh_off, sc_off, lane);
    for (int i = 0; i < rpw; i += moe::NRB) {
        f32x4 v[moe::NRB][4]; moe::load_rows(v, x, rbase + i, lane); moe::norm_rows(v, mv, lane);
#pragma unroll
        for (int r = 0; r < moe::NRB; ++r) { if constexpr (F8) moe::store_row_fp8(v[r], (unsigned char*)H + (size_t)(rbase + i + r) * DM, lane); else moe::store_row_bf16(v[r], H + (size_t)(rbase + i + r) * DM, lane); }
    }
}
__device__ __forceinline__ void final_phase(float* x, const float* g, int vcu, int G) {
    const int tid = otid(); const int lane = tid & 63; const int wid = __builtin_amdgcn_readfirstlane(tid >> 6);
    const int rpw = MROWS / (G * NWAVES), rbase = (vcu * NWAVES + wid) * rpw;
    moe::ModVec mv;
#pragma unroll
    for (int j = 0; j < 4; ++j) { mv.gm[j] = *(const f32x4*)(g + 4 * lane + 256 * j); mv.sh[j] = (f32x4){0.f, 0.f, 0.f, 0.f}; }
    for (int i = 0; i < rpw; i += moe::NRB) {
        f32x4 v[moe::NRB][4]; moe::load_rows(v, x, rbase + i, lane); moe::norm_rows(v, mv, lane);
#pragma unroll
        for (int r = 0; r < moe::NRB; ++r)
#pragma unroll
            for (int j = 0; j < 4; ++j) ((f32x4*)(x + (size_t)(rbase + i + r) * DM) + lane)[64 * j] = v[r][j];
    }
}

#ifndef MK_PER_PHASE
#define MK_PER_PHASE 0
#endif
#ifndef REP_PRO
#define REP_PRO 1
#endif
#ifndef REP_NORM
#define REP_NORM 1
#endif
#ifndef REP_G1
#define REP_G1 1
#endif
#ifndef REP_LRU1
#define REP_LRU1 1
#endif
#ifndef REP_LRU2
#define REP_LRU2 1
#endif
#ifndef REP_ATT
#define REP_ATT 1
#endif
#ifndef REP_G3
#define REP_G3 1
#endif
#ifndef REP_ROUTE
#define REP_ROUTE 1
#endif
#ifndef REP_GATHER
#define REP_GATHER 1
#endif
#ifndef REP_GU
#define REP_GU 1
#endif
#define REPEAT(n) for (int rep_ = 0; rep_ < (n); ++rep_)
constexpr int N_PHASES = 19;
constexpr int CW_LEFT = 3584;
__global__ void __launch_bounds__(NWAVES * 64, 2) mega_fwd(Params p) {
    extern __shared__ __attribute__((aligned(16))) unsigned char lds_raw[];
    LAS unsigned char* lds = (LAS unsigned char*)lds_raw;
    const int tid = threadIdx.x; const int G = gridDim.x, bx = blockIdx.x;
    const int vcu = (G % 8 == 0) ? (bx % 8) * (G / 8) + bx / 8 : bx;
    volatile LAS unsigned* MISC = (volatile LAS unsigned*)(lds + MISC_OFF);
    if (tid < 64) MISC[tid] = 0u;
    __syncthreads();
    unsigned char* ws = p.ws;
    XcdBarrier bar; bar.bar = (unsigned*)(ws + WS_CTL); bar.x = 0; bar.st = nullptr;
    if (!MK_PER_PHASE) bar = xcd_barrier_post((unsigned*)(ws + WS_CTL), MISC + 8);
#if MK_PER_PHASE
    const int lo = p.ph_lo, hi = p.ph_hi; int ph = 0;
#endif
#if MK_PER_PHASE
#define PH_BEGIN if (lo <= ph && ph < hi) { GAS unsigned char* ws = (GAS unsigned char*)p.ws; asm volatile("" : "+s"(ws));
#define PH_END   } ++ph;
#define PH_LAST  } ++ph;
#else
#define PH_BEGIN { GAS unsigned char* ws = (GAS unsigned char*)p.ws; asm volatile("" : "+s"(ws));
#define PH_END   xcd_barrier(bar); }
#define PH_LAST  }
#endif
#define Win ((bf16*)(ws + WS_WIN))
#define Wout ((bf16*)(ws + WS_WOUT))
#define Wgu ((bf16*)(ws + WS_WGU))
#define Wd ((bf16*)(ws + WS_WD))
#define Mgu ((unsigned char*)(ws + WS_MGU))
#define Md ((unsigned char*)(ws + WS_MD))
#define MOD ((float*)(ws + WS_MOD))
#define ROPE ((const float*)(ws + WS_ROPE))
#define AGG ((float2*)(ws + WS_AGG))
#define RPP ((float*)(ws + WS_RP))
#define BIASP ((float*)(ws + WS_BIAS))
#define HB ((bf16*)(ws + WS_HB))
#define ZB ((bf16*)(ws + WS_ZB))
#define KTB ((bf16*)(ws + WS_KT))
#define VTB ((bf16*)(ws + WS_VT))
#define MIX ((bf16*)(ws + WS_MIX))
#define ACT ((bf16*)(ws + WS_ACT))
#define ACTM ((unsigned char*)(ws + WS_ACTM))
    float* xr = p.xr;

    PH_BEGIN REPEAT(REP_PRO) { prologue_phase(p, lds, vcu, G); __syncthreads(); } PH_END

#pragma unroll 1
    for (int l = 0; l < DEPTH; ++l) {
        const float lambda_init = 0.8f - 0.6f * __expf(-0.3f * (float)l);
        const float* modl = MOD + (size_t)l * NB * NMOD;
        const float* xcur = (l == 0) ? p.x_in : xr;
        if (l == 0) { PH_BEGIN REPEAT(REP_NORM) norm_phase<false>(xcur, p.ln1_g + l * DM, modl, 0, DM, HB, vcu, G);
                      bias_job((const unsigned char*)Wgu, Win + (size_t)DIN * DM, MOD + 3 * DM, MOD + (size_t)NB * NMOD, BIASP, vcu, G); PH_END }
        PH_BEGIN REPEAT(REP_G1) { pg8::Gemm g{HB, Win + (size_t)l * DIN * DM, 0, MROWS, DIN, DM, 0}; pg8::StaticOrder S; S.init(MROWS, DIN, G, bx);
                   pg8::EpiAffine<pg8::EpiG1> E{{ZB, KTB, VTB, ROPE, ZP, SEQ}, (l == 1) ? RPP : nullptr, BIASP + 4 * (2 * DFF), DIN, SEQ, 1.0f / DM, EPS};
                   pg8::gemm_phase<pg8::EpiAffine<pg8::EpiG1>, pg8::StaticOrder, true, true>(lds, g, S, E); } PH_END
        lru::Par LP{p.conv_w + l * 4 * LRU_W, p.conv_b + l * LRU_W, (const bf16*)(ws + WS_GF) + (size_t)(l * 2 + 0) * 32768, p.gate_a_b + l * LRU_W, (const bf16*)(ws + WS_GF) + (size_t)(l * 2 + 1) * 32768, p.gate_x_b + l * LRU_W, p.lru_lambda + l * LRU_W};
        PH_BEGIN REPEAT(REP_LRU1) lru::phase<1>(ZB, LP, AGG, MIX, lds, vcu, G, lru::CvCtx{p.moe_wg, p.moe_wu, p.moe_wd, Mgu, Md, l * 8, 0}); PH_END
        PH_BEGIN { const bool att_first = ((bx >> 3) & 1) != 0;
#pragma unroll 1
                   for (int step = 0; step < 2; ++step) {
                       if ((step == 0) != att_first) { REPEAT(REP_LRU2) lru::phase<2>(ZB, LP, AGG, MIX, lds, vcu, G, lru::CvCtx{p.moe_wg, p.moe_wu, p.moe_wd, Mgu, Md, l * 8 + 4, 0}); }
                       else { const int lane = otid() & 63;
                           const float lam = __expf(wave_sum(p.lam_q1[l * 64 + lane] * p.lam_k1[l * 64 + lane], lane)) - __expf(wave_sum(p.lam_q2[l * 64 + lane] * p.lam_k2[l * 64 + lane], lane)) + lambda_init;
                           REPEAT(REP_ATT) for (int pp = vcu; pp < 256; pp += G) { const int bh = pp >> 4, s = pp & 15;
                               att::attn_unit(bh >> 2, bh & 3, s, ZB, KTB, VTB, MIX, (unsigned*)(ws + WS_O0S) + (size_t)bx * 16384, lds, lam, 1.0f - lambda_init, p.subln_g + l * 128);
                               att::attn_unit(bh >> 2, bh & 3, 31 - s, ZB, KTB, VTB, MIX, (unsigned*)(ws + WS_O0S) + (size_t)bx * 16384, lds, lam, 1.0f - lambda_init, p.subln_g + l * 128); } }
                       __syncthreads(); } } PH_END
        PH_BEGIN { pg8::Gemm g{MIX, Wout + (size_t)l * DM * DM, 0, MROWS, DM, DM, 0}; pg8::StaticOrder S; S.init(MROWS, DM, G, bx);
                   if (l == 0) { pg8::EpiResidQ<!FFN0_BF16> E{xcur, xr, modl + 2 * DM, p.ln2_g, modl + 4 * DM, (void*)HB, RPP, DM, NMOD, SEQ, 1.0f};
                                 pg8::gemm_phase<pg8::EpiResidQ<!FFN0_BF16>, pg8::StaticOrder, true, true>(lds, g, S, E); }
                   else { pg8::EpiResid E{xcur, xr, modl + 2 * DM, nullptr, DM, NMOD, SEQ, 0, 1.0f, 0};
                          pg8::gemm_phase<pg8::EpiResid, pg8::StaticOrder, true, true>(lds, g, S, E); } } PH_END
        if (l == 0) {
#if FFN0_BF16
            PH_BEGIN REPEAT(REP_G3) { pg8::Gemm g{HB, Wgu, 0, MROWS, 2 * DFF, DM, 0}; pg8::StaticOrder S; S.init(MROWS, 2 * DFF, G, bx);
                       pg8::EpiAffine<pg8::EpiSwiglu> E{{ACT, DFF, 0}, RPP, BIASP, 2 * DFF, SEQ, 1.0f / DM, EPS};
                       pg8::gemm_phase<pg8::EpiAffine<pg8::EpiSwiglu>, pg8::StaticOrder, true, true, false>(lds, g, S, E); } PH_END
            PH_BEGIN { pg8::Gemm g{ACT, Wd, 0, MROWS, DM, DFF, 0}; pg8::StaticOrder S; S.init(MROWS, DM, G, bx);
                       pg8::EpiResidQ<false> E{xr, xr, modl + 5 * DM, p.ln1_g + DM, MOD + (size_t)NB * NMOD + DM, (void*)HB, RPP, DM, NMOD, SEQ, 1.0f};
                       pg8::gemm_phase<pg8::EpiResidQ<false>, pg8::StaticOrder, true, true, false>(lds, g, S, E); } PH_END
#else
            PH_BEGIN REPEAT(REP_G3) { pg8::Gemm g{HB, Wgu, 0, MROWS, 2 * DFF, DM / 2, 0}; pg8::StaticOrder S; S.init(MROWS, 2 * DFF, G, bx);
                       pg8::EpiAffine<pg8::EpiSwigluF8> E{{(unsigned char*)ACT, DFF, 1.0f / W_F8_SCALE}, RPP, BIASP, 2 * DFF, SEQ, 1.0f / DM, EPS};
                       pg8::gemm_phase<pg8::EpiAffine<pg8::EpiSwigluF8>, pg8::StaticOrder, true, true, true>(lds, g, S, E); } PH_END
            PH_BEGIN { pg8::Gemm g{ACT, Wd, 0, MROWS, DM, DFF / 2, 0}; pg8::StaticOrder S; S.init(MROWS, DM, G, bx);
                       pg8::EpiResidQ<false> E{xr, xr, modl + 5 * DM, p.ln1_g + DM, MOD + (size_t)NB * NMOD + DM, (void*)HB, RPP, DM, NMOD, SEQ, 1.0f / (W_F8_SCALE * pg8::ACT_F8_SCALE)};
                       pg8::gemm_phase<pg8::EpiResidQ<false>, pg8::StaticOrder, true, true, true>(lds, g, S, E); } PH_END
#endif
        } else {
            unsigned char* mb = ws + WS_MOE;
            moe::Ws W{(int*)mb, (uint4*)(mb + 16384), (int*)(mb + 16384 + 524288), (float*)(mb + 16384 + 524288 + 2 * moe::SLOTS * 4), (int*)(mb + 16384 + 524288 + 4 * moe::SLOTS * 4), (unsigned char*)(ws + WS_HG), (int*)(mb + 0x110000), (int*)(mb + 0x110000 + 16384), (unsigned char*)(ws + WS_HG1)};
            PH_BEGIN REPEAT(REP_ROUTE) moe::route_phase(xr, p.ln2_g + l * DM, modl, p.moe_router, W, (unsigned char*)(ws + WS_KT), lds, vcu, G); PH_END
            PH_BEGIN REPEAT(REP_GATHER) moe::flipgather_phase((const unsigned char*)(ws + WS_KT), W, lds, vcu, G); PH_END
            unsigned* left_done = (unsigned*)(ws + WS_CTL) + CW_LEFT;
            PH_BEGIN REPEAT(REP_GU) { pg8::Gemm g{(const bf16*)W.HG, (const bf16*)Mgu, (size_t)2 * DFF * DM, moe::SLOTS, 2 * DFF, DM / 2, 0}; pg8::PanelOrder S; S.init(W.pinfo[0], 2 * DFF, G, bx, W.pinfo + 1); pg8::EpiSwigluF8 E{ACTM, DFF, 1.0f / W_F8_SCALE};
                       pg8::gemm_phase<pg8::EpiSwigluF8, pg8::PanelOrder, true, true, true>(lds, g, S, E); } PH_END
            PH_BEGIN { pg8::Gemm g{(const bf16*)ACTM, (const bf16*)Md, (size_t)DM * DFF, moe::SLOTS, DM, DFF / 2, 0}; pg8::DownOrder S; S.init(W.pinfo[0], DM / 256, G, bx, W.pinfo + 1, 0);
                       pg8::EpiScatter E{xr, modl + 5 * DM, W.slot_tok, W.slot_w, DM, NMOD, SEQ, 1.0f / (W_F8_SCALE * pg8::ACT_F8_SCALE)};
                       pg8::gemm_phase<pg8::EpiScatter, pg8::DownOrder, true, true, true>(lds, g, S, E); } PH_END
            PH_BEGIN { const int np0 = W.pinfo[0]; const int nu0 = np0 * (DM / 256); const int left = nu0 - (nu0 / G) * G;
                       { pg8::Gemm g{(const bf16*)ACTM, (const bf16*)Md, (size_t)DM * DFF, moe::SLOTS, DM, DFF / 2, 0}; pg8::DownOrder S; S.init(np0, DM / 256, G, bx, W.pinfo + 1, 1);
                         pg8::EpiScatter E{xr, modl + 5 * DM, W.slot_tok, W.slot_w, DM, NMOD, SEQ, 1.0f / (W_F8_SCALE * pg8::ACT_F8_SCALE)};
                         pg8::gemm_phase<pg8::EpiScatter, pg8::DownOrder, false, true, true>(lds, g, S, E);
                         if (bx < left && otid() == 0) __hip_atomic_fetch_add(left_done, 1u, __ATOMIC_RELAXED, __HIP_MEMORY_SCOPE_AGENT); }
                       { pg8::Gemm g{(const bf16*)W.HG1, (const bf16*)Mgu, (size_t)2 * DFF * DM, moe::SLOTS, 2 * DFF, DM / 2, 0}; pg8::GuOverlapOrder S; S.init(W.pinfo[moe::PINFO], 2 * DFF, G, bx, W.pinfo + moe::PINFO + 1, left);
                         pg8::EpiSwigluGuard E{{ACTM, DFF, 1.0f / W_F8_SCALE}, left_done, (nu0 / G) * G / (DM / 256), left};
                         pg8::gemm_phase<pg8::EpiSwigluGuard, pg8::GuOverlapOrder, true, true, true>(lds, g, S, E); } } PH_END
            PH_BEGIN { pg8::Gemm g{(const bf16*)ACTM, (const bf16*)Md, (size_t)DM * DFF, moe::SLOTS, DM, DFF / 2, 0}; pg8::DownOrder S; S.init(W.pinfo[moe::PINFO], DM / 256, G, bx, W.pinfo + moe::PINFO + 1, 2);
                       pg8::EpiScatter E{xr, modl + 5 * DM, W.slot_tok + moe::SLOTS, W.slot_w + moe::SLOTS, DM, NMOD, SEQ, 1.0f / (W_F8_SCALE * pg8::ACT_F8_SCALE)};
                       pg8::gemm_phase<pg8::EpiScatter, pg8::DownOrder, true, true, true>(lds, g, S, E); } PH_END
        }
    }
    PH_BEGIN final_phase(xr, p.final_g, vcu, G); PH_LAST
#undef PH_BEGIN
#undef PH_END
#undef PH_LAST
}

extern "C" void kernel_launch(void* const* d_in, const int* in_sizes, int n_in, void* d_out, int out_size, void* d_ws, size_t ws_size, hipStream_t stream) {
    static int grid = 0;
    if (grid == 0) {
        if (n_in != 29 || in_sizes[0] != MROWS * DM || out_size != MROWS * DM || ws_size < WS_END) { fprintf(stderr, "kernel_launch: unexpected shapes / workspace (n_in %d, ws %zu); nothing launched\n", n_in, ws_size); grid = -1; return; }
        int dev = 0, cus = 0, per_cu = 0;
        if (hipGetDevice(&dev) != hipSuccess || hipDeviceGetAttribute(&cus, hipDeviceAttributeMultiprocessorCount, dev) != hipSuccess) { grid = -1; return; }
        if (hipFuncSetAttribute((const void*)mega_fwd, hipFuncAttributeMaxDynamicSharedMemorySize, LDS_BYTES) != hipSuccess) { fprintf(stderr, "kernel_launch: hipFuncSetAttribute failed\n"); grid = -1; return; }
        if (hipOccupancyMaxActiveBlocksPerMultiprocessor(&per_cu, (const void*)mega_fwd, NWAVES * 64, LDS_BYTES) != hipSuccess || per_cu < 1)
            fprintf(stderr, "kernel_launch: note: occupancy query reports %d workgroups per CU\n", per_cu);
        (void)hipGetLastError();
        grid = cus;
        if (MROWS % (grid * NWAVES) != 0) { fprintf(stderr, "kernel_launch: grid %d does not divide the row count\n", grid); grid = -1; return; }
    }
    if (grid < 0) return;
    if (hipMemsetAsync((char*)d_ws + WS_CTL, 0, 16384, stream) != hipSuccess) return;
    Params p{};
    const float** pf = (const float**)&p;
    p.x_in = (const float*)d_in[0]; p.c_in = (const float*)d_in[1]; p.pos = (const int*)d_in[2]; p.ada_w = (const float*)d_in[3]; p.ada_b = (const float*)d_in[4];
    p.ln1_g = (const float*)d_in[5]; p.ln2_g = (const float*)d_in[6]; p.w_in = (const float*)d_in[7]; p.conv_w = (const float*)d_in[8]; p.conv_b = (const float*)d_in[9];
    p.gate_a_w = (const float*)d_in[10]; p.gate_a_b = (const float*)d_in[11]; p.gate_x_w = (const float*)d_in[12]; p.gate_x_b = (const float*)d_in[13]; p.lru_lambda = (const float*)d_in[14];
    p.lam_q1 = (const float*)d_in[15]; p.lam_k1 = (const float*)d_in[16]; p.lam_q2 = (const float*)d_in[17]; p.lam_k2 = (const float*)d_in[18]; p.subln_g = (const float*)d_in[19];
    p.w_out = (const float*)d_in[20]; p.ffn_wg = (const float*)d_in[21]; p.ffn_wu = (const float*)d_in[22]; p.ffn_wd = (const float*)d_in[23]; p.moe_router = (const float*)d_in[24];
    p.moe_wg = (const float*)d_in[25]; p.moe_wu = (const float*)d_in[26]; p.moe_wd = (const float*)d_in[27]; p.final_g = (const float*)d_in[28];
    p.xr = (float*)d_out; p.ws = (unsigned char*)d_ws; (void)pf;
#if MK_PER_PHASE
    for (int i = 0; i < N_PHASES; ++i) { p.ph_lo = i; p.ph_hi = i + 1; mega_fwd<<<grid, NWAVES * 64, LDS_BYTES, stream>>>(p); }
#else
    p.ph_lo = 0; p.ph_hi = N_PHASES; mega_fwd<<<grid, NWAVES * 64, LDS_BYTES, stream>>>(p);
#endif
}
```

```cpp
#include <hip/hip_runtime.h>
#include <cstdio>
#include <cstdint>

__device__ __forceinline__ int otid() { int t = threadIdx.x; asm volatile("" : "+v"(t)); return t; }
namespace pg8 {
#define PG8_LAS __attribute__((address_space(3)))
typedef unsigned short bf16_t;
typedef short bf16x8 __attribute__((ext_vector_type(8)));
typedef float f32x4 __attribute__((ext_vector_type(4)));
typedef unsigned u32x4 __attribute__((ext_vector_type(4)));
typedef int i32x4 __attribute__((ext_vector_type(4)));
typedef int i32x8 __attribute__((ext_vector_type(8)));
typedef unsigned u32x2 __attribute__((ext_vector_type(2)));
constexpr int BM = 256, BK = 64, HALF = 128, HTB = HALF * BK * 2, STAGE_BYTES = 8 * HTB, NXCD = 8, WGM = 4;

__host__ __device__ __forceinline__ int lds_byte(int r, int c) { const int st = (r >> 4) * 2 + (c >> 5), rr = r & 15, cc = c & 31, ob = rr * 64 + cc * 2; return st * 1024 + (ob ^ (((ob >> 9) & 1) << 5)); }
__host__ __device__ __forceinline__ void stage_rc(int b, int& R, int& C) { const int st = b / 1024, sb = b % 1024, swz = sb ^ (((sb >> 9) & 1) << 5); R = (st >> 1) * 16 + swz / 64; C = (st & 1) * 32 + (swz % 64) / 2; }
__host__ __device__ __forceinline__ int perm32(int rho) { const int n = rho >> 4, i = rho & 15; return 8 * (i >> 2) + 4 * n + (i & 3); }

struct Unit { int pm, pn, pe; };
struct Gemm { const bf16_t* A; const bf16_t* Bt; size_t estride; int M, N, K, pad; };

struct StaticOrder {
    int nM, nN, nwg, G, c;
    __host__ __device__ void init(int M, int N, int G_, int c_) { nM = M / BM; nN = N / BM; nwg = nM * nN; G = G_; c = c_; }
    __host__ __device__ bool next(int i, Unit& u) const { return at((long)i * G + c, u); }
    __host__ __device__ bool at(long L, Unit& u) const {
        if (L >= nwg) return false;
        int wgid = (int)L; { const int q = nwg / NXCD, r = nwg % NXCD, xcd = wgid % NXCD, off = wgid / NXCD; wgid = (xcd < r ? xcd * (q + 1) : r * (q + 1) + (xcd - r) * q) + off; }
        const int nig = WGM * nN, gid = wgid / nig, fm = gid * WGM, gsz = (nM - fm) < WGM ? (nM - fm) : WGM;
        u.pm = fm + ((wgid % nig) % gsz); u.pn = (wgid % nig) / gsz; u.pe = 0; return true;
    }
    __device__ __forceinline__ void a_ready(const Unit&) const {}
    __device__ __forceinline__ void done(const Unit&) const {}
};
struct PanelOrder {
    StaticOrder so; const int* tab;
    __device__ void init(int npanels, int N, int G_, int c_, const int* tab_) { so.init(npanels * BM, N, G_, c_); tab = tab_; }
    __device__ bool next(int i, Unit& u) const { if (!so.next(i, u)) return false; u.pe = tab[u.pm]; return true; }
    __device__ __forceinline__ void a_ready(const Unit&) const {}
    __device__ __forceinline__ void done(const Unit&) const {}
};
struct DownOrder {
    int nN, G, c, lo, hi, main; const int* tab;
    __device__ void init(int npanels, int nN_, int G_, int c_, const int* tab_, int part  ) {
        nN = nN_; G = G_; c = c_; tab = tab_; const int nu = npanels * nN_; main = (nu / G_) * G_;
        lo = (part == 1) ? main : 0; hi = (part == 0) ? main : nu; }
    __device__ bool next(int i, Unit& u) const {
        const long L = (long)lo + (long)i * G + c; if (L >= hi) return false;
        int w = (int)L; if (w < main) w = (w % NXCD) * (main / NXCD) + w / NXCD;
        u.pm = w / nN; u.pn = w % nN; u.pe = tab[u.pm]; return true; }
    __device__ __forceinline__ void a_ready(const Unit&) const {}
    __device__ __forceinline__ void done(const Unit&) const {}
};
struct GuOverlapOrder {
    PanelOrder po; int left, G, c;
    static constexpr int SKIP = 4;
    __device__ void init(int npanels, int N, int G_, int c_, const int* tab_, int left_) { po.init(npanels, N, G_, c_, tab_); left = left_; G = G_; c = c_; }
    __device__ bool next(int i, Unit& u) const {
        long L = (long)((c < left) ? i + SKIP : i) * G + c;
        if (L >= po.so.nwg) { const long k = L - po.so.nwg; if (k >= (long)left * SKIP) return false; L = (k / left) * G + (k % left); }
        if (!po.so.at(L, u)) return false; u.pe = po.tab[u.pm]; return true; }
    __device__ __forceinline__ void a_ready(const Unit&) const {}
    __device__ __forceinline__ void done(const Unit&) const {}
};

typedef float f32x2_t __attribute__((ext_vector_type(2))); typedef __bf16 bf16x2_t __attribute__((ext_vector_type(2)));
__device__ __forceinline__ unsigned cvt_pk_bf16(float lo, float hi) { f32x2_t v = {lo, hi}; bf16x2_t b = __builtin_convertvector(v, bf16x2_t); return __builtin_bit_cast(unsigned, b); }

struct EpiStoreBf16 {
    static constexpr bool PERM = true, AFTER_DRAIN = false, PREFETCH = false;
    bf16_t* O; int ldc; int pad;
    __device__ __forceinline__ void operator()(const f32x4 (&acc)[2][2][4][2], const Unit& u, int wr, int wc, int fr, int fq) const {
        const int row0 = u.pm * BM + wr * 64 + fr; const int col0 = u.pn * BM + wc * 32 + 8 * fq;
#pragma unroll
        for (int ai = 0; ai < 2; ++ai)
#pragma unroll
            for (int m = 0; m < 4; ++m) { bf16_t* rowp = O + (size_t)(row0 + ai * HALF + m * 16) * ldc + col0;
#pragma unroll
                for (int bj = 0; bj < 2; ++bj) { const f32x4 v0 = acc[ai][bj][m][0], v1 = acc[ai][bj][m][1];
                    u32x4 w; w.x = cvt_pk_bf16(v0[0], v0[1]); w.y = cvt_pk_bf16(v0[2], v0[3]); w.z = cvt_pk_bf16(v1[0], v1[1]); w.w = cvt_pk_bf16(v1[2], v1[3]);
                    *(u32x4*)(rowp + bj * HALF) = w; } }
    }
};
__device__ __forceinline__ float silu_f(float x) { return x * __builtin_amdgcn_rcpf(1.0f + __builtin_amdgcn_exp2f(-1.4426950408889634f * x)); }
struct EpiSwiglu {
    static constexpr bool PERM = true, AFTER_DRAIN = false, PREFETCH = false;
    bf16_t* O; int ldc; int pad;
    __device__ __forceinline__ void operator()(const f32x4 (&acc)[2][2][4][2], const Unit& u, int wr, int wc, int fr, int fq) const {
        const int row0 = u.pm * BM + wr * 64 + fr; const int col0 = u.pn * HALF + wc * 32 + 8 * fq;
#pragma unroll
        for (int ai = 0; ai < 2; ++ai)
#pragma unroll
            for (int m = 0; m < 4; ++m) { bf16_t* rowp = O + (size_t)(row0 + ai * HALF + m * 16) * ldc + col0;
                float r[8];
#pragma unroll
                for (int n = 0; n < 2; ++n)
#pragma unroll
                    for (int i = 0; i < 4; ++i) r[n * 4 + i] = silu_f(acc[ai][0][m][n][i]) * acc[ai][1][m][n][i];
                u32x4 w; w.x = cvt_pk_bf16(r[0], r[1]); w.y = cvt_pk_bf16(r[2], r[3]); w.z = cvt_pk_bf16(r[4], r[5]); w.w = cvt_pk_bf16(r[6], r[7]);
                *(u32x4*)rowp = w; }
    }
};
__device__ __forceinline__ float clamp_f8(float v) { return __builtin_amdgcn_fmed3f(v, -448.0f, 448.0f); }
__device__ __forceinline__ unsigned cvt4_fp8(float a, float b, float c, float d) { int w = 0; w = __builtin_amdgcn_cvt_pk_fp8_f32(clamp_f8(a), clamp_f8(b), w, false); w = __builtin_amdgcn_cvt_pk_fp8_f32(clamp_f8(c), clamp_f8(d), w, true); return (unsigned)w; }
constexpr float ACT_F8_SCALE = 4.0f;
struct EpiSwigluF8 {
    static constexpr bool PERM = true, AFTER_DRAIN = false, PREFETCH = false;
    unsigned char* O; int ldc; float inscale;
    __device__ __forceinline__ void operator()(const f32x4 (&acc)[2][2][4][2], const Unit& u, int wr, int wc, int fr, int fq) const {
        const int row0 = u.pm * BM + wr * 64 + fr; const int col0 = u.pn * HALF + wc * 32 + 8 * fq;
        const float kk = 1.0f / (ACT_F8_SCALE * inscale * inscale), c2 = -1.4426950408889634f * inscale, lk = __builtin_log2f(kk);
#pragma unroll
        for (int ai = 0; ai < 2; ++ai)
#pragma unroll
            for (int m = 0; m < 4; ++m) { unsigned char* rowp = O + (unsigned)((row0 + ai * HALF + m * 16) * ldc + col0);
                float r[8];
#pragma unroll
                for (int n = 0; n < 2; ++n)
#pragma unroll
                    for (int i = 0; i < 4; ++i) {
                        const float gg = acc[ai][0][m][n][i], uu = acc[ai][1][m][n][i];
                        const float e = __builtin_amdgcn_exp2f(__builtin_fmaf(gg, c2, lk));
                        r[n * 4 + i] = (gg * uu) * __builtin_amdgcn_rcpf(e + kk); }
                u32x2 w; w.x = cvt4_fp8(r[0], r[1], r[2], r[3]); w.y = cvt4_fp8(r[4], r[5], r[6], r[7]);
                *(u32x2*)rowp = w; }
    }
};
struct EpiSwigluGuard {
    static constexpr bool PERM = true, AFTER_DRAIN = false, PREFETCH = false;
    EpiSwigluF8 base; unsigned* cnt; int guard_pm; int want;
    __device__ __forceinline__ void operator()(const f32x4 (&acc)[2][2][4][2], const Unit& u, int wr, int wc, int fr, int fq) const {
        if (u.pm >= guard_pm && want > 0) { unsigned sp = 0;
            while ((int)__hip_atomic_load(cnt, __ATOMIC_RELAXED, __HIP_MEMORY_SCOPE_AGENT) < want && ++sp < (1u << 22)) __builtin_amdgcn_s_sleep(2); }
        base(acc, u, wr, wc, fr, fq);
    }
};
struct EpiResid {
    static constexpr bool PERM = true, AFTER_DRAIN = false, PREFETCH = false;
    const float* base; float* out; const float* gvec; const float* rowscale; int ldc; int gstride; int rows_per_batch; int rs_stride; float ascale; int pad;
    __device__ __forceinline__ void operator()(const f32x4 (&acc)[2][2][4][2], const Unit& u, int wr, int wc, int fr, int fq) const {
        const int row0 = u.pm * BM + wr * 64 + fr; const int col0 = u.pn * BM + wc * 32 + 8 * fq;
        const float* gv = gvec + (size_t)((u.pm * BM) / rows_per_batch) * gstride + col0;
        f32x4 g[2][2];
#pragma unroll
        for (int bj = 0; bj < 2; ++bj)
#pragma unroll
            for (int n = 0; n < 2; ++n) g[bj][n] = *(const f32x4*)(gv + bj * HALF + 4 * n);
        f32x4 b[8][2][2]; float rs[8];
#define ER_LOAD(ri) do { const int row = row0 + ((ri) >> 2) * HALF + ((ri) & 3) * 16; const size_t off = (size_t)row * ldc + col0; rs[ri] = (rowscale ? rowscale[(size_t)row * rs_stride] : 1.0f) * ascale; \
        _Pragma("unroll") for (int bj = 0; bj < 2; ++bj) _Pragma("unroll") for (int n = 0; n < 2; ++n) b[ri][bj][n] = *(const f32x4*)(base + off + bj * HALF + 4 * n); } while (0)
        ER_LOAD(0); ER_LOAD(1);
#pragma unroll
        for (int ri = 0; ri < 8; ++ri) { if (ri + 2 < 8) ER_LOAD(ri + 2);
            const int row = row0 + (ri >> 2) * HALF + (ri & 3) * 16; const size_t off = (size_t)row * ldc + col0;
#pragma unroll
            for (int bj = 0; bj < 2; ++bj)
#pragma unroll
                for (int n = 0; n < 2; ++n) *(f32x4*)(out + off + bj * HALF + 4 * n) = b[ri][bj][n] + g[bj][n] * rs[ri] * acc[ri >> 2][bj][ri & 3][n]; }
#undef ER_LOAD
    }
};

__device__ __forceinline__ float xlane(float v, int o, int lane) { return __builtin_bit_cast(float, __builtin_amdgcn_ds_bpermute((lane ^ o) << 2, __builtin_bit_cast(int, v))); }
template <bool QF8>
struct EpiResidQ {
    static constexpr bool PERM = true, AFTER_DRAIN = false, PREFETCH = false;
    const float* base; float* out; const float* gvec; const float* lng; const float* scv; void* Q; float* RP; int ldc; int gstride; int rows_per_batch; float ascale;
    __device__ __forceinline__ void operator()(const f32x4 (&acc)[2][2][4][2], const Unit& u, int wr, int wc, int fr, int fq) const {
        const int row0 = u.pm * BM + wr * 64 + fr; const int col0 = u.pn * BM + wc * 32 + 8 * fq; const int lane = fr + 16 * fq;
        const size_t boff = (size_t)((u.pm * BM) / rows_per_batch) * gstride + col0;
        f32x4 g[2][2], gm[2][2];
#pragma unroll
        for (int bj = 0; bj < 2; ++bj)
#pragma unroll
            for (int n = 0; n < 2; ++n) { g[bj][n] = *(const f32x4*)(gvec + boff + bj * HALF + 4 * n) * ascale;
                gm[bj][n] = *(const f32x4*)(lng + col0 + bj * HALF + 4 * n) * (1.0f + *(const f32x4*)(scv + boff + bj * HALF + 4 * n)); }
#pragma unroll
        for (int ai = 0; ai < 2; ++ai)
#pragma unroll
            for (int m = 0; m < 4; ++m) { const int row = row0 + ai * HALF + m * 16; const unsigned off = (unsigned)(row * ldc + col0); float ss = 0.f;
                f32x4 bb[2][2];
#pragma unroll
                for (int bj = 0; bj < 2; ++bj)
#pragma unroll
                    for (int n = 0; n < 2; ++n) bb[bj][n] = *(const f32x4*)(base + off + bj * HALF + 4 * n);
#pragma unroll
                for (int bj = 0; bj < 2; ++bj) { f32x4 v[2];
#pragma unroll
                    for (int n = 0; n < 2; ++n) { const f32x4 b = bb[bj][n]; v[n] = b + g[bj][n] * acc[ai][bj][m][n];
                        *(f32x4*)(out + off + bj * HALF + 4 * n) = v[n]; ss += (v[n][0] * v[n][0] + v[n][1] * v[n][1]) + (v[n][2] * v[n][2] + v[n][3] * v[n][3]); v[n] = v[n] * gm[bj][n]; }
                    if constexpr (QF8) { u32x2 w; w.x = cvt4_fp8(v[0][0], v[0][1], v[0][2], v[0][3]); w.y = cvt4_fp8(v[1][0], v[1][1], v[1][2], v[1][3]); *(u32x2*)((unsigned char*)Q + off + bj * HALF) = w; }
                    else { u32x4 w; w.x = cvt_pk_bf16(v[0][0], v[0][1]); w.y = cvt_pk_bf16(v[0][2], v[0][3]); w.z = cvt_pk_bf16(v[1][0], v[1][1]); w.w = cvt_pk_bf16(v[1][2], v[1][3]); *(u32x4*)((bf16_t*)Q + off + bj * HALF) = w; } }
                ss += xlane(ss, 16, lane); ss += xlane(ss, 32, lane);
                if (fq == 0) ((bf16_t*)RP)[(unsigned)(row * 16 + u.pn * 4 + wc)] = (bf16_t)(cvt_pk_bf16(ss, 0.f) & 0xffffu); }
    }
};
template <class Base>
struct EpiAffine {
    static constexpr bool PERM = true, AFTER_DRAIN = false, PREFETCH = true;
    static constexpr int BUF = 3072;
    Base inner; const float* RP; const float* bias; int bstride; int rows_per_batch; float inv_n; float eps;
    __device__ __forceinline__ void pf_load(u32x4& pr, u32x4& pb, const Unit& n, int tid) const {
        pr = *(const u32x4*)((const bf16_t*)RP + (unsigned)((n.pm * BM + (tid >> 1)) * 16 + (tid & 1) * 8));
        if (tid < 64) pb = *(const u32x4*)(bias + (unsigned)(((n.pm * BM) / rows_per_batch) * bstride + n.pn * BM + 4 * tid));
    }
    __device__ __forceinline__ void pf_store(const u32x4& pr, const u32x4& pb, PG8_LAS unsigned char* buf, int tid) const {
        float sq = 0.f;
#pragma unroll
        for (int i = 0; i < 4; ++i) sq += __uint_as_float(pr[i] << 16) + __uint_as_float(pr[i] & 0xffff0000u);
        ((PG8_LAS float*)buf)[tid] = sq;
        if (tid < 64) *(PG8_LAS u32x4*)(buf + 2048 + 16 * tid) = pb;
    }
    __device__ __forceinline__ void prefetch_first(PG8_LAS unsigned char* spare, const Unit& u, int tid) const {
        if (RP != nullptr) { u32x4 pr, pb = {0u, 0u, 0u, 0u}; pf_load(pr, pb, u, tid); pf_store(pr, pb, spare, tid); asm volatile("s_waitcnt lgkmcnt(0)" ::: "memory"); }
    }
    __device__ __forceinline__ void operator()(f32x4 (&acc)[2][2][4][2], const Unit& u, int wr, int wc, int fr, int fq, PG8_LAS unsigned char* spare, int buf, bool has_next, const Unit& nxt, int tid) const {
        u32x4 pr = {0u, 0u, 0u, 0u}, pb = {0u, 0u, 0u, 0u};
        if (RP != nullptr) {
            const PG8_LAS unsigned char* cb = spare + buf * BUF;
            __builtin_amdgcn_sched_barrier(0);
            float rstd[2][4]; f32x4 bv[2][2];
#pragma unroll
            for (int ai = 0; ai < 2; ++ai)
#pragma unroll
                for (int m = 0; m < 4; ++m) { const f32x2_t p = *(const PG8_LAS f32x2_t*)(cb + (wr * 64 + fr + ai * HALF + m * 16) * 8); rstd[ai][m] = __builtin_amdgcn_rsqf((p.x + p.y) * inv_n + eps); }
#pragma unroll
            for (int bj = 0; bj < 2; ++bj)
#pragma unroll
                for (int n = 0; n < 2; ++n) bv[bj][n] = *(const PG8_LAS f32x4*)(cb + 2048 + (bj * HALF + wc * 32 + 8 * fq + 4 * n) * 4);
            if (has_next) pf_load(pr, pb, nxt, tid);
#pragma unroll
            for (int bj = 0; bj < 2; ++bj)
#pragma unroll
                for (int n = 0; n < 2; ++n)
#pragma unroll
                    for (int ai = 0; ai < 2; ++ai)
#pragma unroll
                        for (int m = 0; m < 4; ++m) acc[ai][bj][m][n] = acc[ai][bj][m][n] * rstd[ai][m] + bv[bj][n];
            __builtin_amdgcn_sched_barrier(0); }
        inner(acc, u, wr, wc, fr, fq);
        if (RP != nullptr && has_next) { __builtin_amdgcn_sched_barrier(0); pf_store(pr, pb, spare + (buf ^ 1) * BUF, tid); }
    }
};

struct EpiScatter {
    static constexpr bool PERM = true, AFTER_DRAIN = false, PREFETCH = false;
    float* out; const float* gvec; const int* slot_tok; const float* slot_w; int ldc; int gstride; int rows_per_batch; float wscale;
    __device__ __forceinline__ void operator()(const f32x4 (&acc)[2][2][4][2], const Unit& u, int wr, int wc, int fr, int fq) const {
        const int row0 = u.pm * BM + wr * 64 + fr; const int col0 = u.pn * BM + wc * 32 + 8 * fq;
        int tok[2][4]; float w[2][4];
#pragma unroll
        for (int ai = 0; ai < 2; ++ai)
#pragma unroll
            for (int m = 0; m < 4; ++m) { const int slot = row0 + ai * HALF + m * 16; tok[ai][m] = slot_tok[slot]; w[ai][m] = slot_w[slot] * wscale; }
        f32x4 g[8][2][2], b[8][2][2];
#define ES_LOAD(ri) do { const int t_ = tok[(ri) >> 2][(ri) & 3] < 0 ? 0 : tok[(ri) >> 2][(ri) & 3]; const float* gv = gvec + (size_t)(t_ / rows_per_batch) * gstride + col0; const float* xo = out + (size_t)t_ * ldc + col0; \
        _Pragma("unroll") for (int bj = 0; bj < 2; ++bj) _Pragma("unroll") for (int n = 0; n < 2; ++n) { g[ri][bj][n] = *(const f32x4*)(gv + bj * HALF + 4 * n); b[ri][bj][n] = *(const f32x4*)(xo + bj * HALF + 4 * n); } } while (0)
        ES_LOAD(0);
#pragma unroll
        for (int ri = 0; ri < 8; ++ri) { if (ri + 1 < 8) ES_LOAD(ri + 1);
            const int t = tok[ri >> 2][ri & 3];
            if (t >= 0) { const float ww = w[ri >> 2][ri & 3]; float* xo = out + (size_t)t * ldc + col0;
#pragma unroll
                for (int bj = 0; bj < 2; ++bj)
#pragma unroll
                    for (int n = 0; n < 2; ++n) *(f32x4*)(xo + bj * HALF + 4 * n) = b[ri][bj][n] + g[ri][bj][n] * ww * acc[ri >> 2][bj][ri & 3][n]; } }
#undef ES_LOAD
    }
};

struct EpiG1 {
    static constexpr bool PERM = true, AFTER_DRAIN = false, PREFETCH = false;
    bf16_t* O; bf16_t* KT; bf16_t* VT; const float* tbl  ; int ldc; int seq;
    __device__ __forceinline__ void operator()(const f32x4 (&acc)[2][2][4][2], const Unit& u, int wr, int wc, int fr, int fq) const {
        const int row0 = u.pm * BM + wr * 64 + fr;
        if (u.pn >= 4 && u.pn < 8) {
            const bool isq = u.pn < 6;
            const float sc = isq ? 0.125f * 1.4426950408889634f : 1.0f;
#pragma unroll
            for (int ai = 0; ai < 2; ++ai)
#pragma unroll
                for (int m = 0; m < 4; ++m) { const int row = row0 + ai * HALF + m * 16;
                    const f32x4* tp = (const f32x4*)(tbl + (size_t)row * 64 + 16 * fq);
                    float o1[8], o2[8];
#pragma unroll
                    for (int n = 0; n < 2; ++n) { const f32x4 ta = tp[2 * n], tb = tp[2 * n + 1]; const f32x4 x1 = acc[ai][0][m][n], x2 = acc[ai][1][m][n];
                        o1[4 * n + 0] = (x1[0] * ta[0] - x2[0] * ta[1]) * sc; o2[4 * n + 0] = (x2[0] * ta[0] + x1[0] * ta[1]) * sc;
                        o1[4 * n + 1] = (x1[1] * ta[2] - x2[1] * ta[3]) * sc; o2[4 * n + 1] = (x2[1] * ta[2] + x1[1] * ta[3]) * sc;
                        o1[4 * n + 2] = (x1[2] * tb[0] - x2[2] * tb[1]) * sc; o2[4 * n + 2] = (x2[2] * tb[0] + x1[2] * tb[1]) * sc;
                        o1[4 * n + 3] = (x1[3] * tb[2] - x2[3] * tb[3]) * sc; o2[4 * n + 3] = (x2[3] * tb[2] + x1[3] * tb[3]) * sc; }
                    u32x4 w1, w2;
                    w1.x = cvt_pk_bf16(o1[0], o1[1]); w1.y = cvt_pk_bf16(o1[2], o1[3]); w1.z = cvt_pk_bf16(o1[4], o1[5]); w1.w = cvt_pk_bf16(o1[6], o1[7]);
                    w2.x = cvt_pk_bf16(o2[0], o2[1]); w2.y = cvt_pk_bf16(o2[2], o2[3]); w2.z = cvt_pk_bf16(o2[4], o2[5]); w2.w = cvt_pk_bf16(o2[6], o2[7]);
                    if (isq) { bf16_t* rowp = O + (size_t)row * ldc + u.pn * BM + 64 * wc + 8 * fq; *(u32x4*)rowp = w1; *(u32x4*)(rowp + 32) = w2; }
                    else { const int b = row / seq, s = row - b * seq, sub = (u.pn - 6) * 4 + wc;
                        bf16_t* kp = KT + ((size_t)(b * 8 + sub) * seq + (size_t)(s & ~63)) * 64 + (s & 63) * 8;
                        *(u32x4*)(kp + fq * 512) = w1; *(u32x4*)(kp + (4 + fq) * 512) = w2; } }
        } else if (u.pn >= 8) {
#pragma unroll
            for (int ai = 0; ai < 2; ++ai)
#pragma unroll
                for (int m = 0; m < 4; ++m) { const int row = row0 + ai * HALF + m * 16; const int b = row / seq, s = row - b * seq;
#pragma unroll
                    for (int bj = 0; bj < 2; ++bj) { const int h = (u.pn - 8) * 2 + bj; const f32x4 v0 = acc[ai][bj][m][0], v1 = acc[ai][bj][m][1];
                        u32x4 w; w.x = cvt_pk_bf16(v0[0], v0[1]); w.y = cvt_pk_bf16(v0[2], v0[3]); w.z = cvt_pk_bf16(v1[0], v1[1]); w.w = cvt_pk_bf16(v1[2], v1[3]);
                        bf16_t* vp = VT + ((size_t)(b * 4 + h) * seq + (size_t)(s & ~63)) * 128 + wc * 2048 + ((s & 63) >> 4) * 512 + (s & 15) * 32 + 8 * fq;
                        *(u32x4*)vp = w; } }
        } else {
            const int col0 = u.pn * BM + wc * 32 + 8 * fq;
#pragma unroll
            for (int ai = 0; ai < 2; ++ai)
#pragma unroll
                for (int m = 0; m < 4; ++m) { bf16_t* rowp = O + (size_t)(row0 + ai * HALF + m * 16) * ldc + col0;
#pragma unroll
                    for (int bj = 0; bj < 2; ++bj) { const f32x4 v0 = acc[ai][bj][m][0], v1 = acc[ai][bj][m][1];
                        u32x4 w; w.x = cvt_pk_bf16(v0[0], v0[1]); w.y = cvt_pk_bf16(v0[2], v0[3]); w.z = cvt_pk_bf16(v1[0], v1[1]); w.w = cvt_pk_bf16(v1[2], v1[3]);
                        *(u32x4*)(rowp + bj * HALF) = w; } }
        }
    }
};

__device__ __forceinline__ const char* uni_ptr(const char* p) {
    const unsigned long long v = (unsigned long long)p; const unsigned lo = (unsigned)__builtin_amdgcn_readfirstlane((int)(unsigned)v), hi = (unsigned)__builtin_amdgcn_readfirstlane((int)(unsigned)(v >> 32));
    return (const char*)(((unsigned long long)hi << 32) | lo); }
template <class Epi, class Sched, bool ALIGN_EPI = false, bool SP2 = false, bool F8 = false>
__device__ __forceinline__ void gemm_phase(PG8_LAS unsigned char* lds, const Gemm g, const Sched& S, const Epi& E) {
    const int tid = otid(), wid = __builtin_amdgcn_readfirstlane(tid >> 6), lane = tid & 63, wr = wid >> 2, wc = wid & 3, fr = lane & 15, fq = lane >> 4;
    const int K = g.K, nt = K / BK;
    unsigned voffA[2], voffB[2];
#pragma unroll
    for (int i = 0; i < 2; ++i) { int R, C; stage_rc(wid * 2048 + i * 1024 + lane * 16, R, C); const int Rb = Epi::PERM ? ((R & ~31) + perm32(R & 31)) : R;
        voffA[i] = (unsigned)(R * K + C) * 2u + (i == 0 ? 1024u : 0u); voffB[i] = (unsigned)(Rb * K + C) * 2u + (i == 0 ? 1024u : 0u); }
    const size_t kstep = (size_t)(BK * 2);
    const size_t hstep = (size_t)HALF * K * 2;
    const size_t tstep = 2 * hstep;
    const unsigned ldsw = (unsigned)wid * 2048u;
    const int aoff = lds_byte(wr * 64 + fr, fq * 8), boff = lds_byte(wc * 32 + fr, fq * 8);
#define PG8_SA(b, h) (((b) * 2 + (h)) * HTB)
#define PG8_SB(b, h) ((4 + (b) * 2 + (h)) * HTB)
    const unsigned ldsb = (unsigned)__builtin_amdgcn_readfirstlane((int)((unsigned)(size_t)lds + ldsw));
#define PG8_STAGE(bufoff, gbase, voff) asm volatile("s_mov_b32 m0, %3\n\ts_nop 0\n\tglobal_load_lds_dwordx4 %0, %2\n\tglobal_load_lds_dwordx4 %1, %2 offset:1024" \
        :: "v"((voff)[0]), "v"((voff)[1]), "s"((const char*)(gbase) - 1024), "s"(ldsb + (unsigned)(bufoff)) : "memory")
#define PG8_LDA(dst, b, h) do { _Pragma("unroll") for (int m = 0; m < 4; ++m) _Pragma("unroll") for (int k = 0; k < 2; ++k) dst[m][k] = *(const PG8_LAS bf16x8*)(lds + PG8_SA(b, h) + aoff + m * 2048 + k * 1024); } while (0)
#define PG8_LDB(dst, b, h) do { _Pragma("unroll") for (int n = 0; n < 2; ++n) _Pragma("unroll") for (int k = 0; k < 2; ++k) dst[n][k] = *(const PG8_LAS bf16x8*)(lds + PG8_SB(b, h) + boff + n * 2048 + k * 1024); } while (0)
#define PG8_CAT(lo, hi) __builtin_shufflevector(__builtin_bit_cast(i32x4, lo), __builtin_bit_cast(i32x4, hi), 0, 1, 2, 3, 4, 5, 6, 7)
#define PG8_MMA(ai, bj, At, Bt) do { __builtin_amdgcn_s_setprio(1); _Pragma("unroll") for (int m = 0; m < 4; ++m) _Pragma("unroll") for (int n = 0; n < 2; ++n) { \
        if constexpr (F8) asm volatile("v_mfma_f32_16x16x128_f8f6f4 %0, %1, %2, %0" : "+v"(acc[ai][bj][m][n]) : "v"(PG8_CAT(Bt[n][0], Bt[n][1])), "v"(PG8_CAT(At[m][0], At[m][1])));   \
        else { _Pragma("unroll") for (int k = 0; k < 2; ++k) acc[ai][bj][m][n] = __builtin_amdgcn_mfma_f32_16x16x32_bf16(Bt[n][k], At[m][k], acc[ai][bj][m][n], 0, 0, 0); } } __builtin_amdgcn_s_setprio(0); } while (0)
#define PG8_MMA_CORE(ai, bj, At, Bt) do { _Pragma("unroll") for (int m = 0; m < 4; ++m) _Pragma("unroll") for (int n = 0; n < 2; ++n) { \
        if constexpr (F8) asm volatile("v_mfma_f32_16x16x128_f8f6f4 %0, %1, %2, %0" : "+v"(acc[ai][bj][m][n]) : "v"(PG8_CAT(Bt[n][0], Bt[n][1])), "v"(PG8_CAT(At[m][0], At[m][1]))); \
        else { _Pragma("unroll") for (int k = 0; k < 2; ++k) acc[ai][bj][m][n] = __builtin_amdgcn_mfma_f32_16x16x32_bf16(Bt[n][k], At[m][k], acc[ai][bj][m][n], 0, 0, 0); } } } while (0)
#define PG8_MMA2(ai, At, Bx, By) do { __builtin_amdgcn_s_setprio(1); PG8_MMA_CORE(ai, 0, At, Bx); PG8_MMA_CORE(ai, 1, At, By); __builtin_amdgcn_s_setprio(0); } while (0)
#define PG8_WAIT_V(n) asm volatile("s_waitcnt vmcnt(" #n ")" ::: "memory")
#define PG8_WAIT_L(n) do { if ((n) == 0) __builtin_amdgcn_s_waitcnt(0xC07F); else asm volatile("s_waitcnt lgkmcnt(" #n ")" ::: "memory"); } while (0)
#define PG8_BAR __builtin_amdgcn_s_barrier()
#define PG8_SCHED __builtin_amdgcn_sched_barrier(0)
    Unit cur, nxt; int ui = 0;
    if (!S.next(0, cur)) return;
    f32x4 acc[2][2][4][2];
#pragma unroll
    for (int a = 0; a < 2; ++a)
#pragma unroll
        for (int b = 0; b < 2; ++b)
#pragma unroll
            for (int m = 0; m < 4; ++m)
#pragma unroll
                for (int n = 0; n < 2; ++n) acc[a][b][m][n] = (f32x4){0.f, 0.f, 0.f, 0.f};
    bf16x8 At[4][2], B0[2][2], B1[2][2];
    const char* cA = uni_ptr((const char*)g.A + (size_t)cur.pm * tstep); const char* cB = uni_ptr((const char*)g.Bt + (size_t)cur.pe * g.estride + (size_t)cur.pn * tstep);
    S.a_ready(cur);
    if constexpr (Epi::PREFETCH) E.prefetch_first(lds + STAGE_BYTES, cur, tid);
    if constexpr (SP2) {
        PG8_STAGE(PG8_SB(0, 0), cB, voffB); PG8_STAGE(PG8_SB(0, 1), cB + hstep, voffB); PG8_STAGE(PG8_SA(0, 0), cA, voffA); PG8_STAGE(PG8_SA(0, 1), cA + hstep, voffA);
        if (wr == 1) PG8_BAR;
        PG8_WAIT_V(2); PG8_BAR;
        PG8_STAGE(PG8_SB(1, 0), cB + kstep, voffB); PG8_STAGE(PG8_SA(1, 0), cA + kstep, voffA); PG8_STAGE(PG8_SB(1, 1), cB + hstep + kstep, voffB);
        PG8_WAIT_V(6); PG8_BAR;
    } else {
        PG8_STAGE(PG8_SB(0, 0), cB, voffB); PG8_STAGE(PG8_SA(0, 0), cA, voffA); PG8_STAGE(PG8_SB(0, 1), cB + hstep, voffB); PG8_STAGE(PG8_SA(0, 1), cA + hstep, voffA);
        if (wr == 1) PG8_BAR;
        PG8_WAIT_V(4); PG8_BAR;
        PG8_STAGE(PG8_SB(1, 0), cB + kstep, voffB); PG8_STAGE(PG8_SA(1, 0), cA + kstep, voffA); PG8_STAGE(PG8_SB(1, 1), cB + hstep + kstep, voffB);
        PG8_WAIT_V(6); PG8_BAR;
    }
    for (;;) {
        const bool has_next = S.next(ui + 1, nxt);
        const char* nA = uni_ptr(has_next ? (const char*)g.A + (size_t)nxt.pm * tstep : cA); const char* nB = uni_ptr(has_next ? (const char*)g.Bt + (size_t)nxt.pe * g.estride + (size_t)nxt.pn * tstep : cB);
#pragma unroll 1
        for (int t = 0; t < nt; t += 2) {
            const bool last = (t == nt - 2);
            const char* a1 = cA + (size_t)(t + 1) * kstep;
            const char* a2 = last ? nA : cA + (size_t)(t + 2) * kstep; const char* b2 = last ? nB : cB + (size_t)(t + 2) * kstep;
            const char* a3 = a2 + kstep; const char* b3 = b2 + kstep;
            if (last && has_next) S.a_ready(nxt);
            if constexpr (SP2) {
            PG8_LDB(B0, 0, 0); PG8_LDB(B1, 0, 1); PG8_SCHED; PG8_LDA(At, 0, 0); PG8_STAGE(PG8_SA(1, 1), a1 + hstep, voffA);
            PG8_WAIT_V(8); PG8_WAIT_L(0); PG8_BAR; PG8_MMA2(0, At, B0, B1); PG8_BAR; PG8_SCHED;
            PG8_LDA(At, 0, 1); PG8_STAGE(PG8_SB(0, 0), b2, voffB); PG8_STAGE(PG8_SB(0, 1), b2 + hstep, voffB); PG8_STAGE(PG8_SA(0, 0), a2, voffA);
            PG8_WAIT_V(8); PG8_WAIT_L(0); PG8_BAR; PG8_MMA2(1, At, B0, B1); PG8_BAR; PG8_SCHED;
            PG8_LDB(B0, 1, 0); PG8_LDB(B1, 1, 1); PG8_SCHED; PG8_LDA(At, 1, 0); PG8_STAGE(PG8_SA(0, 1), a2 + hstep, voffA);
            PG8_WAIT_V(8); PG8_WAIT_L(0); PG8_BAR; PG8_MMA2(0, At, B0, B1); PG8_BAR; PG8_SCHED;
            PG8_LDA(At, 1, 1); PG8_STAGE(PG8_SB(1, 0), b3, voffB); PG8_STAGE(PG8_SB(1, 1), b3 + hstep, voffB); PG8_STAGE(PG8_SA(1, 0), a3, voffA);
            PG8_WAIT_V(8); PG8_WAIT_L(0); PG8_BAR; PG8_MMA2(1, At, B0, B1); PG8_BAR; PG8_SCHED;
            } else {
            PG8_LDB(B0, 0, 0); PG8_SCHED; PG8_LDA(At, 0, 0); PG8_STAGE(PG8_SA(1, 1), a1 + hstep, voffA);
            PG8_WAIT_L(8); PG8_BAR; PG8_WAIT_L(0); PG8_MMA(0, 0, At, B0); PG8_BAR; PG8_SCHED;
            PG8_LDB(B1, 0, 1); PG8_STAGE(PG8_SB(0, 0), b2, voffB);
            PG8_BAR; PG8_WAIT_L(0); PG8_MMA(0, 1, At, B1); PG8_BAR;
            PG8_LDA(At, 0, 1); PG8_STAGE(PG8_SA(0, 0), a2, voffA);
            PG8_BAR; PG8_WAIT_L(0); PG8_MMA(1, 0, At, B0); PG8_BAR; PG8_SCHED;
            PG8_STAGE(PG8_SB(0, 1), b2 + hstep, voffB);
            PG8_WAIT_V(6); PG8_BAR; PG8_MMA(1, 1, At, B1); PG8_BAR;
            PG8_LDB(B0, 1, 0); PG8_SCHED; PG8_LDA(At, 1, 0); PG8_STAGE(PG8_SA(0, 1), a2 + hstep, voffA);
            PG8_WAIT_L(8); PG8_BAR; PG8_WAIT_L(0); PG8_MMA(0, 0, At, B0); PG8_BAR; PG8_SCHED;
            PG8_LDB(B1, 1, 1); PG8_STAGE(PG8_SB(1, 0), b3, voffB);
            PG8_BAR; PG8_WAIT_L(0); PG8_MMA(0, 1, At, B1); PG8_BAR;
            PG8_LDA(At, 1, 1); PG8_STAGE(PG8_SA(1, 0), a3, voffA);
            PG8_BAR; PG8_WAIT_L(0); PG8_MMA(1, 0, At, B0); PG8_BAR; PG8_SCHED;
            PG8_STAGE(PG8_SB(1, 1), b3 + hstep, voffB);
            PG8_WAIT_V(6); PG8_BAR; PG8_MMA(1, 1, At, B1); PG8_BAR;
            }
        }
        if constexpr (ALIGN_EPI) { if (wr == 0) PG8_BAR; }
        if constexpr (F8) { PG8_SCHED; asm volatile("s_nop 15\n\ts_nop 7" ::: "memory"); PG8_SCHED; }
        if constexpr (!Epi::AFTER_DRAIN) { if constexpr (Epi::PREFETCH) E(acc, cur, wr, wc, fr, fq, lds + STAGE_BYTES, ui & 1, has_next, nxt, tid); else E(acc, cur, wr, wc, fr, fq); S.done(cur); }
        if (!has_next) break;
#pragma unroll
        for (int a = 0; a < 2; ++a)
#pragma unroll
            for (int b = 0; b < 2; ++b)
#pragma unroll
                for (int m = 0; m < 4; ++m)
#pragma unroll
                    for (int n = 0; n < 2; ++n) acc[a][b][m][n] = (f32x4){0.f, 0.f, 0.f, 0.f};
        cur = nxt; cA = nA; cB = nB; ++ui;
        if constexpr (ALIGN_EPI) { if (wr == 1) PG8_BAR; }
    }
    PG8_WAIT_V(0);
    if constexpr (!ALIGN_EPI) { if (wr == 0) PG8_BAR; }
    PG8_BAR;
#undef PG8_SA
#undef PG8_SB
#undef PG8_STAGE
#undef PG8_LDA
#undef PG8_LDB
#undef PG8_MMA
#undef PG8_MMA2
#undef PG8_MMA_CORE
#undef PG8_CAT
#undef PG8_WAIT_V
#undef PG8_WAIT_L
#undef PG8_BAR
#undef PG8_SCHED
}
}

typedef unsigned short bf16;
#define GAS __attribute__((address_space(1)))
#define LAS __attribute__((address_space(3)))
typedef unsigned v4u __attribute__((ext_vector_type(4)));
typedef float f32x4 __attribute__((ext_vector_type(4)));
typedef unsigned u32x4_t __attribute__((ext_vector_type(4)));

constexpr int DM = 1024, NB = 4, SEQ = 8192, MROWS = NB * SEQ, DEPTH = 2;
constexpr int LRU_W = 512, DIN = 2560, DFF = 3072, NEXP = 8, NMOD = 6 * DM;
constexpr int ZC_XR = 0, ZC_YR = 512, ZC_Q = 1024, ZC_K = 1536, ZC_V = 2048;
constexpr int ZP = 1536;
constexpr float EPS = 1e-6f;
constexpr int NWAVES = 8;
constexpr int GEMM_LDS = 131072;

constexpr size_t MiB = 1u << 20;
constexpr size_t WS_CTL = 0;
constexpr size_t WS_WIN = 2 * MiB;
constexpr size_t WS_WOUT = 12 * MiB;
constexpr size_t WS_WGU = 16 * MiB;
constexpr size_t WS_WD = 28 * MiB;
constexpr size_t WS_MGU = 34 * MiB;
constexpr size_t WS_MD = 130 * MiB;
constexpr size_t WS_MOD = 178 * MiB;
constexpr size_t WS_ROPE = 180 * MiB;
constexpr size_t WS_AGG = 188 * MiB;
constexpr size_t WS_RP = 190 * MiB;
constexpr size_t WS_GF = 191 * MiB;
constexpr size_t WS_BIAS = WS_MOD + 512 * 1024;
constexpr size_t WS_MOE = 179 * MiB;
constexpr size_t WS_HG = 181 * MiB;
constexpr size_t WS_HG1 = 453 * MiB;
constexpr size_t WS_ACTM = 249 * MiB;
constexpr size_t WS_HB = 192 * MiB;
constexpr size_t WS_ZB = 256 * MiB;
constexpr size_t WS_KT = 352 * MiB;
constexpr size_t WS_VT = 384 * MiB;
constexpr size_t WS_MIX = 416 * MiB;
constexpr size_t WS_ACT = 256 * MiB;
constexpr size_t WS_O0S = 480 * MiB;
constexpr size_t WS_END = 521 * MiB;
static_assert(WS_ACTM + (size_t)34816 * 3072 * 2 <= WS_HG1 && WS_HG1 + (size_t)34816 * 1024 * 2 <= WS_END && WS_HG + (size_t)34816 * 1024 * 2 <= WS_ACTM && WS_MOE + 0x110000 + 16384 + 65536 <= WS_HG && WS_MOD + 2 * 4 * 6144 * 4 <= WS_MOE, "MoE workspace map");

__device__ __forceinline__ float bf2f(bf16 v) { return __uint_as_float((unsigned)v << 16); }
__device__ __forceinline__ bf16 f2bf(float f) { return (bf16)(pg8::cvt_pk_bf16(f, 0.f) & 0xffffu); }
__device__ __forceinline__ float shx(float v, int o, int lane) { return __builtin_bit_cast(float, __builtin_amdgcn_ds_bpermute((lane ^ o) << 2, __builtin_bit_cast(int, v))); }
__device__ __forceinline__ float wave_sum(float v, int lane) {
#pragma unroll
    for (int o = 1; o < 64; o <<= 1) v += shx(v, o, lane);
    return v;
}
__device__ __forceinline__ float gelu_tanh(float y) { const float u = 0.7978845608028654f * (y + 0.044715f * y * y * y); const float t = 1.0f - 2.0f / (1.0f + __expf(2.0f * u)); return 0.5f * y * (1.0f + t); }

constexpr float W_F8_SCALE = 64.0f;
template <bool F8 = false>
__device__ __forceinline__ void transpose_item(const float* W, int K, int N, bf16* WT, int dest_row0, LAS float* scr, int k0, int n0, int lane) {
    float tv[32];
#pragma unroll
    for (int i = 0; i < 32; ++i) { const int kk = 2 * i + (lane >> 5); tv[i] = __builtin_nontemporal_load(W + (size_t)(k0 + kk) * N + n0 + (lane & 31)); }
#pragma unroll
    for (int i = 0; i < 32; ++i) { const int kk = 2 * i + (lane >> 5); scr[kk * 33 + (lane & 31)] = tv[i]; }
    asm volatile("s_waitcnt lgkmcnt(0)" ::: "memory");
    const int c = lane & 7;
#pragma unroll
    for (int j = 0; j < 4; ++j) { const int n = (lane >> 3) + 8 * j; const LAS float* s = scr + (8 * c) * 33 + n;
        if constexpr (F8) { pg8::u32x2 o; o.x = pg8::cvt4_fp8(s[0 * 33] * W_F8_SCALE, s[1 * 33] * W_F8_SCALE, s[2 * 33] * W_F8_SCALE, s[3 * 33] * W_F8_SCALE); o.y = pg8::cvt4_fp8(s[4 * 33] * W_F8_SCALE, s[5 * 33] * W_F8_SCALE, s[6 * 33] * W_F8_SCALE, s[7 * 33] * W_F8_SCALE);
            *(GAS pg8::u32x2*)((unsigned char*)WT + (size_t)(dest_row0 + n) * K + k0 + 8 * c) = o; }
        else { v4u o; o.x = pg8::cvt_pk_bf16(s[0 * 33], s[1 * 33]); o.y = pg8::cvt_pk_bf16(s[2 * 33], s[3 * 33]); o.z = pg8::cvt_pk_bf16(s[4 * 33], s[5 * 33]); o.w = pg8::cvt_pk_bf16(s[6 * 33], s[7 * 33]);
            *(GAS v4u*)(WT + (size_t)(dest_row0 + n) * K + k0 + 8 * c) = o; } }
    asm volatile("s_waitcnt lgkmcnt(0)" ::: "memory");
}
__constant__ float c_inv[32] = {1.000000000e+00f, 7.498942018e-01f, 5.623413324e-01f, 4.216965139e-01f, 3.162277639e-01f, 2.371373773e-01f, 1.778279394e-01f, 1.333521456e-01f, 1.000000015e-01f, 7.498942316e-02f, 5.623413250e-02f, 4.216964915e-02f, 3.162277490e-02f, 2.371373773e-02f, 1.778279431e-02f, 1.333521400e-02f, 9.999999776e-03f, 7.498942316e-03f, 5.623413250e-03f, 4.216964822e-03f, 3.162277630e-03f, 2.371373819e-03f, 1.778279431e-03f, 1.333521446e-03f, 1.000000047e-03f, 7.498941850e-04f, 5.623413017e-04f, 4.216965172e-04f, 3.162277571e-04f, 2.371373703e-04f, 1.778279402e-04f, 1.333521504e-04f};
__device__ __forceinline__ void sincos_acc(float angf, float& cs, float& sn) {
    const double x = (double)angf;
    const double k = rint(x * 0.63661977236758134308);
    const double r = fma(-k, 6.123233995736766036e-17, fma(-k, 1.57079632679489655800, x));
    const double r2 = r * r;
    double s = -7.6471637318198164759e-13; s = fma(s, r2, 1.6059043836821614599e-10); s = fma(s, r2, -2.5052108385441718775e-08); s = fma(s, r2, 2.7557319223985890653e-06);
    s = fma(s, r2, -1.9841269841269841270e-04); s = fma(s, r2, 8.3333333333333333333e-03); s = fma(s, r2, -1.6666666666666666667e-01); s = fma(s * r2, r, r);
    double c = 4.7794773323873852974e-14; c = fma(c, r2, -1.1470745597729724714e-11); c = fma(c, r2, 2.0876756987868098979e-09); c = fma(c, r2, -2.7557319223985890653e-07);
    c = fma(c, r2, 2.4801587301587301587e-05); c = fma(c, r2, -1.3888888888888888889e-03); c = fma(c, r2, 4.1666666666666666667e-02); c = fma(c, r2, -0.5); c = fma(c, r2, 1.0);
    const int q = ((int)(long long)k) & 3;
    const double sv = (q == 0) ? s : (q == 1) ? c : (q == 2) ? -s : -c;
    const double cv = (q == 0) ? c : (q == 1) ? -s : (q == 2) ? -c : s;
    cs = (float)cv; sn = (float)sv;
}
namespace att {
typedef short bf16x8 __attribute__((ext_vector_type(8)));
typedef short s16x4 __attribute__((ext_vector_type(4)));
typedef float f32x16 __attribute__((ext_vector_type(16)));
typedef LAS const unsigned char* lds_cptr;
constexpr int KSLOT = 8192, VSLOT = 16384, NSLOT = 3;
constexpr int L_K = 0, L_V = 4 * KSLOT, L_WS = L_V + 3 * VSLOT, L_Q = L_WS + NWAVES * 256, L_END = L_Q + NWAVES * 4096;
constexpr float C2 = 0.125f * 1.4426950408889634f;
constexpr float THR = 8.0f;
__device__ __forceinline__ int crow(int r, int hi) { return (r & 3) + 8 * (r >> 2) + 4 * hi; }
__device__ __forceinline__ void glds16(const void* gsrc, unsigned lds_dst) { unsigned keep;
    asm volatile("s_mov_b32 %0, m0\n\ts_mov_b32 m0, %2\n\ts_nop 0\n\tglobal_load_lds_dwordx4 %1, off\n\ts_mov_b32 m0, %0" : "=&s"(keep) : "v"(gsrc), "s"(lds_dst) : "memory"); }
#define ATT_WAIT_BAR(N) asm volatile("s_waitcnt vmcnt(" #N ")\n\ts_barrier" ::: "memory")
__device__ __forceinline__ float max3f(float a, float b, float c) { float r; asm("v_max3_f32 %0, %1, %2, %3" : "=v"(r) : "v"(a), "v"(b), "v"(c)); return r; }
__device__ __forceinline__ float merge_max32(float m) { auto rr = __builtin_amdgcn_permlane32_swap(__float_as_uint(m), __float_as_uint(m), false, false); return fmaxf(__uint_as_float(rr[0]), __uint_as_float(rr[1])); }
__device__ __forceinline__ float merge_sum32(float m) { auto rr = __builtin_amdgcn_permlane32_swap(__float_as_uint(m), __float_as_uint(m), false, false); return __uint_as_float(rr[0]) + __uint_as_float(rr[1]); }
__device__ __forceinline__ s16x4 vtr(lds_cptr p) { typedef short v4i16_t __attribute__((ext_vector_type(4))); return __builtin_bit_cast(s16x4, __builtin_amdgcn_ds_read_tr16_b64_v4i16((LAS v4i16_t*)p)); }

#define SBAR() __builtin_amdgcn_sched_barrier(0)
#define ATT_WB(N) asm volatile("s_waitcnt vmcnt(" #N ") lgkmcnt(0)\n\ts_barrier" ::: "memory")
__device__ __forceinline__ void attn_pass(f32x16 (&o)[4], const bf16* Qblk  , const bf16* Kh, const bf16* Vh, LAS unsigned char* shm, int NT, int tmax, int wid, int lane_in) {
    int lane = lane_in; asm volatile("" : "+v"(lane));
    const int r32 = lane & 31, hi = lane >> 5;
    const bf16* Qw = Qblk + (size_t)r32 * ZP;
    const unsigned lds0 = (unsigned)(size_t)shm;
    LAS float* wsf = (LAS float*)(shm + L_WS) + wid * 64;
    const char* ksb = pg8::uni_ptr((const char*)Kh); const char* vsb = pg8::uni_ptr((const char*)Vh);
    const unsigned dmao = (unsigned)(wid * 1024 + lane * 16);
    const unsigned dmav = (unsigned)(wid * 2048 + lane * 16);
    const unsigned kdst = (unsigned)__builtin_amdgcn_readfirstlane((int)(lds0 + L_K + wid * 1024)), vdst = (unsigned)__builtin_amdgcn_readfirstlane((int)(lds0 + L_V + wid * 2048));
#define GLDS_S(sbase, ldsa) asm volatile("s_mov_b32 m0, %2\n\ts_nop 0\n\tglobal_load_lds_dwordx4 %0, %1" :: "v"(dmao), "s"(sbase), "s"(ldsa) : "memory")
#define DMA_K(t) GLDS_S(ksb + (size_t)(t) * 8192, kdst + (unsigned)(((t) & 3) * KSLOT))
#define DMA_V(t, slot) asm volatile("s_mov_b32 m0, %2\n\ts_nop 0\n\tglobal_load_lds_dwordx4 %0, %1\n\tglobal_load_lds_dwordx4 %0, %1 offset:1024" :: "v"(dmav), "s"(vsb + (size_t)(t) * 16384), "s"(vdst + (unsigned)((slot) * VSLOT)) : "memory")
    bf16x8 kf[8];
    const lds_cptr kp0 = (lds_cptr)shm + L_K + hi * 1024 + r32 * 16;
    const lds_cptr vp0 = (lds_cptr)shm + L_V + ((lane >> 4) & 1) * 32 + (lane & 3) * 8 + (4 * hi + ((lane & 15) >> 2)) * 64;
#define KFRAG(t, j) (*(const LAS bf16x8*)(kp0 + ((t) & 3) * KSLOT + ((j) >> 1) * 2048 + ((j) & 1) * 512))
    DMA_K(0); DMA_V(0, 0); DMA_K(1);
    const lds_cptr qp0 = (lds_cptr)shm + L_Q + wid * 4096 + hi * 512 + r32 * 16;
    { bf16x8 qt[4];
#pragma unroll
      for (int d0 = 0; d0 < 4; ++d0) qt[d0] = *(const bf16x8*)(Qw + d0 * 16 + hi * 8);
#pragma unroll
      for (int d0 = 0; d0 < 4; ++d0) *(LAS bf16x8*)((LAS unsigned char*)shm + L_Q + wid * 4096 + hi * 512 + r32 * 16 + d0 * 1024) = qt[d0]; }
#define QFRAG(d0) (*(const LAS bf16x8*)(qp0 + (d0) * 1024))
    bf16x8 qr[4];
    float mhat = 0.f, l_reg = 0.f;
#pragma unroll
    for (int db = 0; db < 4; ++db) o[db] = f32x16{};
    f32x16 negm = f32x16{}; asm volatile("" : "+v"(negm));
    s16x4 vlo[8], vhi[8]; u32x4_t pwa0, pwa1, pwa2, pwa3, pwb0, pwb1, pwb2, pwb3;
    f32x16 c0, c1;
    int sv_prev = 0, sv_cur = 0, sv_next = 1;
#define ROT() do { sv_prev = sv_cur; sv_cur = sv_next; sv_next = (sv_next == 2) ? 0 : sv_next + 1; } while (0)
#define PIN(x) asm volatile("" : "+v"(x))
#define MX3(a, b, c) __builtin_fmaxf(__builtin_fmaxf((a), (b)), (c))
#define EX(v) __builtin_amdgcn_exp2f(v)
#define VFR(i) (bf16x8){vlo[i][0], vlo[i][1], vlo[i][2], vlo[i][3], vhi[i][0], vhi[i][1], vhi[i][2], vhi[i][3]}
#define VRD(i, f) do { vlo[i] = vtr(vp_ + (((f) >> 2) * 4096 + ((f) & 3) * 1024)); vhi[i] = vtr(vp_ + (((f) >> 2) * 4096 + ((f) & 3) * 1024 + 512)); } while (0)
    DMA_K(2);
    ATT_WB(4);
    { asm volatile("s_waitcnt lgkmcnt(0)" ::: "memory");
#pragma unroll
      for (int d0 = 0; d0 < 4; ++d0) qr[d0] = QFRAG(d0);
      c0 = negm; c1 = negm;
#pragma unroll
      for (int d0 = 0; d0 < 4; ++d0) { c0 = __builtin_amdgcn_mfma_f32_32x32x16_bf16(KFRAG(0, 2 * d0), qr[d0], c0, 0, 0, 0); c1 = __builtin_amdgcn_mfma_f32_32x32x16_bf16(KFRAG(0, 2 * d0 + 1), qr[d0], c1, 0, 0, 0); }
      float a = MX3(c0[0], c0[1], c1[0]), b = MX3(c0[2], c0[3], c1[1]); a = MX3(a, c1[2], c1[3]);
#pragma unroll
      for (int r = 4; r < 16; r += 4) { a = MX3(a, c0[r], c0[r + 1]); b = MX3(b, c0[r + 2], c0[r + 3]); a = MX3(a, c1[r], c1[r + 1]); b = MX3(b, c1[r + 2], c1[r + 3]); }
      mhat = merge_max32(__builtin_fmaxf(a, b));
      float sacc = 0.f;
#pragma unroll
      for (int r = 0; r < 16; ++r) { c0[r] = EX(c0[r] - mhat); c1[r] = EX(c1[r] - mhat); sacc += c0[r] + c1[r]; }
      l_reg = sacc;
#pragma unroll
      for (int r = 0; r < 16; ++r) negm[r] = -mhat;
      asm volatile("" : "+v"(negm));
      pwa0 = (u32x4_t){pg8::cvt_pk_bf16(c0[0], c0[1]), pg8::cvt_pk_bf16(c0[2], c0[3]), pg8::cvt_pk_bf16(c0[4], c0[5]), pg8::cvt_pk_bf16(c0[6], c0[7])};
      pwa1 = (u32x4_t){pg8::cvt_pk_bf16(c0[8], c0[9]), pg8::cvt_pk_bf16(c0[10], c0[11]), pg8::cvt_pk_bf16(c0[12], c0[13]), pg8::cvt_pk_bf16(c0[14], c0[15])};
      pwa2 = (u32x4_t){pg8::cvt_pk_bf16(c1[0], c1[1]), pg8::cvt_pk_bf16(c1[2], c1[3]), pg8::cvt_pk_bf16(c1[4], c1[5]), pg8::cvt_pk_bf16(c1[6], c1[7])};
      pwa3 = (u32x4_t){pg8::cvt_pk_bf16(c1[8], c1[9]), pg8::cvt_pk_bf16(c1[10], c1[11]), pg8::cvt_pk_bf16(c1[12], c1[13]), pg8::cvt_pk_bf16(c1[14], c1[15])}; }
    ATT_WB(0);
    DMA_K(3); DMA_V(1, 1);
    ROT();
    kf[0] = KFRAG(1, 0); kf[1] = KFRAG(1, 1); kf[2] = KFRAG(1, 2); kf[3] = KFRAG(1, 3); qr[0] = QFRAG(0);
    ATT_WB(3);
#define GAPB(MF, X, B, PN, W) do { X[B] = EX(X[B]); PIN(X); SBAR(); MF; X[B + 1] = EX(X[B + 1]); sacc += X[B]; sacc += X[B + 1]; PN[W] = pg8::cvt_pk_bf16(X[B], X[B + 1]); PIN(PN); PIN(sacc); SBAR(); } while (0)
#define PVM(db, PWk, i) o[db] = __builtin_amdgcn_mfma_f32_32x32x16_bf16(__builtin_bit_cast(bf16x8, PWk), VFR(i), o[db], 0, 0, 0)
#define STEP(PW0, PW1, PW2, PW3, PN0, PN1, PN2, PN3, t, GK, GV, GL) do { SBAR(); \
    const lds_cptr vp_ = vp0 + sv_prev * VSLOT; \
    qr[1] = QFRAG(1); kf[4] = KFRAG(t, 4); kf[5] = KFRAG(t, 5); qr[2] = QFRAG(2); kf[6] = KFRAG(t, 6); kf[7] = KFRAG(t, 7); qr[3] = QFRAG(3); \
    VRD(0, 0); SBAR(); \
    c0 = __builtin_amdgcn_mfma_f32_32x32x16_bf16(kf[0], qr[0], negm, 0, 0, 0); VRD(1, 1); SBAR(); \
    c1 = __builtin_amdgcn_mfma_f32_32x32x16_bf16(kf[1], qr[0], negm, 0, 0, 0); VRD(2, 2); SBAR(); \
    c0 = __builtin_amdgcn_mfma_f32_32x32x16_bf16(kf[2], qr[1], c0, 0, 0, 0);     VRD(3, 3); SBAR(); \
    c1 = __builtin_amdgcn_mfma_f32_32x32x16_bf16(kf[3], qr[1], c1, 0, 0, 0);     VRD(4, 4); SBAR(); \
    c0 = __builtin_amdgcn_mfma_f32_32x32x16_bf16(kf[4], qr[2], c0, 0, 0, 0);     VRD(5, 5); SBAR(); \
    c1 = __builtin_amdgcn_mfma_f32_32x32x16_bf16(kf[5], qr[2], c1, 0, 0, 0);     VRD(6, 6); SBAR(); \
    c0 = __builtin_amdgcn_mfma_f32_32x32x16_bf16(kf[6], qr[3], c0, 0, 0, 0);     VRD(7, 7); SBAR(); \
    c1 = __builtin_amdgcn_mfma_f32_32x32x16_bf16(kf[7], qr[3], c1, 0, 0, 0); SBAR(); \
    if (GK) { DMA_K((t) + 3); } if (GV) { DMA_V((t) + 1, sv_next); } \
    if (__builtin_expect((t) > tmax, 0)) { asm volatile("; masked tile" ::: "memory"); _Pragma("unroll") for (int r = 0; r < 16; ++r) { c0[r] = -INFINITY; c1[r] = -INFINITY; } asm volatile("" : "+v"(c0), "+v"(c1)); } \
    SBAR(); \
    float sacc = 0.f; \
    GAPB(PVM(0, PW0, 0), c0, 0,  PN0, 0); VRD(0, 8);  SBAR(); \
    GAPB(PVM(0, PW1, 1), c0, 2,  PN0, 1); VRD(1, 9);  SBAR(); \
    GAPB(PVM(0, PW2, 2), c0, 4,  PN0, 2); VRD(2, 10); SBAR(); \
    GAPB(PVM(0, PW3, 3), c0, 6,  PN0, 3); VRD(3, 11); SBAR(); \
    GAPB(PVM(1, PW0, 4), c0, 8,  PN1, 0); VRD(4, 12); SBAR(); \
    GAPB(PVM(1, PW1, 5), c0, 10, PN1, 1); VRD(5, 13); SBAR(); \
    GAPB(PVM(1, PW2, 6), c0, 12, PN1, 2); VRD(6, 14); SBAR(); \
    GAPB(PVM(1, PW3, 7), c0, 14, PN1, 3); VRD(7, 15); SBAR(); \
    if (GL) { kf[0] = KFRAG((t) + 1, 0); SBAR(); } GAPB(PVM(2, PW0, 0), c1, 0,  PN2, 0); \
    if (GL) { kf[1] = KFRAG((t) + 1, 1); SBAR(); } GAPB(PVM(2, PW1, 1), c1, 2,  PN2, 1); \
    if (GL) { kf[2] = KFRAG((t) + 1, 2); SBAR(); } GAPB(PVM(2, PW2, 2), c1, 4,  PN2, 2); \
    if (GL) { kf[3] = KFRAG((t) + 1, 3); qr[0] = QFRAG(0); SBAR(); } GAPB(PVM(2, PW3, 3), c1, 6,  PN2, 3); \
    GAPB(PVM(3, PW0, 4), c1, 8,  PN3, 0); \
    GAPB(PVM(3, PW1, 5), c1, 10, PN3, 1); \
    GAPB(PVM(3, PW2, 6), c1, 12, PN3, 2); \
    GAPB(PVM(3, PW3, 7), c1, 14, PN3, 3); \
    l_reg += sacc; \
    } while (0)
#define STEP_AB(t, GK, GV, GL) STEP(pwa0, pwa1, pwa2, pwa3, pwb0, pwb1, pwb2, pwb3, t, GK, GV, GL)
#define STEP_BA(t, GK, GV, GL) STEP(pwb0, pwb1, pwb2, pwb3, pwa0, pwa1, pwa2, pwa3, t, GK, GV, GL)
    int t = 1;
    for (; t + 5 < NT; t += 2) {
        STEP_AB(t, true, true, true);       ATT_WB(3); ROT();
        STEP_BA(t + 1, true, true, true);   ATT_WB(3); ROT();
    }
#define ENDW(tt) do { if ((tt) + 3 < NT) { ATT_WB(3); } else if ((tt) + 2 < NT) { ATT_WB(2); } else { ATT_WB(0); } } while (0)
    for (; t + 1 < NT; t += 2) {
        STEP_AB(t, (t + 3 < NT), (t + 1 < NT), (t + 1 < NT));         ENDW(t);     ROT();
        STEP_BA(t + 1, (t + 4 < NT), (t + 2 < NT), (t + 2 < NT));     ENDW(t + 1); ROT();
    }
    STEP_AB(NT - 1, false, false, false);
    { SBAR();
      const lds_cptr vp_ = vp0 + sv_cur * VSLOT;
#pragma unroll
      for (int db = 0; db < 4; ++db) { VRD(0, db * 4 + 0); VRD(1, db * 4 + 1); VRD(2, db * 4 + 2); VRD(3, db * 4 + 3);
          PVM(db, pwb0, 0); PVM(db, pwb1, 1); PVM(db, pwb2, 2); PVM(db, pwb3, 3); } }
    ATT_WB(0);
    l_reg = merge_sum32(l_reg);
    if (hi == 0) wsf[32 + r32] = 1.0f / l_reg;
    asm volatile("s_waitcnt lgkmcnt(0)" ::: "memory");
#pragma unroll
    for (int g = 0; g < 4; ++g) { const f32x4 fv = *(const LAS f32x4*)(wsf + 32 + 8 * g + 4 * hi);
#pragma unroll
        for (int i = 0; i < 4; ++i)
#pragma unroll
            for (int db = 0; db < 4; ++db) o[db][4 * g + i] *= fv[i]; }
    asm volatile("s_waitcnt lgkmcnt(0)" ::: "memory");
#undef DMA_K
#undef DMA_V
#undef GLDS_S
#undef KFRAG
#undef QFRAG
#undef ROT
#undef PIN
#undef MX3
#undef EX
#undef VFR
#undef VRD
#undef GAPB
#undef PVM
#undef STEP
#undef STEP_AB
#undef STEP_BA
#undef ENDW
}
#undef SBAR
#undef ATT_WB

__device__ __forceinline__ void attn_unit(int b, int h, int qb, const bf16* Z, const bf16* KT, const bf16* VT, bf16* MIX, unsigned* O0S, LAS unsigned char* shm, float lam, float out_scale, const float* subg) {
    const int tid = otid(); const int wid = __builtin_amdgcn_readfirstlane(tid >> 6);
    const size_t rowbase = (size_t)b * SEQ; const int q0 = qb * 256;
    const int NT = 4 * qb + 4, tmax = 4 * qb + (wid >> 1);
    const bf16* Qblk = Z + (rowbase + q0 + wid * 32) * ZP + ZC_Q + h * 128;
    const bf16* Kh = KT + (size_t)((b * 4 + h) * 2) * SEQ * 64;
    const bf16* Vh = VT + (size_t)(b * 4 + h) * SEQ * 128;
    unsigned* svw = O0S + (size_t)wid * 2048;
    f32x16 o[4];
    attn_pass(o, Qblk, Kh, Vh, shm, NT, tmax, wid, tid & 63);
    { int lane = tid & 63; asm volatile("" : "+v"(lane)); unsigned* sv = svw + lane;
#pragma unroll
      for (int db = 0; db < 4; ++db)
#pragma unroll
          for (int r2 = 0; r2 < 8; ++r2) sv[(db * 8 + r2) * 64] = pg8::cvt_pk_bf16(o[db][2 * r2], o[db][2 * r2 + 1]); }
    attn_pass(o, Qblk + 64, Kh + (size_t)SEQ * 64, Vh, shm, NT, tmax, wid, tid & 63);
    int lane = tid & 63; asm volatile("" : "+v"(lane));
    const int r32 = lane & 31, hi = lane >> 5;
    const unsigned* sv = svw + lane;
    float ssq[16];
#pragma unroll
    for (int r = 0; r < 16; ++r) ssq[r] = 0.f;
#pragma unroll
    for (int db = 0; db < 4; ++db)
#pragma unroll
        for (int r2 = 0; r2 < 8; ++r2) { const unsigned w = sv[(db * 8 + r2) * 64];
            const float a0 = __uint_as_float(w << 16), a1 = __uint_as_float(w & 0xffff0000u);
            const float v0 = a0 - lam * o[db][2 * r2], v1 = a1 - lam * o[db][2 * r2 + 1];
            o[db][2 * r2] = v0; o[db][2 * r2 + 1] = v1; ssq[2 * r2] += v0 * v0; ssq[2 * r2 + 1] += v1 * v1; }
#pragma unroll
    for (int r = 0; r < 16; ++r) {
#pragma unroll
        for (int off = 1; off < 32; off <<= 1) ssq[r] += shx(ssq[r], off, lane);
        ssq[r] = rsqrtf(ssq[r] * (1.0f / 128.0f) + EPS) * out_scale; }
    bf16* Ow = MIX + (rowbase + q0 + wid * 32) * DM + 512 + h * 128 + r32;
#pragma unroll
    for (int db = 0; db < 4; ++db) { const float gsc = subg[32 * db + r32];
#pragma unroll
        for (int r = 0; r < 16; ++r) Ow[(size_t)crow(r, hi) * DM + 32 * db] = f2bf(o[db][r] * ssq[r] * gsc); }
}
#undef ATT_WAIT_BAR
}

namespace lru {
typedef short bf16x8 __attribute__((ext_vector_type(8)));
typedef float f32x16 __attribute__((ext_vector_type(16)));
constexpr int NCH = SEQ / 64;
constexpr int WLDS = 2 * 32 * 144;
constexpr float LOG2E = 1.4426950408889634f;
__device__ __forceinline__ float sigm(float x) { return __builtin_amdgcn_rcpf(1.0f + __builtin_amdgcn_exp2f(-LOG2E * x)); }
typedef float f32x2_t __attribute__((ext_vector_type(2)));
__device__ __forceinline__ f32x2_t ex2(f32x2_t v) { return (f32x2_t){__builtin_amdgcn_exp2f(v.x), __builtin_amdgcn_exp2f(v.y)}; }
__device__ __forceinline__ f32x2_t rc2(f32x2_t v) { return (f32x2_t){__builtin_amdgcn_rcpf(v.x), __builtin_amdgcn_rcpf(v.y)}; }
__device__ __forceinline__ f32x2_t sq2(f32x2_t v) { return (f32x2_t){__builtin_amdgcn_sqrtf(v.x), __builtin_amdgcn_sqrtf(v.y)}; }
constexpr float NL2E = -1.4426950408889634f;
__device__ __forceinline__ float gelu_fast(float y) {
    const float u2 = (2.0f * 0.7978845608028654f * LOG2E) * y * __builtin_fmaf(0.044715f * y, y, 1.0f);
    return y * __builtin_amdgcn_rcpf(1.0f + __builtin_amdgcn_exp2f(-u2)); }
__device__ __forceinline__ float one_minus_exp(float x) {
    if (x > -0.25f) { float p = 1.0f + x * (1.0f / 7.0f); p = 1.0f + x * (1.0f / 6.0f) * p; p = 1.0f + x * 0.2f * p; p = 1.0f + x * 0.25f * p; p = 1.0f + x * (1.0f / 3.0f) * p; p = 1.0f + x * 0.5f * p; return -x * p; }
    return 1.0f - __builtin_amdgcn_exp2f(LOG2E * x);
}
struct Par { const float* cw; const float* cb; const bf16* wa_img; const float* ba; const bf16* wx_img; const float* bx; const float* lam; };
__device__ __forceinline__ void load_gate_frags(bf16x8 (&wf)[8], const float* W  , int lane) {
    const int r32 = lane & 31, hi = lane >> 5;
#pragma unroll
    for (int ks = 0; ks < 4; ++ks)
#pragma unroll
        for (int nb = 0; nb < 2; ++nb) { const float* p = W + (size_t)(16 * ks + 8 * hi) * 64 + 32 * nb + r32; u32x4_t w;
            w.x = pg8::cvt_pk_bf16(p[0 * 64], p[1 * 64]); w.y = pg8::cvt_pk_bf16(p[2 * 64], p[3 * 64]); w.z = pg8::cvt_pk_bf16(p[4 * 64], p[5 * 64]); w.w = pg8::cvt_pk_bf16(p[6 * 64], p[7 * 64]);
            wf[ks * 2 + nb] = __builtin_bit_cast(bf16x8, w); }
}
struct CvJob { const float* W; unsigned char* WT; int K, N, k0, n0, d0; };
constexpr int CV_SLOTS = 16;
constexpr int CV_ITEMS = CV_SLOTS * 256 * NWAVES;
constexpr int CV_I_FF = (DM / 64) * (DFF / 32);
__device__ __forceinline__ CvJob cv_job(int m, const float* wg, const float* wu, const float* wd, unsigned char* Mgu, unsigned char* Md) {
    CvJob j; const int seg = m / CV_I_FF, r = m - seg * CV_I_FF, e = seg / 3, kind = seg - 3 * e;
    j.W = ((kind == 0) ? wg : (kind == 1) ? wu : wd) + (size_t)e * DM * DFF;
    j.WT = (kind < 2) ? Mgu + (size_t)e * 2 * DFF * DM : Md + (size_t)e * DM * DFF;
    if (kind < 2) { j.K = DM; j.N = DFF; } else { j.K = DFF; j.N = DM; }
    const int nblk = j.N / 32, kb = r / nblk, nb = r - kb * nblk; j.k0 = 64 * kb; j.n0 = 32 * nb;
    j.d0 = (kind == 0) ? 256 * (j.n0 / 128) + (j.n0 % 128) : (kind == 1) ? 256 * (j.n0 / 128) + 128 + (j.n0 % 128) : j.n0;
    return j;
}
__device__ __forceinline__ void cv_issue(const CvJob& j, LAS unsigned char* slot, int lane) {
    const float* src = j.W + (size_t)(j.k0 + (lane >> 3)) * j.N + j.n0 + 4 * (lane & 7);
#pragma unroll
    for (int q = 0; q < 8; ++q) __builtin_amdgcn_global_load_lds((const unsigned*)(src + (size_t)(8 * q) * j.N), (LAS unsigned*)(slot + q * 1024), 16, 0, 2);
}
template <int NYOUNG>
__device__ __forceinline__ void cv_finish(const CvJob& j, LAS unsigned char* slot, int lane) {
    if constexpr (NYOUNG == 4) asm volatile("s_waitcnt vmcnt(4)" ::: "memory"); else asm volatile("s_waitcnt vmcnt(0)" ::: "memory");
    const int c = lane & 7; const LAS float* t = (const LAS float*)slot;
#pragma unroll
    for (int jj = 0; jj < 4; ++jj) { const int n = (lane >> 3) + 8 * jj; const LAS float* p = t + (8 * c) * 32 + n;
        pg8::u32x2 o; o.x = pg8::cvt4_fp8(p[0 * 32] * W_F8_SCALE, p[1 * 32] * W_F8_SCALE, p[2 * 32] * W_F8_SCALE, p[3 * 32] * W_F8_SCALE); o.y = pg8::cvt4_fp8(p[4 * 32] * W_F8_SCALE, p[5 * 32] * W_F8_SCALE, p[6 * 32] * W_F8_SCALE, p[7 * 32] * W_F8_SCALE);
        __builtin_nontemporal_store(o, (GAS pg8::u32x2*)(j.WT + (size_t)(j.d0 + n) * j.K + j.k0 + 8 * c)); }
    asm volatile("s_waitcnt lgkmcnt(0)" ::: "memory");
}
struct CvCtx { const float* wg; const float* wu; const float* wd; unsigned char* Mgu; unsigned char* Md; int slot0; int gw; };
template <int PASS>
__device__ __forceinline__ void item(int b, int ch, int n, const bf16* Z, const Par& P, const bf16x8 (&wfa)[8], const bf16x8 (&wfx)[8], float2* AGG, bf16* MIX, LAS unsigned char* wl, int lane, const CvCtx& cv, int cvslot, LAS unsigned char* cvl) {
    const int r32 = lane & 31, hi = lane >> 5, c = n * 64 + lane;
    const int lr = lane >> 3, lc = lane & 7;
    const size_t row0 = (size_t)b * SEQ + (size_t)ch * 64;
    const float cw0 = P.cw[c], cw1 = P.cw[LRU_W + c], cw2 = P.cw[2 * LRU_W + c], cw3 = P.cw[3 * LRU_W + c], cbv = P.cb[c];
    const float bav2 = NL2E * P.ba[c], bxv2 = NL2E * P.bx[c];
    const float L = P.lam[c]; const float sp = log1pf(__expf(-L));
    const float ka2 = -8.0f * sp * LOG2E;
    const GAS bf16* zc = (const GAS bf16*)Z + row0 * ZP + ZC_XR + c;
    float xm3 = 0.f, xm2 = 0.f, xm1 = 0.f;
    if (ch > 0) { xm3 = bf2f(zc[-3 * ZP]); xm2 = bf2f(zc[-2 * ZP]); xm1 = bf2f(zc[-1 * ZP]); }
    float carry = 0.f;
    if (PASS == 2) {
        const float2* ag = AGG + ((size_t)b * NCH) * LRU_W + c;
        for (int cc = 0; cc < ch; cc += 64) { float2 v[64];
#pragma unroll
            for (int j = 0; j < 64; ++j) { const int ci = (cc + j < ch) ? cc + j : ch - 1; v[j] = ag[(size_t)ci * LRU_W]; }
#pragma unroll
            for (int j = 0; j < 64; ++j) { const bool ok = cc + j < ch; carry = ok ? v[j].x * carry + v[j].y : carry; } }
    }
    float h = carry, aprod = 1.0f;
    const GAS v4u* xg = (const GAS v4u*)((const GAS bf16*)Z + (row0 + lr) * ZP + ZC_XR + n * 64 + lc * 8);
    const GAS v4u* yg = (const GAS v4u*)((const GAS bf16*)Z + (row0 + lr) * ZP + ZC_YR + n * 64 + lc * 8);
    GAS v4u* og = (GAS v4u*)((GAS bf16*)MIX + (row0 + lr) * DM + n * 64 + lc * 8);
    LAS unsigned char* xt = wl; LAS unsigned char* yt = wl + 32 * 144;
    LAS bf16* xcol = (LAS bf16*)xt + lane; LAS bf16* ycol = (LAS bf16*)yt + lane;
    LAS v4u* xw = (LAS v4u*)(xt + lr * 144 + lc * 16); LAS v4u* yw = (LAS v4u*)(yt + lr * 144 + lc * 16);
#pragma unroll 1
    for (int th = 0; th < 2; ++th) {
        const int cm = (cvslot + th) * (256 * NWAVES) + cv.gw; const bool cvon = (cvslot + th) < CV_SLOTS && cv.wg != nullptr;
        CvJob cj; cj.W = nullptr;
        if (cvon) { cj = cv_job(cm, cv.wg, cv.wu, cv.wd, cv.Mgu, cv.Md); cv_issue(cj, cvl, lane); }
        v4u xq[4], yq[4];
#pragma unroll
        for (int q = 0; q < 4; ++q) { xq[q] = xg[(size_t)(th * 32 + q * 8) * (ZP / 8)]; if (PASS == 2) yq[q] = yg[(size_t)(th * 32 + q * 8) * (ZP / 8)]; }
#pragma unroll
        for (int q = 0; q < 4; ++q) { xw[q * 8 * 9] = xq[q]; if (PASS == 2) yw[q * 8 * 9] = yq[q]; }
        asm volatile("s_waitcnt lgkmcnt(0)" ::: "memory");
        float xc[32];
#pragma unroll
        for (int t = 0; t < 32; ++t) { const float xv = bf2f(xcol[t * 72]); xc[t] = cbv + cw0 * xm3 + cw1 * xm2 + cw2 * xm1 + cw3 * xv; xm3 = xm2; xm2 = xm1; xm1 = xv; }
#pragma unroll
        for (int t = 0; t < 32; ++t) xcol[t * 72] = f2bf(xc[t]);
        asm volatile("s_waitcnt lgkmcnt(0)" ::: "memory");
        f32x16 ga[2], gx[2];
        ga[0] = f32x16{}; ga[1] = f32x16{}; gx[0] = f32x16{}; gx[1] = f32x16{};
#pragma unroll
        for (int ks = 0; ks < 4; ++ks) { const bf16x8 af = *(const LAS bf16x8*)(xt + r32 * 144 + (ks * 16 + hi * 8) * 2);
#pragma unroll
            for (int nb = 0; nb < 2; ++nb) { ga[nb] = __builtin_amdgcn_mfma_f32_32x32x16_bf16(af, wfa[ks * 2 + nb], ga[nb], 0, 0, 0); gx[nb] = __builtin_amdgcn_mfma_f32_32x32x16_bf16(af, wfx[ks * 2 + nb], gx[nb], 0, 0, 0); } }
#pragma unroll
        for (int r = 0; r < 16; ++r) {
            auto s1 = __builtin_amdgcn_permlane32_swap(__float_as_uint(ga[0][r]), __float_as_uint(ga[1][r]), false, false); ga[0][r] = __uint_as_float(s1[0]); ga[1][r] = __uint_as_float(s1[1]);
            auto s2 = __builtin_amdgcn_permlane32_swap(__float_as_uint(gx[0][r]), __float_as_uint(gx[1][r]), false, false); gx[0][r] = __uint_as_float(s2[0]); gx[1][r] = __uint_as_float(s2[1]); }
#pragma unroll
        for (int g = 0; g < 4; ++g)
#pragma unroll
            for (int hf = 0; hf < 2; ++hf)
#pragma unroll
                for (int ip = 0; ip < 2; ++ip) { const int i = 2 * ip, tl = 8 * g + 4 * hf + i;
                    const f32x2_t gr = {ga[hf][4 * g + i], ga[hf][4 * g + i + 1]}, gi = {gx[hf][4 * g + i], gx[hf][4 * g + i + 1]};
                    const f32x2_t r = rc2(ex2(gr * NL2E + bav2) + 1.0f), ig = rc2(ex2(gi * NL2E + bxv2) + 1.0f);
                    const f32x2_t a = ex2(r * ka2);
                    const f32x2_t mult = sq2(1.0f - a * a);
                    const f32x2_t xv2 = {xc[tl], xc[tl + 1]};
                    const f32x2_t bt = mult * (ig * xv2);
                    ga[hf][4 * g + i] = a.x; ga[hf][4 * g + i + 1] = a.y; gx[hf][4 * g + i] = bt.x; gx[hf][4 * g + i + 1] = bt.y; }
#pragma unroll
        for (int g = 0; g < 4; ++g)
#pragma unroll
            for (int hf = 0; hf < 2; ++hf)
#pragma unroll
                for (int i = 0; i < 4; ++i) { h = ga[hf][4 * g + i] * h + gx[hf][4 * g + i]; gx[hf][4 * g + i] = h; if (PASS == 1) aprod *= ga[hf][4 * g + i]; }
        if (PASS == 2) {
#pragma unroll
            for (int g = 0; g < 4; ++g)
#pragma unroll
                for (int hf = 0; hf < 2; ++hf)
#pragma unroll
                    for (int ip = 0; ip < 2; ++ip) { const int i = 2 * ip, tl = 8 * g + 4 * hf + i;
                        const f32x2_t hh = {gx[hf][4 * g + i], gx[hf][4 * g + i + 1]};
                        const f32x2_t y2 = {bf2f(ycol[tl * 72]), bf2f(ycol[(tl + 1) * 72])};
                        const f32x2_t u2 = (y2 * (2.0f * 0.7978845608028654f * LOG2E)) * (y2 * y2 * 0.044715f + 1.0f);
                        const f32x2_t ov = hh * y2 * rc2(ex2(-u2) + 1.0f);
                        const unsigned pk = pg8::cvt_pk_bf16(ov.x, ov.y);
                        ycol[tl * 72] = (bf16)(pk & 0xffffu); ycol[(tl + 1) * 72] = (bf16)(pk >> 16); }
        }
        if (PASS == 2) {
            asm volatile("s_waitcnt lgkmcnt(0)" ::: "memory");
#pragma unroll
            for (int q = 0; q < 4; ++q) __builtin_nontemporal_store((v4u)yw[q * 8 * 9], og + (size_t)(th * 32 + q * 8) * (DM / 8));
        }
        asm volatile("s_waitcnt lgkmcnt(0)" ::: "memory");
        if (cvon) cv_finish<(PASS == 2) ? 4 : 0>(cj, cvl, lane);
    }
    if (PASS == 1) AGG[((size_t)b * NCH + ch) * LRU_W + c] = make_float2(aprod, h);
}
template <int PASS>
__device__ __forceinline__ void phase(const bf16* Z, const Par& P, float2* AGG, bf16* MIX, LAS unsigned char* lds, int vcu, int G, CvCtx cv) {
    const int tid = otid(); const int lane = tid & 63; const int wid = __builtin_amdgcn_readfirstlane(tid >> 6);
    bf16x8 wfa[8], wfx[8];
#pragma unroll
    for (int f = 0; f < 8; ++f) { wfa[f] = *(const bf16x8*)(P.wa_img + ((size_t)(wid * 8 + f) * 64 + lane) * 8); wfx[f] = *(const bf16x8*)(P.wx_img + ((size_t)(wid * 8 + f) * 64 + lane) * 8); }
    cv.gw = vcu * NWAVES + wid; if (G != 256) cv.wg = nullptr;
    int it = 0;
    for (int bc = vcu; bc < NB * NCH; bc += G, ++it) item<PASS>(bc / NCH, bc % NCH, wid, Z, P, wfa, wfx, AGG, MIX, lds + wid * WLDS, lane, cv, cv.slot0 + 2 * it, lds + NWAVES * WLDS + wid * 8192);
}
}
namespace moe {
constexpr int MAXP = 136;
constexpr int SLOTS = MAXP * 256;
constexpr int PINFO = 160;
struct Ws { int* cnt; uint4* topk; int* slot_tok; float* slot_w; int* pinfo; unsigned char* HG; int* cnt_pre; int* cntp; unsigned char* HG1; };
constexpr int NRB = 4;
struct ModVec { f32x4 gm[4], sh[4]; };
__device__ __forceinline__ void load_modvec(ModVec& mv, const float* lng, const float* mb, int sh_off, int sc_off, int lane) {
#pragma unroll
    for (int j = 0; j < 4; ++j) { const int c0 = 4 * lane + 256 * j;
        const f32x4 g = *(const f32x4*)(lng + c0), sc = *(const f32x4*)(mb + sc_off + c0); mv.sh[j] = *(const f32x4*)(mb + sh_off + c0); mv.gm[j] = g * (1.0f + sc); }
}
__device__ __forceinline__ void load_rows(f32x4 (&v)[NRB][4], const float* x, int row0, int lane) {
#pragma unroll
    for (int r = 0; r < NRB; ++r)
#pragma unroll
        for (int j = 0; j < 4; ++j) v[r][j] = __builtin_nontemporal_load((const f32x4*)(x + (size_t)(row0 + r) * DM) + lane + 64 * j);
}
__device__ __forceinline__ void norm_rows(f32x4 (&v)[NRB][4], const ModVec& mv, int lane) {
    float s[NRB];
#pragma unroll
    for (int r = 0; r < NRB; ++r) { s[r] = 0.f;
#pragma unroll
        for (int j = 0; j < 4; ++j) s[r] += (v[r][j].x * v[r][j].x + v[r][j].y * v[r][j].y) + (v[r][j].z * v[r][j].z + v[r][j].w * v[r][j].w); }
#pragma unroll
    for (int o = 1; o < 64; o <<= 1)
#pragma unroll
        for (int r = 0; r < NRB; ++r) s[r] += shx(s[r], o, lane);
#pragma unroll
    for (int r = 0; r < NRB; ++r) { const float rstd = rsqrtf(s[r] * (1.0f / DM) + EPS);
#pragma unroll
        for (int j = 0; j < 4; ++j) v[r][j] = v[r][j] * rstd * mv.gm[j] + mv.sh[j]; }
}
__device__ __forceinline__ void store_row_bf16(const f32x4 (&h)[4], bf16* dst, int lane) {
#pragma unroll
    for (int j = 0; j < 4; ++j) { uint2 o; o.x = pg8::cvt_pk_bf16(h[j].x, h[j].y); o.y = pg8::cvt_pk_bf16(h[j].z, h[j].w); *(uint2*)(dst + 4 * lane + 256 * j) = o; }
}
__device__ __forceinline__ void store_row_fp8(const f32x4 (&h)[4], unsigned char* dst, int lane) {
#pragma unroll
    for (int j = 0; j < 4; ++j) *(unsigned*)(dst + 4 * lane + 256 * j) = pg8::cvt4_fp8(h[j].x, h[j].y, h[j].z, h[j].w);
}
__device__ __forceinline__ void route_phase(const float* x, const float* lng, const float* modl, const float* router, const Ws& W, unsigned char* H8  , LAS unsigned char* lds, int vcu, int G) {
    const int tid = otid(), lane = tid & 63; const int wid = __builtin_amdgcn_readfirstlane(tid >> 6);
    LAS int* lcnt = (LAS int*)lds;
    if (tid < 80) lcnt[tid] = 0;
    __syncthreads();
    const int rpw = MROWS / G / NWAVES;
    const int rbase = vcu * (MROWS / G) + wid * rpw;
    ModVec mv; load_modvec(mv, lng, modl + (size_t)(rbase / SEQ) * NMOD, 3 * DM, 4 * DM, lane);
    for (int i = 0; i < rpw; i += NRB) {
        f32x4 v[NRB][4]; load_rows(v, x, rbase + i, lane); norm_rows(v, mv, lane);
#pragma unroll
        for (int r = 0; r < NRB; ++r) store_row_fp8(v[r], H8 + (size_t)(rbase + i + r) * DM, lane);
        float lg[NRB][8];
#pragma unroll
        for (int r = 0; r < NRB; ++r)
#pragma unroll
            for (int e = 0; e < 8; ++e) lg[r][e] = 0.f;
#pragma unroll
        for (int j = 0; j < 4; ++j)
#pragma unroll
            for (int q = 0; q < 4; ++q) { const int c = 4 * lane + 256 * j + q; const f32x4 r0 = *(const f32x4*)(router + (size_t)c * 8), r1 = *(const f32x4*)(router + (size_t)c * 8 + 4);
#pragma unroll
                for (int r = 0; r < NRB; ++r) { const float hv = v[r][j][q];
                    lg[r][0] += hv * r0.x; lg[r][1] += hv * r0.y; lg[r][2] += hv * r0.z; lg[r][3] += hv * r0.w; lg[r][4] += hv * r1.x; lg[r][5] += hv * r1.y; lg[r][6] += hv * r1.z; lg[r][7] += hv * r1.w; } }
#pragma unroll
        for (int o = 1; o < 64; o <<= 1)
#pragma unroll
            for (int r = 0; r < NRB; ++r)
#pragma unroll
                for (int e = 0; e < 8; ++e) lg[r][e] += shx(lg[r][e], o, lane);
#pragma unroll
        for (int r = 0; r < NRB; ++r) { const int row = rbase + i + r;
            int i0 = 0; float v0 = lg[r][0];
#pragma unroll
            for (int e = 1; e < 8; ++e) if (lg[r][e] > v0) { v0 = lg[r][e]; i0 = e; }
            int i1 = -1; float v1 = -INFINITY;
#pragma unroll
            for (int e = 0; e < 8; ++e) if (e != i0 && lg[r][e] > v1) { v1 = lg[r][e]; i1 = e; }
            const float e1 = expf(v1 - v0), w0 = 1.0f / (1.0f + e1), w1 = e1 / (1.0f + e1);
            if (lane == 0) { W.topk[row] = make_uint4((unsigned)i0, (unsigned)i1, __float_as_uint(w0), __float_as_uint(w1)); __hip_atomic_fetch_add(&lcnt[i0], 1, __ATOMIC_RELAXED, __HIP_MEMORY_SCOPE_WORKGROUP); __hip_atomic_fetch_add(&lcnt[8 + i1], 1, __ATOMIC_RELAXED, __HIP_MEMORY_SCOPE_WORKGROUP); __hip_atomic_fetch_add(&lcnt[16 + i0 * 8 + i1], 1, __ATOMIC_RELAXED, __HIP_MEMORY_SCOPE_WORKGROUP); } }
    }
    __syncthreads();
    if (tid < 16) W.cnt_pre[vcu * 16 + tid] = lcnt[tid];
    if (tid < 64) W.cntp[vcu * 64 + tid] = lcnt[16 + tid];
    __syncthreads();
}
__device__ __forceinline__ void flip_phase(const Ws& W, LAS unsigned char* lds, int vcu, int G) {
    const int tid = otid(), lane = tid & 63; const int wid = __builtin_amdgcn_readfirstlane(tid >> 6);
    LAS int* s_N = (LAS int*)lds; LAS int* s_P = s_N + 64; LAS int* s_f = s_P + 64; LAS int* s_run = s_f + 64; LAS int* s_c1 = s_run + 64; LAS int* s_d = s_c1 + 8; LAS int* s_up = s_d + 8; LAS int* lcnt = s_up + 8;
    const int rpg = MROWS / G;
    if (tid < 64) { s_f[tid] = 0; s_run[tid] = 0; } if (tid < 16) lcnt[tid] = 0;
    {
        int tn[8], tp[8], c1 = 0;
#pragma unroll
        for (int b = 0; b < 8; ++b) { tn[b] = 0; tp[b] = 0; }
        for (int g = lane; g < G; g += 64) { const int4 q0 = *(const int4*)(W.cntp + g * 64 + wid * 8), q1 = *(const int4*)(W.cntp + g * 64 + wid * 8 + 4); const bool pre = g < vcu;
            const int qv[8] = {q0.x, q0.y, q0.z, q0.w, q1.x, q1.y, q1.z, q1.w};
#pragma unroll
            for (int b = 0; b < 8; ++b) { tn[b] += qv[b]; tp[b] += pre ? qv[b] : 0; }
            c1 += W.cnt_pre[g * 16 + 8 + wid]; }
#pragma unroll
        for (int b = 0; b < 8; ++b) { tn[b] = (int)wave_sum((float)tn[b], lane); tp[b] = (int)wave_sum((float)tp[b], lane); }
        c1 = (int)wave_sum((float)c1, lane);
        if (lane == 0) {
#pragma unroll
            for (int b = 0; b < 8; ++b) { s_N[wid * 8 + b] = tn[b]; s_P[wid * 8 + b] = tp[b]; }
            s_c1[wid] = c1; }
    }
    __syncthreads();
    if (tid == 0) {
        int S = 0;
        for (int e = 0; e < 8; ++e) { s_d[e] = s_c1[e] & 255; s_up[e] = 0; S += s_d[e]; }
        const int j = S >> 8;
        for (int n = 0; n < j; ++n) { int best = -1, br = 0; for (int e = 0; e < 8; ++e) if (!s_up[e] && s_d[e] > br) { br = s_d[e]; best = e; } if (best >= 0) s_up[best] = 1; }
        for (int e = 0; e < 8; ++e) s_d[e] = s_up[e] ? 256 - s_d[e] : -s_d[e];
        for (int a = 0; a < 8; ++a) for (int b = 0; b < 8; ++b) { if (a == b) continue; const int need = s_d[a], give = -s_d[b];
            if (need > 0 && give > 0) { int amt = need < give ? need : give; const int av = s_N[a * 8 + b]; amt = amt < av ? amt : av; s_f[a * 8 + b] = amt; s_d[a] -= amt; s_d[b] += amt; } }
    }
    __syncthreads();
    if (wid == 0) {
        for (int r0 = 0; r0 < rpg; r0 += 64) { const int row = vcu * rpg + r0 + lane; uint4 tk = W.topk[row]; const int pr = (int)tk.x * 8 + (int)tk.y; bool flip = false;
            for (int p = 0; p < 64; ++p) { const int f = __builtin_amdgcn_readfirstlane(s_f[p]); if (f <= 0) continue;
                const unsigned long long m = __ballot(pr == p); const int base = __builtin_amdgcn_readfirstlane(s_P[p] + s_run[p]);
                if (pr == p && base + __popcll(m & ((1ull << lane) - 1ull)) < f) flip = true;
                if (lane == 0) s_run[p] = base - s_P[p] + __popcll(m); }
            if (flip) { tk = make_uint4(tk.y, tk.x, tk.w, tk.z); W.topk[row] = tk; }
            __hip_atomic_fetch_add(&lcnt[tk.x], 1, __ATOMIC_RELAXED, __HIP_MEMORY_SCOPE_WORKGROUP); __hip_atomic_fetch_add(&lcnt[8 + tk.y], 1, __ATOMIC_RELAXED, __HIP_MEMORY_SCOPE_WORKGROUP); }
    }
    __syncthreads();
    if (tid < 16) W.cnt[vcu * 16 + tid] = lcnt[tid];
    __syncthreads();
}
__device__ __forceinline__ void flipgather_phase(const unsigned char* H8, const Ws& W, LAS unsigned char* lds, int vcu, int G) {
    const int tid = otid(), lane = tid & 63; const int wid = __builtin_amdgcn_readfirstlane(tid >> 6);
    LAS int* s_N = (LAS int*)lds; LAS int* s_P = s_N + 64; LAS int* s_f = s_P + 64; LAS int* s_run = s_f + 64; LAS int* s_d = s_run + 64; LAS int* s_up = s_d + 8;
    LAS int* s_tot = s_up + 8; LAS int* s_off = s_tot + 16; LAS int* s_slot = s_off + 16;
    const int rpg = MROWS / G, rpw = rpg / NWAVES;
    LAS v4u* s_tk = (LAS v4u*)(s_slot + 2 * rpg);
    if (tid < 64) { s_f[tid] = 0; s_run[tid] = 0; }
    {
        int tn[8], tp[8];
#pragma unroll
        for (int b = 0; b < 8; ++b) { tn[b] = 0; tp[b] = 0; }
        for (int g = lane; g < G; g += 64) { const int4 q0 = *(const int4*)(W.cntp + g * 64 + wid * 8), q1 = *(const int4*)(W.cntp + g * 64 + wid * 8 + 4); const bool pre = g < vcu;
            const int qv[8] = {q0.x, q0.y, q0.z, q0.w, q1.x, q1.y, q1.z, q1.w};
#pragma unroll
            for (int b = 0; b < 8; ++b) { tn[b] += qv[b]; tp[b] += pre ? qv[b] : 0; } }
#pragma unroll
        for (int b = 0; b < 8; ++b) { tn[b] = (int)wave_sum((float)tn[b], lane); tp[b] = (int)wave_sum((float)tp[b], lane); }
        if (lane == 0) {
#pragma unroll
            for (int b = 0; b < 8; ++b) { s_N[wid * 8 + b] = tn[b]; s_P[wid * 8 + b] = tp[b]; } }
    }
    __syncthreads();
    if (tid == 0) {
        int S = 0;
        for (int e = 0; e < 8; ++e) { int c1 = 0; for (int a = 0; a < 8; ++a) c1 += s_N[a * 8 + e]; s_d[e] = c1 & 255; s_up[e] = 0; S += s_d[e]; }
        const int j = S >> 8;
        for (int n = 0; n < j; ++n) { int best = -1, br = 0; for (int e = 0; e < 8; ++e) if (!s_up[e] && s_d[e] > br) { br = s_d[e]; best = e; } if (best >= 0) s_up[best] = 1; }
        for (int e = 0; e < 8; ++e) s_d[e] = s_up[e] ? 256 - s_d[e] : -s_d[e];
        for (int a = 0; a < 8; ++a) for (int b = 0; b < 8; ++b) { if (a == b) continue; const int need = s_d[a], give = -s_d[b];
            if (need > 0 && give > 0) { int amt = need < give ? need : give; const int av = s_N[a * 8 + b]; amt = amt < av ? amt : av; s_f[a * 8 + b] = amt; s_d[a] -= amt; s_d[b] += amt; } }
    }
    __syncthreads();
    if (tid < 16) { const int k = tid >> 3, e = tid & 7; int t = 0, o = 0;
        for (int q = 0; q < 8; ++q) { const int pr = e * 8 + q, pc = q * 8 + e;
            const int fr_ = s_f[pr], fc_ = s_f[pc], Fr = fr_ < s_P[pr] ? fr_ : s_P[pr], Fc = fc_ < s_P[pc] ? fc_ : s_P[pc];
            if (k == 0) { t += s_N[pr] - fr_ + fc_; o += s_P[pr] - Fr + Fc; } else { t += s_N[pc] + fr_ - fc_; o += s_P[pc] + Fr - Fc; } }
        s_tot[tid] = t; s_off[tid] = o; }
    if (wid == 0) {
        for (int r0 = 0; r0 < rpg; r0 += 64) { const int row = vcu * rpg + r0 + lane; uint4 tk = W.topk[row]; const int pr = (int)tk.x * 8 + (int)tk.y; bool flip = false;
            for (int p = 0; p < 64; ++p) { const int f = __builtin_amdgcn_readfirstlane(s_f[p]); if (f <= 0) continue;
                const unsigned long long m = __ballot(pr == p); const int base = __builtin_amdgcn_readfirstlane(s_P[p] + s_run[p]);
                if (pr == p && base + __popcll(m & ((1ull << lane) - 1ull)) < f) flip = true;
                if (lane == 0) s_run[p] = base - s_P[p] + __popcll(m); }
            if (flip) tk = make_uint4(tk.y, tk.x, tk.w, tk.z);
            s_tk[r0 + lane] = (v4u){tk.x, tk.y, tk.z, tk.w}; }
    }
    __syncthreads();
    if (wid < 2) { const int k = wid;
        int base[8], run[8]; { int bsum = 0;
#pragma unroll
            for (int e = 0; e < 8; ++e) { base[e] = bsum + s_off[k * 8 + e]; bsum += (s_tot[k * 8 + e] + 255) & ~255; run[e] = 0; } }
        for (int r0 = 0; r0 < rpg; r0 += 64) { const int row = vcu * rpg + r0 + lane; const v4u tk = s_tk[r0 + lane]; const int ek = (k == 0) ? (int)tk.x : (int)tk.y; int slot = 0;
#pragma unroll
            for (int e = 0; e < 8; ++e) { const unsigned long long m = __ballot(ek == e); const int below = __popcll(m & ((1ull << lane) - 1ull));
                if (ek == e) slot = base[e] + run[e] + below; run[e] += __popcll(m); }
            s_slot[k * rpg + r0 + lane] = slot;
            W.slot_tok[k * SLOTS + slot] = row; W.slot_w[k * SLOTS + slot] = __uint_as_float(k == 0 ? tk.z : tk.w); }
    }
    if (vcu == 0 && tid < 2 * MAXP) { const int k = tid / MAXP, pi = tid % MAXP; int np = 0, mine = -1;
#pragma unroll
        for (int e = 0; e < 8; ++e) { const int n = (s_tot[k * 8 + e] + 255) >> 8; if (pi >= np && pi < np + n) mine = e; np += n; }
        if (mine >= 0) W.pinfo[k * PINFO + 1 + pi] = mine;
        if (pi == 0) W.pinfo[k * PINFO] = np; }
    if (vcu < 16) { const int k = vcu >> 3, e = vcu & 7; int te = 0, be = 0, bsum = 0;
#pragma unroll
        for (int q = 0; q < 8; ++q) { const int tq = s_tot[k * 8 + q]; if (q == e) { te = tq; be = bsum; } bsum += (tq + 255) & ~255; }
        const int pe = (te + 255) & ~255;
        for (int sidx = te + tid; sidx < pe; sidx += NWAVES * 64) W.slot_tok[k * SLOTS + be + sidx] = -1; }
    __syncthreads();
    { const int rbase = vcu * rpg + wid * rpw;
      for (int i = 0; i < rpw; i += 8) { v4u v[8];
#pragma unroll
          for (int r = 0; r < 8; ++r) v[r] = __builtin_nontemporal_load((const GAS v4u*)(H8 + (size_t)(rbase + i + r) * DM + 16 * lane));
#pragma unroll
          for (int r = 0; r < 8; ++r) { const int lr = wid * rpw + i + r;
              *(GAS v4u*)(W.HG + (size_t)s_slot[lr] * DM + 16 * lane) = v[r]; __builtin_nontemporal_store(v[r], (GAS v4u*)(W.HG1 + (size_t)s_slot[rpg + lr] * DM + 16 * lane)); }
      } }
    __syncthreads();
}
__device__ __forceinline__ void gather_phase(const unsigned char* H8, const Ws& W, LAS unsigned char* lds, int vcu, int G) {
    const int tid = otid(), lane = tid & 63; const int wid = __builtin_amdgcn_readfirstlane(tid >> 6);
    LAS int* s_tot = (LAS int*)lds; LAS int* s_off = s_tot + 16; LAS int* s_slot = s_tot + 32;
    const int rpg = MROWS / G, rpw = rpg / NWAVES;
    {
#pragma unroll
        for (int k = 0; k < 2; ++k) { int t = 0, o = 0;
            for (int g = lane; g < G; g += 64) { const int c = W.cnt[g * 16 + k * 8 + wid]; t += c; o += (g < vcu) ? c : 0; }
            t = (int)wave_sum((float)t, lane); o = (int)wave_sum((float)o, lane);
            if (lane == 0) { s_tot[k * 8 + wid] = t; s_off[k * 8 + wid] = o; } }
    }
    __syncthreads();
    if (wid < 2) { const int k = wid;
        int base[8], run[8]; { int bsum = 0;
#pragma unroll
            for (int e = 0; e < 8; ++e) { base[e] = bsum + s_off[k * 8 + e]; bsum += (s_tot[k * 8 + e] + 255) & ~255; run[e] = 0; } }
        for (int r0 = 0; r0 < rpg; r0 += 64) { const int row = vcu * rpg + r0 + lane; const uint4 tk = W.topk[row]; const int ek = (k == 0) ? (int)tk.x : (int)tk.y; int slot = 0;
#pragma unroll
            for (int e = 0; e < 8; ++e) { const unsigned long long m = __ballot(ek == e); const int below = __popcll(m & ((1ull << lane) - 1ull));
                if (ek == e) slot = base[e] + run[e] + below; run[e] += __popcll(m); }
            s_slot[k * rpg + r0 + lane] = slot;
            W.slot_tok[k * SLOTS + slot] = row; W.slot_w[k * SLOTS + slot] = __uint_as_float(k == 0 ? tk.z : tk.w); }
    }
    if (vcu == 0 && tid < 2 * MAXP) { const int k = tid / MAXP, pi = tid % MAXP; int np = 0, mine = -1;
#pragma unroll
        for (int e = 0; e < 8; ++e) { const int n = (s_tot[k * 8 + e] + 255) >> 8; if (pi >= np && pi < np + n) mine = e; np += n; }
        if (mine >= 0) W.pinfo[k * PINFO + 1 + pi] = mine;
        if (pi == 0) W.pinfo[k * PINFO] = np; }
    if (vcu < 16) { const int k = vcu >> 3, e = vcu & 7; int te = 0, be = 0, bsum = 0;
#pragma unroll
        for (int q = 0; q < 8; ++q) { const int tq = s_tot[k * 8 + q]; if (q == e) { te = tq; be = bsum; } bsum += (tq + 255) & ~255; }
        const int pe = (te + 255) & ~255;
        for (int sidx = te + tid; sidx < pe; sidx += NWAVES * 64) W.slot_tok[k * SLOTS + be + sidx] = -1; }
    __syncthreads();
    { const int rbase = vcu * rpg + wid * rpw;
      for (int i = 0; i < rpw; i += 8) { v4u v[8];
#pragma unroll
          for (int r = 0; r < 8; ++r) v[r] = __builtin_nontemporal_load((const GAS v4u*)(H8 + (size_t)(rbase + i + r) * DM + 16 * lane));
#pragma unroll
          for (int r = 0; r < 8; ++r) { const int lr = wid * rpw + i + r;
              *(GAS v4u*)(W.HG + (size_t)s_slot[lr] * DM + 16 * lane) = v[r]; *(GAS v4u*)(W.HG1 + (size_t)s_slot[rpg + lr] * DM + 16 * lane) = v[r]; }
      } }
    __syncthreads();
}
}

constexpr int LDS_BYTES = 147456;
constexpr int MISC_OFF = LDS_BYTES - 256;
static_assert(att::L_END <= MISC_OFF && GEMM_LDS <= MISC_OFF, "LDS map");
#define RLX_AGENT __ATOMIC_RELAXED, __HIP_MEMORY_SCOPE_AGENT
#define XB_TMO      128
#define XB_XCNT(j)  (256  + 64 * (j))
#define XB_XSUB(j)  (1280 + 64 * (j))
#define XB_XGEN(j)  (2304 + 64 * (j))
#define XB_TOP      3328
#define XB_TOPGEN   3392
#define XCD_BAR_WORDS 3456
#define XB_SPIN_CAP (1u << 18)
__device__ __forceinline__ unsigned xb_ld(unsigned* p)              { return __hip_atomic_load((GAS unsigned*)p, __ATOMIC_RELAXED, __HIP_MEMORY_SCOPE_AGENT); }
__device__ __forceinline__ unsigned xb_add(unsigned* p, unsigned v) { return __hip_atomic_fetch_add((GAS unsigned*)p, v, __ATOMIC_RELAXED, __HIP_MEMORY_SCOPE_AGENT); }
__device__ __forceinline__ unsigned xb_xcc_id() { return (unsigned)__builtin_amdgcn_s_getreg((3 << 11) | 20) & 0xFu; }
#define XB_SPIN(cond, bar) do { unsigned _sp = 0; while (cond) { __builtin_amdgcn_s_sleep(1); \
    if ((++_sp & 255u) == 0u) { if (xb_ld(&(bar)[XB_TMO])) break; if (_sp > XB_SPIN_CAP) { atomicAdd(&(bar)[XB_TMO], 1u); break; } } } } while (0)
struct XcdBarrier { unsigned* bar; unsigned x; volatile LAS unsigned* st; };
__device__ __forceinline__ XcdBarrier xcd_barrier_post(unsigned* bar, volatile LAS unsigned* st) {
    XcdBarrier b; b.bar = bar; b.x = xb_xcc_id(); b.st = st;
    if (threadIdx.x == 0) (void)xb_add(&bar[XB_XCNT(b.x)], 1u);
    return b;
}
__device__ __forceinline__ void xcd_barrier_complete(unsigned* bar, unsigned x, unsigned& nloc, unsigned& nx) {
    const unsigned G = gridDim.x * gridDim.y * gridDim.z;
    unsigned sum, cnt, mine, sp = 0u;
    for (;;) {
        sum = 0u; cnt = 0u; mine = 0u;
#pragma unroll
        for (unsigned j = 0; j < 16; ++j) { const unsigned c = xb_ld(&bar[XB_XCNT(j)]); sum += c; cnt += (c > 0u) ? 1u : 0u; mine = (j == x) ? c : mine; }
        if (sum == G) break;
        __builtin_amdgcn_s_sleep(1);
        if ((++sp & 255u) == 0u) { if (xb_ld(&bar[XB_TMO])) break; if (sp > XB_SPIN_CAP) { atomicAdd(&bar[XB_TMO], 1u); break; } }
    }
    nloc = mine > 0u ? mine : 1u; nx = cnt > 0u ? cnt : 1u;
}
__device__ __forceinline__ void xcd_barrier(const XcdBarrier& b) {
    asm volatile("s_waitcnt vmcnt(0)" ::: "memory");
    __syncthreads();
    if (threadIdx.x == 0) {
        unsigned* bar = b.bar; unsigned bx_ = b.x;
        asm volatile("" : "+s"(bar), "+s"(bx_));
        __builtin_amdgcn_s_waitcnt(0);
        unsigned nloc = b.st[0], nx = b.st[1];
        if (nloc == 0u) { xcd_barrier_complete(bar, bx_, nloc, nx); b.st[0] = nloc; b.st[1] = nx; }
        const unsigned old = xb_add(&bar[XB_XSUB(bx_)], 1u);
        const unsigned gen = old / nloc;
        if (old + 1u == (gen + 1u) * nloc) {
            __builtin_amdgcn_fence(__ATOMIC_RELEASE, "agent");
            asm volatile("s_waitcnt vmcnt(0)" ::: "memory");
            const unsigned og = xb_add(&bar[XB_TOP], 1u);
            const unsigned tg = og / nx;
            if (og + 1u == (tg + 1u) * nx) xb_add(&bar[XB_TOPGEN], 1u);
            else XB_SPIN(xb_ld(&bar[XB_TOPGEN]) == tg, bar);
            __builtin_amdgcn_fence(__ATOMIC_ACQUIRE, "agent");
            xb_add(&bar[XB_XGEN(bx_)], 1u);
            asm volatile("s_waitcnt vmcnt(0)" ::: "memory");
        } else {
            XB_SPIN(xb_ld(&bar[XB_XGEN(bx_)]) == gen, bar);
            __builtin_amdgcn_fence(__ATOMIC_ACQUIRE, "agent");
            asm volatile("s_waitcnt vmcnt(0)" ::: "memory");
        }
    }
    __syncthreads();
}

struct Params {
    const float* x_in; const float* c_in; const int* pos; const float* ada_w; const float* ada_b; const float* ln1_g; const float* ln2_g; const float* w_in; const float* conv_w; const float* conv_b;
    const float* gate_a_w; const float* gate_a_b; const float* gate_x_w; const float* gate_x_b; const float* lru_lambda; const float* lam_q1; const float* lam_k1; const float* lam_q2; const float* lam_k2;
    const float* subln_g; const float* w_out; const float* ffn_wg; const float* ffn_wu; const float* ffn_wd; const float* moe_router; const float* moe_wg; const float* moe_wu; const float* moe_wd; const float* final_g;
    float* xr; unsigned char* ws; int ph_lo, ph_hi;
};
__device__ __forceinline__ void prologue_phase(const Params& p, LAS unsigned char* lds, int vcu, int G) {
    const int tid = otid(), lane = tid & 63; const int wid = __builtin_amdgcn_readfirstlane(tid >> 6);
    unsigned char* ws = p.ws;
    if (vcu < DEPTH * NMOD / 64) {
        LAS float* sc = (LAS float*)lds; LAS float* red = sc + NB * DM;
        for (int i = tid; i < NB * DM; i += NWAVES * 64) { const float v = p.c_in[i]; sc[i] = v / (1.0f + __expf(-v)); }
        __syncthreads();
        const int l = vcu / (NMOD / 64), n0 = (vcu % (NMOD / 64)) * 64;
        const float* w = p.ada_w + (size_t)l * DM * NMOD + (size_t)(wid * 128) * NMOD + n0 + lane;
        float a0 = 0.f, a1 = 0.f, a2 = 0.f, a3 = 0.f;
#pragma unroll 8
        for (int k = 0; k < 128; ++k) { const float wv = w[(size_t)k * NMOD]; const int kk = wid * 128 + k; a0 += sc[kk] * wv; a1 += sc[DM + kk] * wv; a2 += sc[2 * DM + kk] * wv; a3 += sc[3 * DM + kk] * wv; }
        red[(wid * 4 + 0) * 64 + lane] = a0; red[(wid * 4 + 1) * 64 + lane] = a1; red[(wid * 4 + 2) * 64 + lane] = a2; red[(wid * 4 + 3) * 64 + lane] = a3;
        __syncthreads();
        if (tid < 256) { const int b = tid >> 6; float sum = p.ada_b[l * NMOD + n0 + lane];
#pragma unroll
            for (int w8 = 0; w8 < 8; ++w8) sum += red[(w8 * 4 + b) * 64 + lane];
            ((float*)(ws + WS_MOD))[((size_t)l * NB + b) * NMOD + n0 + lane] = sum; }
        __syncthreads();
    }
    { float2* tbl = (float2*)(ws + WS_ROPE);
      for (int gid = vcu * (NWAVES * 64) + tid; gid < MROWS * 32; gid += G * NWAVES * 64) { const int row = gid >> 5, i = gid & 31;
          const float ang = __fmul_rn((float)p.pos[row], c_inv[i]); float cs, sn; sincos_acc(ang, cs, sn); tbl[gid] = make_float2(cs, sn); } }
    { const int gwf = vcu * NWAVES + wid;
      if (gwf < DEPTH * 2 * 8 * 8) { const int f = gwf & 7, n = (gwf >> 3) & 7, mat = (gwf >> 6) & 1, l = gwf >> 7; const int ks = f >> 1, nb = f & 1, r32 = lane & 31, hi = lane >> 5;
          const float* W = ((mat == 0) ? p.gate_a_w : p.gate_x_w) + ((size_t)l * 8 + n) * 64 * 64; const float* pw = W + (size_t)(16 * ks + 8 * hi) * 64 + 32 * nb + r32;
          v4u w; w.x = pg8::cvt_pk_bf16(pw[0 * 64], pw[1 * 64]); w.y = pg8::cvt_pk_bf16(pw[2 * 64], pw[3 * 64]); w.z = pg8::cvt_pk_bf16(pw[4 * 64], pw[5 * 64]); w.w = pg8::cvt_pk_bf16(pw[6 * 64], pw[7 * 64]);
          *(v4u*)(ws + WS_GF + ((size_t)gwf * 64 + lane) * 16) = w; } }
    { LAS float* scr = (LAS float*)(lds + wid * (64 * 33 * 4));
      constexpr int I_IN = (DM / 64) * (DIN / 32), I_OUT = (DM / 64) * (DM / 32), I_FF = (DM / 64) * (DFF / 32);
      constexpr int NITEMS = 2 * I_IN + 2 * I_OUT + 27 * I_FF;
      const int gw = vcu * NWAVES + wid, NGW = G * NWAVES;
      for (int it = gw; it < NITEMS; it += NGW) {
          const float* W; bf16* WT; int K, N, mode, r = it; bool f8 = false;
          if (r < 2 * I_IN) { const int l = r / I_IN; r -= l * I_IN; W = p.w_in + (size_t)l * DM * DIN; WT = (bf16*)(ws + WS_WIN) + (size_t)l * DIN * DM; K = DM; N = DIN; mode = 3; }
          else if ((r -= 2 * I_IN) < 2 * I_OUT) { const int l = r / I_OUT; r -= l * I_OUT; W = p.w_out + (size_t)l * DM * DM; WT = (bf16*)(ws + WS_WOUT) + (size_t)l * DM * DM; K = DM; N = DM; mode = 0; }
          else { r -= 2 * I_OUT; if (G == 256 && r >= 3 * I_FF && r - 3 * I_FF < lru::CV_ITEMS) continue;
              const int seg = r / I_FF; r -= seg * I_FF; const int e = (seg - 3) / 3, kind = (seg < 3) ? seg : (seg - 3) % 3;
              if (seg < 3) { W = (kind == 0) ? p.ffn_wg : (kind == 1) ? p.ffn_wu : p.ffn_wd; WT = (kind < 2) ? (bf16*)(ws + WS_WGU) : (bf16*)(ws + WS_WD); f8 = true; }
              else { W = ((kind == 0) ? p.moe_wg : (kind == 1) ? p.moe_wu : p.moe_wd) + (size_t)e * DM * DFF; f8 = true;
                     WT = (bf16*)((kind < 2) ? (ws + WS_MGU) + (size_t)e * 2 * DFF * DM : (ws + WS_MD) + (size_t)e * DM * DFF); }
              if (kind < 2) { K = DM; N = DFF; mode = 1 + kind; } else { K = DFF; N = DM; mode = 0; } }
          const int nblk = N / 32, kb = r / nblk, nb = r % nblk, k0 = 64 * kb, n0 = 32 * nb;
          int d0 = n0;
          if (mode == 1) d0 = 256 * (n0 / 128) + (n0 % 128); else if (mode == 2) d0 = 256 * (n0 / 128) + 128 + (n0 % 128);
          else if (mode == 3 && n0 >= ZC_Q && n0 < ZC_V) { const int u = n0 & 255; d0 = (n0 & ~255) + 128 * ((u >> 5) & 1) + 32 * (u >> 6); }
          if (f8) transpose_item<true>(W, K, N, WT, d0, scr, k0, n0, lane); else transpose_item<false>(W, K, N, WT, d0, scr, k0, n0, lane);
      } }
}
__device__ __forceinline__ void bias_job(const unsigned char* Wgu8, const bf16* Win1, const float* sh3  , const float* sh1, float* bias, int vcu, int G) {
    const int tid = otid(), lane = tid & 63; const int wid = __builtin_amdgcn_readfirstlane(tid >> 6);
    const int gw = vcu * NWAVES + wid, NGW = G * NWAVES;
    { f32x4 sh[4][4];
#pragma unroll
      for (int b = 0; b < 4; ++b)
#pragma unroll
          for (int j = 0; j < 4; ++j) sh[b][j] = *(const f32x4*)(sh3 + (size_t)b * NMOD + 16 * lane + 4 * j);
      for (int r0 = gw * 4; r0 < 2 * DFF; r0 += NGW * 4) { v4u w[4]; float a[4][4];
#pragma unroll
          for (int q = 0; q < 4; ++q) w[q] = *(const v4u*)(Wgu8 + (size_t)(r0 + q) * DM + 16 * lane);
#pragma unroll
          for (int q = 0; q < 4; ++q) {
#pragma unroll
              for (int b = 0; b < 4; ++b) a[q][b] = 0.f;
#pragma unroll
              for (int j = 0; j < 4; ++j) { const int word = (int)w[q][j]; const f32x4 f = {__builtin_amdgcn_cvt_f32_fp8(word, 0), __builtin_amdgcn_cvt_f32_fp8(word, 1), __builtin_amdgcn_cvt_f32_fp8(word, 2), __builtin_amdgcn_cvt_f32_fp8(word, 3)};
#pragma unroll
                  for (int b = 0; b < 4; ++b) a[q][b] += (f[0] * sh[b][j][0] + f[1] * sh[b][j][1]) + (f[2] * sh[b][j][2] + f[3] * sh[b][j][3]); } }
#pragma unroll
          for (int o = 1; o < 64; o <<= 1)
#pragma unroll
              for (int q = 0; q < 4; ++q)
#pragma unroll
                  for (int b = 0; b < 4; ++b) a[q][b] += shx(a[q][b], o, lane);
          if (lane == 0) {
#pragma unroll
              for (int q = 0; q < 4; ++q)
#pragma unroll
                  for (int b = 0; b < 4; ++b) bias[b * (2 * DFF) + r0 + q] = a[q][b]; } } }
    { f32x4 sh[4][4];
#pragma unroll
      for (int b = 0; b < 4; ++b)
#pragma unroll
          for (int j = 0; j < 4; ++j) sh[b][j] = *(const f32x4*)(sh1 + (size_t)b * NMOD + 16 * lane + 4 * j);
      for (int r0 = gw * 2; r0 < DIN; r0 += NGW * 2) { v4u w[2][2]; float a[2][4];
#pragma unroll
          for (int q = 0; q < 2; ++q) { w[q][0] = *(const v4u*)(Win1 + (size_t)(r0 + q) * DM + 16 * lane); w[q][1] = *(const v4u*)(Win1 + (size_t)(r0 + q) * DM + 16 * lane + 8); }
#pragma unroll
          for (int q = 0; q < 2; ++q) {
#pragma unroll
              for (int b = 0; b < 4; ++b) a[q][b] = 0.f;
#pragma unroll
              for (int j = 0; j < 4; ++j) { const unsigned lo = w[q][j >> 1][2 * (j & 1)], hi = w[q][j >> 1][2 * (j & 1) + 1];
                  const f32x4 f = {__uint_as_float(lo << 16), __uint_as_float(lo & 0xffff0000u), __uint_as_float(hi << 16), __uint_as_float(hi & 0xffff0000u)};
#pragma unroll
                  for (int b = 0; b < 4; ++b) a[q][b] += (f[0] * sh[b][j][0] + f[1] * sh[b][j][1]) + (f[2] * sh[b][j][2] + f[3] * sh[b][j][3]); } }
#pragma unroll
          for (int o = 1; o < 64; o <<= 1)
#pragma unroll
              for (int q = 0; q < 2; ++q)
#pragma unroll
                  for (int b = 0; b < 4; ++b) a[q][b] += shx(a[q][b], o, lane);
          if (lane == 0) {
#pragma unroll
              for (int q = 0; q < 2; ++q)
#pragma unroll
                  for (int b = 0; b < 4; ++b) bias[4 * (2 * DFF) + b * DIN + r0 + q] = a[q][b]; } } }
}
template <bool F8 = false>
__device__ __forceinline__ void norm_phase(const float* x, const float* lng, const float* modl, int sh_off, int sc_off, bf16* H, int vcu, int G) {
    const int tid = otid(); const int lane = tid & 63; const int wid = __builtin_amdgcn_readfirstlane(tid >> 6);
    const int rpw = MROWS / (G * NWAVES), rbase = (vcu * NWAVES + wid) * rpw;
    moe::ModVec mv; moe::load_modvec(mv, lng, modl + (size_t)(rbase / SEQ) * NMOD, sh_off, sc_off, lane);
    for (int i = 0; i < rpw; i += moe::NRB) {
        f32x4 v[moe::NRB][4]; moe::load_rows(v, x, rbase + i, lane); moe::norm_rows(v, mv, lane);
#pragma unroll
        for (int r = 0; r < moe::NRB; ++r) { if constexpr (F8) moe::store_row_fp8(v[r], (unsigned char*)H + (size_t)(rbase + i + r) * DM, lane); else moe::store_row_bf16(v[r], H + (size_t)(rbase + i + r) * DM, lane); }
    }
}
__device__ __forceinline__ void final_phase(float* x, const float* g, int vcu, int G) {
    const int tid = otid(); const int lane = tid & 63; const int wid = __builtin_amdgcn_readfirstlane(tid >> 6);
    const int rpw = MROWS / (G * NWAVES), rbase = (vcu * NWAVES + wid) * rpw;
    moe::ModVec mv;
#pragma unroll
    for (int j = 0; j < 4; ++j) { mv.gm[j] = *(const f32x4*)(g + 4 * lane + 256 * j); mv.sh[j] = (f32x4){0.f, 0.f, 0.f, 0.f}; }
    for (int i = 0; i < rpw; i += moe::NRB) {
        f32x4 v[moe::NRB][4]; moe::load_rows(v, x, rbase + i, lane); moe::norm_rows(v, mv, lane);
#pragma unroll
        for (int r = 0; r < moe::NRB; ++r)
#pragma unroll
            for (int j = 0; j < 4; ++j) ((f32x4*)(x + (size_t)(rbase + i + r) * DM) + lane)[64 * j] = v[r][j];
    }
}

#ifndef MK_PER_PHASE
#define MK_PER_PHASE 0
#endif
#ifndef REP_PRO
#define REP_PRO 1
#endif
#ifndef REP_NORM
#define REP_NORM 1
#endif
#ifndef REP_G1
#define REP_G1 1
#endif
#ifndef REP_LRU1
#define REP_LRU1 1
#endif
#ifndef REP_LRU2
#define REP_LRU2 1
#endif
#ifndef REP_ATT
#define REP_ATT 1
#endif
#ifndef REP_G3
#define REP_G3 1
#endif
#ifndef REP_ROUTE
#define REP_ROUTE 1
#endif
#ifndef REP_GATHER
#define REP_GATHER 1
#endif
#ifndef REP_GU
#define REP_GU 1
#endif
#define REPEAT(n) for (int rep_ = 0; rep_ < (n); ++rep_)
constexpr int N_PHASES = 19;
constexpr int CW_LEFT = 3584;
__global__ void __launch_bounds__(NWAVES * 64, 2) mega_fwd(Params p) {
    extern __shared__ __attribute__((aligned(16))) unsigned char lds_raw[];
    LAS unsigned char* lds = (LAS unsigned char*)lds_raw;
    const int tid = threadIdx.x; const int G = gridDim.x, bx = blockIdx.x;
    const int vcu = (G % 8 == 0) ? (bx % 8) * (G / 8) + bx / 8 : bx;
    volatile LAS unsigned* MISC = (volatile LAS unsigned*)(lds + MISC_OFF);
    if (tid < 64) MISC[tid] = 0u;
    __syncthreads();
    unsigned char* ws = p.ws;
    XcdBarrier bar; bar.bar = (unsigned*)(ws + WS_CTL); bar.x = 0; bar.st = nullptr;
    if (!MK_PER_PHASE) bar = xcd_barrier_post((unsigned*)(ws + WS_CTL), MISC + 8);
#if MK_PER_PHASE
    const int lo = p.ph_lo, hi = p.ph_hi; int ph = 0;
#endif
#if MK_PER_PHASE
#define PH_BEGIN if (lo <= ph && ph < hi) { GAS unsigned char* ws = (GAS unsigned char*)p.ws; asm volatile("" : "+s"(ws));
#define PH_END   } ++ph;
#define PH_LAST  } ++ph;
#else
#define PH_BEGIN { GAS unsigned char* ws = (GAS unsigned char*)p.ws; asm volatile("" : "+s"(ws));
#define PH_END   xcd_barrier(bar); }
#define PH_LAST  }
#endif
#define Win ((bf16*)(ws + WS_WIN))
#define Wout ((bf16*)(ws + WS_WOUT))
#define Wgu ((bf16*)(ws + WS_WGU))
#define Wd ((bf16*)(ws + WS_WD))
#define Mgu ((unsigned char*)(ws + WS_MGU))
#define Md ((unsigned char*)(ws + WS_MD))
#define MOD ((float*)(ws + WS_MOD))
#define ROPE ((const float*)(ws + WS_ROPE))
#define AGG ((float2*)(ws + WS_AGG))
#define RPP ((float*)(ws + WS_RP))
#define BIASP ((float*)(ws + WS_BIAS))
#define HB ((bf16*)(ws + WS_HB))
#define ZB ((bf16*)(ws + WS_ZB))
#define KTB ((bf16*)(ws + WS_KT))
#define VTB ((bf16*)(ws + WS_VT))
#define MIX ((bf16*)(ws + WS_MIX))
#define ACT ((bf16*)(ws + WS_ACT))
#define ACTM ((unsigned char*)(ws + WS_ACTM))
    float* xr = p.xr;

    PH_BEGIN REPEAT(REP_PRO) { prologue_phase(p, lds, vcu, G); __syncthreads(); } PH_END

#pragma unroll 1
    for (int l = 0; l < DEPTH; ++l) {
        const float lambda_init = 0.8f - 0.6f * __expf(-0.3f * (float)l);
        const float* modl = MOD + (size_t)l * NB * NMOD;
        const float* xcur = (l == 0) ? p.x_in : xr;
        if (l == 0) { PH_BEGIN REPEAT(REP_NORM) norm_phase<false>(xcur, p.ln1_g + l * DM, modl, 0, DM, HB, vcu, G);
                      bias_job((const unsigned char*)Wgu, Win + (size_t)DIN * DM, MOD + 3 * DM, MOD + (size_t)NB * NMOD, BIASP, vcu, G); PH_END }
        PH_BEGIN REPEAT(REP_G1) { pg8::Gemm g{HB, Win + (size_t)l * DIN * DM, 0, MROWS, DIN, DM, 0}; pg8::StaticOrder S; S.init(MROWS, DIN, G, bx);
                   pg8::EpiAffine<pg8::EpiG1> E{{ZB, KTB, VTB, ROPE, ZP, SEQ}, (l == 1) ? RPP : nullptr, BIASP + 4 * (2 * DFF), DIN, SEQ, 1.0f / DM, EPS};
                   pg8::gemm_phase<pg8::EpiAffine<pg8::EpiG1>, pg8::StaticOrder, true, true>(lds, g, S, E); } PH_END
        lru::Par LP{p.conv_w + l * 4 * LRU_W, p.conv_b + l * LRU_W, (const bf16*)(ws + WS_GF) + (size_t)(l * 2 + 0) * 32768, p.gate_a_b + l * LRU_W, (const bf16*)(ws + WS_GF) + (size_t)(l * 2 + 1) * 32768, p.gate_x_b + l * LRU_W, p.lru_lambda + l * LRU_W};
        PH_BEGIN REPEAT(REP_LRU1) lru::phase<1>(ZB, LP, AGG, MIX, lds, vcu, G, lru::CvCtx{p.moe_wg, p.moe_wu, p.moe_wd, Mgu, Md, l * 8, 0}); PH_END
        PH_BEGIN { const bool att_first = ((bx >> 3) & 1) != 0;
#pragma unroll 1
                   for (int step = 0; step < 2; ++step) {
                       if ((step == 0) != att_first) { REPEAT(REP_LRU2) lru::phase<2>(ZB, LP, AGG, MIX, lds, vcu, G, lru::CvCtx{p.moe_wg, p.moe_wu, p.moe_wd, Mgu, Md, l * 8 + 4, 0}); }
                       else { const int lane = otid() & 63;
                           const float lam = __expf(wave_sum(p.lam_q1[l * 64 + lane] * p.lam_k1[l * 64 + lane], lane)) - __expf(wave_sum(p.lam_q2[l * 64 + lane] * p.lam_k2[l * 64 + lane], lane)) + lambda_init;
                           REPEAT(REP_ATT) for (int pp = vcu; pp < 256; pp += G) { const int bh = pp >> 4, s = pp & 15;
                               att::attn_unit(bh >> 2, bh & 3, s, ZB, KTB, VTB, MIX, (unsigned*)(ws + WS_O0S) + (size_t)bx * 16384, lds, lam, 1.0f - lambda_init, p.subln_g + l * 128);
                               att::attn_unit(bh >> 2, bh & 3, 31 - s, ZB, KTB, VTB, MIX, (unsigned*)(ws + WS_O0S) + (size_t)bx * 16384, lds, lam, 1.0f - lambda_init, p.subln_g + l * 128); } }
                       __syncthreads(); } } PH_END
        PH_BEGIN { pg8::Gemm g{MIX, Wout + (size_t)l * DM * DM, 0, MROWS, DM, DM, 0}; pg8::StaticOrder S; S.init(MROWS, DM, G, bx);
                   if (l == 0) { pg8::EpiResidQ<true> E{xcur, xr, modl + 2 * DM, p.ln2_g, modl + 4 * DM, (void*)HB, RPP, DM, NMOD, SEQ, 1.0f};
                                 pg8::gemm_phase<pg8::EpiResidQ<true>, pg8::StaticOrder, true, true>(lds, g, S, E); }
                   else { pg8::EpiResid E{xcur, xr, modl + 2 * DM, nullptr, DM, NMOD, SEQ, 0, 1.0f, 0};
                          pg8::gemm_phase<pg8::EpiResid, pg8::StaticOrder, true, true>(lds, g, S, E); } } PH_END
        if (l == 0) {
            PH_BEGIN REPEAT(REP_G3) { pg8::Gemm g{HB, Wgu, 0, MROWS, 2 * DFF, DM / 2, 0}; pg8::StaticOrder S; S.init(MROWS, 2 * DFF, G, bx);
                       pg8::EpiAffine<pg8::EpiSwigluF8> E{{(unsigned char*)ACT, DFF, 1.0f / W_F8_SCALE}, RPP, BIASP, 2 * DFF, SEQ, 1.0f / DM, EPS};
                       pg8::gemm_phase<pg8::EpiAffine<pg8::EpiSwigluF8>, pg8::StaticOrder, true, true, true>(lds, g, S, E); } PH_END
            PH_BEGIN { pg8::Gemm g{ACT, Wd, 0, MROWS, DM, DFF / 2, 0}; pg8::StaticOrder S; S.init(MROWS, DM, G, bx);
                       pg8::EpiResidQ<false> E{xr, xr, modl + 5 * DM, p.ln1_g + DM, MOD + (size_t)NB * NMOD + DM, (void*)HB, RPP, DM, NMOD, SEQ, 1.0f / (W_F8_SCALE * pg8::ACT_F8_SCALE)};
                       pg8::gemm_phase<pg8::EpiResidQ<false>, pg8::StaticOrder, true, true, true>(lds, g, S, E); } PH_END
        } else {
            unsigned char* mb = ws + WS_MOE;
            moe::Ws W{(int*)mb, (uint4*)(mb + 16384), (int*)(mb + 16384 + 524288), (float*)(mb + 16384 + 524288 + 2 * moe::SLOTS * 4), (int*)(mb + 16384 + 524288 + 4 * moe::SLOTS * 4), (unsigned char*)(ws + WS_HG), (int*)(mb + 0x110000), (int*)(mb + 0x110000 + 16384), (unsigned char*)(ws + WS_HG1)};
            PH_BEGIN REPEAT(REP_ROUTE) moe::route_phase(xr, p.ln2_g + l * DM, modl, p.moe_router, W, (unsigned char*)(ws + WS_KT), lds, vcu, G); PH_END
            PH_BEGIN REPEAT(REP_GATHER) moe::flipgather_phase((const unsigned char*)(ws + WS_KT), W, lds, vcu, G); PH_END
            unsigned* left_done = (unsigned*)(ws + WS_CTL) + CW_LEFT;
            PH_BEGIN REPEAT(REP_GU) { pg8::Gemm g{(const bf16*)W.HG, (const bf16*)Mgu, (size_t)2 * DFF * DM, moe::SLOTS, 2 * DFF, DM / 2, 0}; pg8::PanelOrder S; S.init(W.pinfo[0], 2 * DFF, G, bx, W.pinfo + 1); pg8::EpiSwigluF8 E{ACTM, DFF, 1.0f / W_F8_SCALE};
                       pg8::gemm_phase<pg8::EpiSwigluF8, pg8::PanelOrder, true, true, true>(lds, g, S, E); } PH_END
            PH_BEGIN { pg8::Gemm g{(const bf16*)ACTM, (const bf16*)Md, (size_t)DM * DFF, moe::SLOTS, DM, DFF / 2, 0}; pg8::DownOrder S; S.init(W.pinfo[0], DM / 256, G, bx, W.pinfo + 1, 0);
                       pg8::EpiScatter E{xr, modl + 5 * DM, W.slot_tok, W.slot_w, DM, NMOD, SEQ, 1.0f / (W_F8_SCALE * pg8::ACT_F8_SCALE)};
                       pg8::gemm_phase<pg8::EpiScatter, pg8::DownOrder, true, true, true>(lds, g, S, E); } PH_END
            PH_BEGIN { const int np0 = W.pinfo[0]; const int nu0 = np0 * (DM / 256); const int left = nu0 - (nu0 / G) * G;
                       { pg8::Gemm g{(const bf16*)ACTM, (const bf16*)Md, (size_t)DM * DFF, moe::SLOTS, DM, DFF / 2, 0}; pg8::DownOrder S; S.init(np0, DM / 256, G, bx, W.pinfo + 1, 1);
                         pg8::EpiScatter E{xr, modl + 5 * DM, W.slot_tok, W.slot_w, DM, NMOD, SEQ, 1.0f / (W_F8_SCALE * pg8::ACT_F8_SCALE)};
                         pg8::gemm_phase<pg8::EpiScatter, pg8::DownOrder, false, true, true>(lds, g, S, E);
                         if (bx < left && otid() == 0) __hip_atomic_fetch_add(left_done, 1u, __ATOMIC_RELAXED, __HIP_MEMORY_SCOPE_AGENT); }
                       { pg8::Gemm g{(const bf16*)W.HG1, (const bf16*)Mgu, (size_t)2 * DFF * DM, moe::SLOTS, 2 * DFF, DM / 2, 0}; pg8::GuOverlapOrder S; S.init(W.pinfo[moe::PINFO], 2 * DFF, G, bx, W.pinfo + moe::PINFO + 1, left);
                         pg8::EpiSwigluGuard E{{ACTM, DFF, 1.0f / W_F8_SCALE}, left_done, (nu0 / G) * G / (DM / 256), left};
                         pg8::gemm_phase<pg8::EpiSwigluGuard, pg8::GuOverlapOrder, true, true, true>(lds, g, S, E); } } PH_END
            PH_BEGIN { pg8::Gemm g{(const bf16*)ACTM, (const bf16*)Md, (size_t)DM * DFF, moe::SLOTS, DM, DFF / 2, 0}; pg8::DownOrder S; S.init(W.pinfo[moe::PINFO], DM / 256, G, bx, W.pinfo + moe::PINFO + 1, 2);
                       pg8::EpiScatter E{xr, modl + 5 * DM, W.slot_tok + moe::SLOTS, W.slot_w + moe::SLOTS, DM, NMOD, SEQ, 1.0f / (W_F8_SCALE * pg8::ACT_F8_SCALE)};
                       pg8::gemm_phase<pg8::EpiScatter, pg8::DownOrder, true, true, true>(lds, g, S, E); } PH_END
        }
    }
    PH_BEGIN final_phase(xr, p.final_g, vcu, G); PH_LAST
#undef PH_BEGIN
#undef PH_END
#undef PH_LAST
}

extern "C" void kernel_launch(void* const* d_in, const int* in_sizes, int n_in, void* d_out, int out_size, void* d_ws, size_t ws_size, hipStream_t stream) {
    static int grid = 0;
    if (grid == 0) {
        if (n_in != 29 || in_sizes[0] != MROWS * DM || out_size != MROWS * DM || ws_size < WS_END) { fprintf(stderr, "kernel_launch: unexpected shapes / workspace (n_in %d, ws %zu); nothing launched\n", n_in, ws_size); grid = -1; return; }
        int dev = 0, cus = 0, per_cu = 0;
        if (hipGetDevice(&dev) != hipSuccess || hipDeviceGetAttribute(&cus, hipDeviceAttributeMultiprocessorCount, dev) != hipSuccess) { grid = -1; return; }
        if (hipFuncSetAttribute((const void*)mega_fwd, hipFuncAttributeMaxDynamicSharedMemorySize, LDS_BYTES) != hipSuccess) { fprintf(stderr, "kernel_launch: hipFuncSetAttribute failed\n"); grid = -1; return; }
        if (hipOccupancyMaxActiveBlocksPerMultiprocessor(&per_cu, (const void*)mega_fwd, NWAVES * 64, LDS_BYTES) != hipSuccess || per_cu < 1)
            fprintf(stderr, "kernel_launch: note: occupancy query reports %d workgroups per CU\n", per_cu);
        (void)hipGetLastError();
        grid = cus;
        if (MROWS % (grid * NWAVES) != 0) { fprintf(stderr, "kernel_launch: grid %d does not divide the row count\n", grid); grid = -1; return; }
    }
    if (grid < 0) return;
    if (hipMemsetAsync((char*)d_ws + WS_CTL, 0, 16384, stream) != hipSuccess) return;
    Params p{};
    const float** pf = (const float**)&p;
    p.x_in = (const float*)d_in[0]; p.c_in = (const float*)d_in[1]; p.pos = (const int*)d_in[2]; p.ada_w = (const float*)d_in[3]; p.ada_b = (const float*)d_in[4];
    p.ln1_g = (const float*)d_in[5]; p.ln2_g = (const float*)d_in[6]; p.w_in = (const float*)d_in[7]; p.conv_w = (const float*)d_in[8]; p.conv_b = (const float*)d_in[9];
    p.gate_a_w = (const float*)d_in[10]; p.gate_a_b = (const float*)d_in[11]; p.gate_x_w = (const float*)d_in[12]; p.gate_x_b = (const float*)d_in[13]; p.lru_lambda = (const float*)d_in[14];
    p.lam_q1 = (const float*)d_in[15]; p.lam_k1 = (const float*)d_in[16]; p.lam_q2 = (const float*)d_in[17]; p.lam_k2 = (const float*)d_in[18]; p.subln_g = (const float*)d_in[19];
    p.w_out = (const float*)d_in[20]; p.ffn_wg = (const float*)d_in[21]; p.ffn_wu = (const float*)d_in[22]; p.ffn_wd = (const float*)d_in[23]; p.moe_router = (const float*)d_in[24];
    p.moe_wg = (const float*)d_in[25]; p.moe_wu = (const float*)d_in[26]; p.moe_wd = (const float*)d_in[27]; p.final_g = (const float*)d_in[28];
    p.xr = (float*)d_out; p.ws = (unsigned char*)d_ws; (void)pf;
#if MK_PER_PHASE
    for (int i = 0; i < N_PHASES; ++i) { p.ph_lo = i; p.ph_hi = i + 1; mega_fwd<<<grid, NWAVES * 64, LDS_BYTES, stream>>>(p); }
#else
    p.ph_lo = 0; p.ph_hi = N_PHASES; mega_fwd<<<grid, NWAVES * 64, LDS_BYTES, stream>>>(p);
#endif
}
```
